# Optimizing an MI355X kernel written in HIP

```python
import jax, jax.numpy as jnp
from jax import lax
import numpy as np

D_MODEL = 1024
BATCH = 32
SEQ = 2048
DEPTH = 2
DEC_BATCH = 32
DEC_SEQ = 32
PAST_LEN = 1024

CHUNK = 64
N_MIXERS = 2
N_CONV_LAYERS = (DEPTH + 1) // 2
N_ATTN_LAYERS = DEPTH // 2
CONV_WIDTH = 3
N_HEADS = 16
HEAD_DIM = D_MODEL // N_HEADS
PAST_CHUNKS = 8
BAND_PAST = PAST_CHUNKS * CHUNK
BAND = BAND_PAST + CHUNK
MAX_REL_DIST = 128
D_FF = ((8 * D_MODEL + 3 * 256 - 1) // (3 * 256)) * 256
NORM_EPS = 1e-6
NEG_INF = -1e30

kernel_name = 'hybrid_shortconv_chunkattn_stream_step'


def rmsnorm(x, g):
    xf = x.astype(jnp.float32)
    inv = lax.rsqrt(jnp.mean(xf * xf, axis=-1, keepdims=True) + NORM_EPS)
    return (xf * inv * g.astype(jnp.float32)).astype(x.dtype)


def swiglu_ffn(h, w_gate_up, w_down):
    g, u = jnp.split(h @ w_gate_up, 2, axis=-1)
    return (jax.nn.silu(g) * u) @ w_down


def short_conv_mixer(h, conv_buf, w_in, conv_w, w_out):
    b_gate, c_gate, xh = jnp.split(h @ w_in, 3, axis=-1)
    u = c_gate * xh
    u_ext = jnp.concatenate([conv_buf, u], axis=1)
    T = u.shape[1]
    y = conv_w[0] * u_ext[:, 0:T]
    for tap in range(1, CONV_WIDTH):
        y = y + conv_w[tap] * u_ext[:, tap:tap + T]
    out = (b_gate * y) @ w_out
    return out, u_ext[:, -(CONV_WIDTH - 1):]


def _qkv(h, w_qkv):
    B, T, _ = h.shape
    q, k, v = jnp.split(h @ w_qkv, 3, axis=-1)
    shp = (B, T, N_HEADS, HEAD_DIM)
    return q.reshape(shp), k.reshape(shp), v.reshape(shp)


def _rel_bias(table, q_pos, k_pos):
    rel = jnp.clip(q_pos[:, None] - k_pos[None, :], -MAX_REL_DIST, MAX_REL_DIST) + MAX_REL_DIST
    return table[:, rel].astype(jnp.float32)


def _attend(q, k, v, bias, valid):
    s = jnp.einsum('bqhd,bkhd->bhqk', q, k).astype(jnp.float32) * (HEAD_DIM ** -0.5) + bias
    s = jnp.where(valid, s, NEG_INF)
    p = jax.nn.softmax(s, axis=-1)
    return jnp.einsum('bhqk,bkhd->bqhd', p.astype(v.dtype), v)


def chunk_attention_prompt(h, w_qkv, w_o, table):
    B, S, _ = h.shape
    nc = S // CHUNK
    q, k, v = _qkv(h, w_qkv)
    q_chunks = q.reshape(B, nc, CHUNK, N_HEADS, HEAD_DIM)
    pad = ((0, 0), (BAND_PAST, 0), (0, 0), (0, 0))
    k_pad = jnp.pad(k, pad)
    v_pad = jnp.pad(v, pad)
    band_pos = jnp.arange(BAND)
    bias = _rel_bias(table, jnp.arange(CHUNK) + BAND_PAST, band_pos)

    def one_chunk(c):
        q_c = lax.dynamic_index_in_dim(q_chunks, c, axis=1, keepdims=False)
        k_c = lax.dynamic_slice_in_dim(k_pad, c * CHUNK, BAND, axis=1)
        v_c = lax.dynamic_slice_in_dim(v_pad, c * CHUNK, BAND, axis=1)
        valid = (c * CHUNK - BAND_PAST + band_pos) >= 0
        return _attend(q_c, k_c, v_c, bias, valid)

    o = lax.map(one_chunk, jnp.arange(nc))
    o = jnp.moveaxis(o, 0, 1).reshape(B, S, D_MODEL)
    rows = min(BAND_PAST, S)
    return o @ w_o, k[:, S - rows:], v[:, S - rows:]


def chunk_attention_sample(h, cache_k, cache_v, w_qkv, w_o, table):
    B, T, _ = h.shape
    R = cache_k.shape[1]
    q, k, v = _qkv(h, w_qkv)
    k_all = jnp.concatenate([cache_k, k], axis=1)
    v_all = jnp.concatenate([cache_v, v], axis=1)
    bias = _rel_bias(table, R + jnp.arange(T), jnp.arange(R + T))
    o = _attend(q, k_all, v_all, bias, True).reshape(B, T, D_MODEL)
    return o @ w_o, k, v


def setup_inputs(seed: int = 0) -> dict:
    key = jax.random.key(seed)
    ks = jax.random.split(key, 20)
    f32 = jnp.float32

    def nrm(k, shape, scale):
        return jax.random.normal(k, shape, f32) * scale

    kv_rows = min(BAND_PAST, PAST_LEN)
    d_inv = D_MODEL ** -0.5
    return {
        'x_prompt': nrm(ks[0], (BATCH, SEQ, D_MODEL), 1.0),
        'x_sample': nrm(ks[1], (DEC_BATCH, DEC_SEQ, D_MODEL), 1.0),
        'state_conv': nrm(ks[2], (N_CONV_LAYERS, DEC_BATCH, CONV_WIDTH - 1, D_MODEL), 1.0),
        'cache_k': nrm(ks[3], (N_ATTN_LAYERS, DEC_BATCH, kv_rows, N_HEADS, HEAD_DIM), 1.0),
        'cache_v': nrm(ks[4], (N_ATTN_LAYERS, DEC_BATCH, kv_rows, N_HEADS, HEAD_DIM), 1.0),
        'conv_w_in': nrm(ks[5], (N_CONV_LAYERS, D_MODEL, 3 * D_MODEL), d_inv),
        'conv_kernel': nrm(ks[6], (N_CONV_LAYERS, CONV_WIDTH, D_MODEL), CONV_WIDTH ** -0.5),
        'conv_w_out': nrm(ks[7], (N_CONV_LAYERS, D_MODEL, D_MODEL), d_inv),
        'attn_w_qkv': nrm(ks[8], (N_ATTN_LAYERS, D_MODEL, 3 * D_MODEL), d_inv),
        'attn_w_o': nrm(ks[9], (N_ATTN_LAYERS, D_MODEL, D_MODEL), d_inv),
        'attn_rel_bias': nrm(ks[10], (N_ATTN_LAYERS, N_HEADS, 2 * MAX_REL_DIST + 1), 0.5),
        'norm_mix_pre': 1.0 + nrm(ks[11], (DEPTH, D_MODEL), 0.05),
        'norm_mix_post': 1.0 + nrm(ks[12], (DEPTH, D_MODEL), 0.05),
        'norm_ffn_pre': 1.0 + nrm(ks[13], (DEPTH, D_MODEL), 0.05),
        'norm_ffn_post': 1.0 + nrm(ks[14], (DEPTH, D_MODEL), 0.05),
        'ffn_w_gate_up': nrm(ks[15], (DEPTH, D_MODEL, 2 * D_FF), d_inv),
        'ffn_w_down': nrm(ks[16], (DEPTH, D_FF, D_MODEL), D_FF ** -0.5),
    }


def reference(x_prompt, x_sample, state_conv, cache_k, cache_v, conv_w_in, conv_kernel, conv_w_out,
              attn_w_qkv, attn_w_o, attn_rel_bias, norm_mix_pre, norm_mix_post, norm_ffn_pre,
              norm_ffn_post, ffn_w_gate_up, ffn_w_down):
    xp, xs = x_prompt, x_sample
    conv_p, conv_s, kp_l, vp_l, ks_l, vs_l = [], [], [], [], [], []
    for i in range(DEPTH):
        j = i // N_MIXERS
        hp = rmsnorm(xp, norm_mix_pre[i])
        hs = rmsnorm(xs, norm_mix_pre[i])
        if i % N_MIXERS == 0:
            zero_buf = jnp.zeros((xp.shape[0], CONV_WIDTH - 1, D_MODEL), xp.dtype)
            mp, bp = short_conv_mixer(hp, zero_buf, conv_w_in[j], conv_kernel[j], conv_w_out[j])
            ms, bs = short_conv_mixer(hs, state_conv[j], conv_w_in[j], conv_kernel[j], conv_w_out[j])
            conv_p.append(bp)
            conv_s.append(bs)
        else:
            mp, kp, vp = chunk_attention_prompt(hp, attn_w_qkv[j], attn_w_o[j], attn_rel_bias[j])
            ms, kn, vn = chunk_attention_sample(hs, cache_k[j], cache_v[j], attn_w_qkv[j], attn_w_o[j],
                                                attn_rel_bias[j])
            kp_l.append(kp)
            vp_l.append(vp)
            ks_l.append(kn)
            vs_l.append(vn)
        xp = xp + rmsnorm(mp, norm_mix_post[i])
        xs = xs + rmsnorm(ms, norm_mix_post[i])
        fp = swiglu_ffn(rmsnorm(xp, norm_ffn_pre[i]), ffn_w_gate_up[i], ffn_w_down[i])
        fs = swiglu_ffn(rmsnorm(xs, norm_ffn_pre[i]), ffn_w_gate_up[i], ffn_w_down[i])
        xp = xp + rmsnorm(fp, norm_ffn_post[i])
        xs = xs + rmsnorm(fs, norm_ffn_post[i])
    return (xp, xs, jnp.stack(conv_p), jnp.stack(conv_s), jnp.stack(kp_l), jnp.stack(vp_l),
            jnp.stack(ks_l), jnp.stack(vs_l))
```

```cpp
#include <hip/hip_runtime.h>
#include <hip/hip_cooperative_groups.h>
#include <cstdio>
#include <cstdint>
namespace cg = cooperative_groups;
namespace pg8 {
#define PG8_LAS __attribute__((address_space(3)))
typedef unsigned short bf16_t;
typedef short bf16x8 __attribute__((ext_vector_type(8)));
typedef float f32x4 __attribute__((ext_vector_type(4)));
typedef unsigned u32x4 __attribute__((ext_vector_type(4)));
constexpr int BM = 256, BK = 64, HALF = 128, HTB = HALF * BK * 2  , STAGE_BYTES = 8 * HTB, NXCD = 8, WGM = 8;

__host__ __device__ __forceinline__ int lds_byte(int r, int c) { const int st = (r >> 4) * 2 + (c >> 5), rr = r & 15, cc = c & 31, ob = rr * 64 + cc * 2; return st * 1024 + (ob ^ (((ob >> 9) & 1) << 5)); }
__host__ __device__ __forceinline__ void stage_rc(int b, int& R, int& C) { const int st = b / 1024, sb = b % 1024, swz = sb ^ (((sb >> 9) & 1) << 5); R = (st >> 1) * 16 + swz / 64; C = (st & 1) * 32 + (swz % 64) / 2; }
__host__ __device__ __forceinline__ int perm32(int rho) { const int n = rho >> 4, i = rho & 15; return 8 * (i >> 2) + 4 * n + (i & 3); }

struct Unit { int pm, pn; };
struct Gemm { const bf16_t* A; const bf16_t* Bt; int M, N, K; };

struct StaticOrder {
    int nM, nN, nwg, G, c;
    __host__ __device__ void init(int M, int N, int G_, int c_) { nM = M / BM; nN = N / BM; nwg = nM * nN; G = G_; c = c_; }
    __host__ __device__ bool next(int i, Unit& u) const {
        const long L = (long)i * G + c; if (L >= nwg) return false;
        int wgid = (int)L; { const int q = nwg / NXCD, r = nwg % NXCD, xcd = wgid % NXCD, off = wgid / NXCD; wgid = (xcd < r ? xcd * (q + 1) : r * (q + 1) + (xcd - r) * q) + off; }
        const int nig = WGM * nN, gid = wgid / nig, fm = gid * WGM, gsz = (nM - fm) < WGM ? (nM - fm) : WGM;
        u.pm = fm + ((wgid % nig) % gsz); u.pn = (wgid % nig) / gsz; return true;
    }
    __device__ __forceinline__ void a_ready(const Unit&) const {}
    __device__ __forceinline__ void done(const Unit&) const {}
};

__device__ __forceinline__ unsigned cvt_pk_bf16(float lo, float hi) { unsigned r; asm volatile("v_cvt_pk_bf16_f32 %0, %1, %2" : "=v"(r) : "v"(lo), "v"(hi)); return r; }
typedef float f32x2 __attribute__((ext_vector_type(2)));
__device__ __forceinline__ f32x2 gelu_pk(f32x2 v) {
    const f32x2 av = __builtin_elementwise_abs(v), d = av * 0.2316418882f + 1.0f;
    f32x2 t; t.x = __builtin_amdgcn_rcpf(d.x); t.y = __builtin_amdgcn_rcpf(d.y);
    f32x2 q = t * 0.5307027145f + (-0.7265760135f); q = q * t + 0.7107068705f; q = q * t + (-0.142248368f); q = q * t + 0.127414796f; q = q * t;
    const f32x2 s = (v * v) * (-0.72134752044f);
    f32x2 e; e.x = __builtin_amdgcn_exp2f(s.x); e.y = __builtin_amdgcn_exp2f(s.y);
    const f32x2 m = v * (q * e), r = v - m;
    f32x2 o; o.x = v.x < 0.f ? m.x : r.x; o.y = v.y < 0.f ? m.y : r.y; return o;
}

template <int ACT  > struct EpiBf16 {
    static constexpr bool PERM = true, AFTER_DRAIN = false; static_assert(ACT == 0 || ACT == 1, "EpiBf16: ACT is 0 (none) or 1 (gelu_pk)");
    bf16_t* O; int ldc; const float* bias; int split_cols; size_t split_stride; float scale0;
    __device__ __forceinline__ void operator()(const f32x4 (&acc)[2][2][4][2], const Unit& u, int wr, int wc, int fr, int fq) const {
        const int row0 = u.pm * BM + wr * 64 + fr; int colt = u.pn * BM; bf16_t* base = O;
        float sc = 1.f; if (split_cols) { const int t = colt / split_cols; base += (size_t)t * split_stride; colt -= t * split_cols; if (t == 0) sc = scale0; }
        const int col0 = colt + wc * 32 + 8 * fq, bcol0 = u.pn * BM + wc * 32 + 8 * fq;
        f32x4 bv[2][2];
#pragma unroll
        for (int bj = 0; bj < 2; ++bj)
#pragma unroll
            for (int n = 0; n < 2; ++n) bv[bj][n] = bias ? *(const f32x4*)(bias + bcol0 + bj * HALF + 4 * n) : (f32x4){0.f, 0.f, 0.f, 0.f};
#pragma unroll
        for (int ai = 0; ai < 2; ++ai)
#pragma unroll
            for (int m = 0; m < 4; ++m) { bf16_t* rowp = base + (size_t)(row0 + ai * HALF + m * 16) * ldc + col0;
#pragma unroll
                for (int bj = 0; bj < 2; ++bj) { f32x4 v0 = acc[ai][bj][m][0] + bv[bj][0], v1 = acc[ai][bj][m][1] + bv[bj][1];
                    if (ACT == 1) { f32x2 a = gelu_pk((f32x2){v0[0], v0[1]}), b = gelu_pk((f32x2){v0[2], v0[3]}), c = gelu_pk((f32x2){v1[0], v1[1]}), d = gelu_pk((f32x2){v1[2], v1[3]});
                        v0 = (f32x4){a.x, a.y, b.x, b.y}; v1 = (f32x4){c.x, c.y, d.x, d.y}; }
                    v0 = v0 * sc; v1 = v1 * sc; u32x4 w; w.x = cvt_pk_bf16(v0[0], v0[1]); w.y = cvt_pk_bf16(v0[2], v0[3]); w.z = cvt_pk_bf16(v1[0], v1[1]); w.w = cvt_pk_bf16(v1[2], v1[3]);
                    *(u32x4*)(rowp + bj * HALF) = w; } }
    }
};
template <class Epi, class Sched, bool ALIGN_EPI = false, bool SP2 = false>
__device__ __forceinline__ void gemm_phase(PG8_LAS unsigned char* lds, const Gemm g, const Sched& S, const Epi& E) {
    const int tid = threadIdx.x, wid = __builtin_amdgcn_readfirstlane(tid >> 6), lane = tid & 63, wr = wid >> 2, wc = wid & 3, fr = lane & 15, fq = lane >> 4;
    const int K = g.K, nt = K / BK;
    unsigned voffA[2], voffB[2];
#pragma unroll
    for (int i = 0; i < 2; ++i) { int R, C; stage_rc(tid * 16 + i * 8192, R, C); const int Rb = Epi::PERM ? ((R & ~31) + perm32(R & 31)) : R;
        voffA[i] = (unsigned)(R * K + C) * 2u; voffB[i] = (unsigned)(Rb * K + C) * 2u; }
    const size_t kstep = (size_t)(BK * 2);
    const size_t hstep = (size_t)HALF * K * 2;
    const size_t tstep = 2 * hstep;
    const unsigned ldsw = (unsigned)wid * 1024u;
    const int aoff = lds_byte(wr * 64 + fr, fq * 8), boff = lds_byte(wc * 32 + fr, fq * 8);
#define PG8_SA(b, h) (((b) * 2 + (h)) * HTB)
#define PG8_SB(b, h) ((4 + (b) * 2 + (h)) * HTB)
#define PG8_STAGE(bufoff, gbase, voff) do { _Pragma("unroll") for (int _i = 0; _i < 2; ++_i) \
        __builtin_amdgcn_global_load_lds((const unsigned*)((const char*)(gbase) + (voff)[_i]), (PG8_LAS unsigned*)(lds + (bufoff) + ldsw + _i * 8192), 16, 0, 0); } while (0)
#define PG8_LDA(dst, b, h) do { _Pragma("unroll") for (int m = 0; m < 4; ++m) _Pragma("unroll") for (int k = 0; k < 2; ++k) dst[m][k] = *(const PG8_LAS bf16x8*)(lds + PG8_SA(b, h) + aoff + m * 2048 + k * 1024); } while (0)
#define PG8_LDB(dst, b, h) do { _Pragma("unroll") for (int n = 0; n < 2; ++n) _Pragma("unroll") for (int k = 0; k < 2; ++k) dst[n][k] = *(const PG8_LAS bf16x8*)(lds + PG8_SB(b, h) + boff + n * 2048 + k * 1024); } while (0)
#define PG8_MMA(ai, bj, At, Bt) do { __builtin_amdgcn_s_setprio(1); _Pragma("unroll") for (int m = 0; m < 4; ++m) _Pragma("unroll") for (int n = 0; n < 2; ++n) _Pragma("unroll") for (int k = 0; k < 2; ++k) \
        acc[ai][bj][m][n] = __builtin_amdgcn_mfma_f32_16x16x32_bf16(Bt[n][k], At[m][k], acc[ai][bj][m][n], 0, 0, 0); __builtin_amdgcn_s_setprio(0); } while (0)
#define PG8_WAIT_V(n) asm volatile("s_waitcnt vmcnt(" #n ")" ::: "memory")
#define PG8_WAIT_L(n) asm volatile("s_waitcnt lgkmcnt(" #n ")" ::: "memory")
#define PG8_BAR __builtin_amdgcn_s_barrier()
#define PG8_SCHED __builtin_amdgcn_sched_barrier(0)
    Unit cur, nxt; int ui = 0;
    if (!S.next(0, cur)) return;
    f32x4 acc[2][2][4][2];
#pragma unroll
    for (int a = 0; a < 2; ++a)
#pragma unroll
        for (int b = 0; b < 2; ++b)
#pragma unroll
            for (int m = 0; m < 4; ++m)
#pragma unroll
                for (int n = 0; n < 2; ++n) acc[a][b][m][n] = (f32x4){0.f, 0.f, 0.f, 0.f};
    bf16x8 At[4][2], B0[2][2], B1[2][2];
    const char* cA = (const char*)g.A + (size_t)cur.pm * tstep; const char* cB = (const char*)g.Bt + (size_t)cur.pn * tstep;
    S.a_ready(cur);
    if constexpr (SP2) {
        PG8_STAGE(PG8_SB(0, 0), cB, voffB); PG8_STAGE(PG8_SB(0, 1), cB + hstep, voffB); PG8_STAGE(PG8_SA(0, 0), cA, voffA); PG8_STAGE(PG8_SA(0, 1), cA + hstep, voffA);
        if (wr == 1) PG8_BAR;
        PG8_WAIT_V(2); PG8_BAR;
        PG8_STAGE(PG8_SB(1, 0), cB + kstep, voffB); PG8_STAGE(PG8_SA(1, 0), cA + kstep, voffA); PG8_STAGE(PG8_SB(1, 1), cB + hstep + kstep, voffB);
        PG8_WAIT_V(6); PG8_BAR;
    } else {
        PG8_STAGE(PG8_SB(0, 0), cB, voffB); PG8_STAGE(PG8_SA(0, 0), cA, voffA); PG8_STAGE(PG8_SB(0, 1), cB + hstep, voffB); PG8_STAGE(PG8_SA(0, 1), cA + hstep, voffA);
        if (wr == 1) PG8_BAR;
        PG8_WAIT_V(4); PG8_BAR;
        PG8_STAGE(PG8_SB(1, 0), cB + kstep, voffB); PG8_STAGE(PG8_SA(1, 0), cA + kstep, voffA); PG8_STAGE(PG8_SB(1, 1), cB + hstep + kstep, voffB);
        PG8_WAIT_V(6); PG8_BAR;
    }
    for (;;) {
        const bool has_next = S.next(ui + 1, nxt);
        const char* nA = has_next ? (const char*)g.A + (size_t)nxt.pm * tstep : cA; const char* nB = has_next ? (const char*)g.Bt + (size_t)nxt.pn * tstep : cB;
        for (int t = 0; t < nt; t += 2) {
            const bool last = (t == nt - 2);
            const char* a1 = cA + (size_t)(t + 1) * kstep;
            const char* a2 = last ? nA : cA + (size_t)(t + 2) * kstep; const char* b2 = last ? nB : cB + (size_t)(t + 2) * kstep;
            const char* a3 = a2 + kstep; const char* b3 = b2 + kstep;
            if (last && has_next) S.a_ready(nxt);
            if constexpr (SP2) {
            PG8_LDB(B0, 0, 0); PG8_LDB(B1, 0, 1); PG8_SCHED; PG8_LDA(At, 0, 0); PG8_STAGE(PG8_SA(1, 1), a1 + hstep, voffA);
            PG8_WAIT_V(8); PG8_WAIT_L(0); PG8_BAR; PG8_MMA(0, 0, At, B0); PG8_MMA(0, 1, At, B1); PG8_BAR; PG8_SCHED;
            PG8_LDA(At, 0, 1); PG8_STAGE(PG8_SB(0, 0), b2, voffB); PG8_STAGE(PG8_SB(0, 1), b2 + hstep, voffB); PG8_STAGE(PG8_SA(0, 0), a2, voffA);
            PG8_WAIT_V(8); PG8_WAIT_L(0); PG8_BAR; PG8_MMA(1, 0, At, B0); PG8_MMA(1, 1, At, B1); PG8_BAR; PG8_SCHED;
            PG8_LDB(B0, 1, 0); PG8_LDB(B1, 1, 1); PG8_SCHED; PG8_LDA(At, 1, 0); PG8_STAGE(PG8_SA(0, 1), a2 + hstep, voffA);
            PG8_WAIT_V(8); PG8_WAIT_L(0); PG8_BAR; PG8_MMA(0, 0, At, B0); PG8_MMA(0, 1, At, B1); PG8_BAR; PG8_SCHED;
            PG8_LDA(At, 1, 1); PG8_STAGE(PG8_SB(1, 0), b3, voffB); PG8_STAGE(PG8_SB(1, 1), b3 + hstep, voffB); PG8_STAGE(PG8_SA(1, 0), a3, voffA);
            PG8_WAIT_V(8); PG8_WAIT_L(0); PG8_BAR; PG8_MMA(1, 0, At, B0); PG8_MMA(1, 1, At, B1); PG8_BAR; PG8_SCHED;
            } else {
            PG8_LDB(B0, 0, 0); PG8_SCHED; PG8_LDA(At, 0, 0); PG8_STAGE(PG8_SA(1, 1), a1 + hstep, voffA);
            PG8_WAIT_L(8); PG8_BAR; PG8_WAIT_L(0); PG8_MMA(0, 0, At, B0); PG8_BAR; PG8_SCHED;
            PG8_LDB(B1, 0, 1); PG8_STAGE(PG8_SB(0, 0), b2, voffB);
            PG8_BAR; PG8_WAIT_L(0); PG8_MMA(0, 1, At, B1); PG8_BAR;
            PG8_LDA(At, 0, 1); PG8_STAGE(PG8_SA(0, 0), a2, voffA);
            PG8_BAR; PG8_WAIT_L(0); PG8_MMA(1, 0, At, B0); PG8_BAR; PG8_SCHED;
            PG8_STAGE(PG8_SB(0, 1), b2 + hstep, voffB);
            PG8_WAIT_V(6); PG8_BAR; PG8_MMA(1, 1, At, B1); PG8_BAR;
            PG8_LDB(B0, 1, 0); PG8_SCHED; PG8_LDA(At, 1, 0); PG8_STAGE(PG8_SA(0, 1), a2 + hstep, voffA);
            PG8_WAIT_L(8); PG8_BAR; PG8_WAIT_L(0); PG8_MMA(0, 0, At, B0); PG8_BAR; PG8_SCHED;
            PG8_LDB(B1, 1, 1); PG8_STAGE(PG8_SB(1, 0), b3, voffB);
            PG8_BAR; PG8_WAIT_L(0); PG8_MMA(0, 1, At, B1); PG8_BAR;
            PG8_LDA(At, 1, 1); PG8_STAGE(PG8_SA(1, 0), a3, voffA);
            PG8_BAR; PG8_WAIT_L(0); PG8_MMA(1, 0, At, B0); PG8_BAR; PG8_SCHED;
            PG8_STAGE(PG8_SB(1, 1), b3 + hstep, voffB);
            PG8_WAIT_V(6); PG8_BAR; PG8_MMA(1, 1, At, B1); PG8_BAR;
            }
        }
        if constexpr (ALIGN_EPI) { if (wr == 0) PG8_BAR; }
        if constexpr (!Epi::AFTER_DRAIN) { E(acc, cur, wr, wc, fr, fq); S.done(cur); }
        if (!has_next) break;
#pragma unroll
        for (int a = 0; a < 2; ++a)
#pragma unroll
            for (int b = 0; b < 2; ++b)
#pragma unroll
                for (int m = 0; m < 4; ++m)
#pragma unroll
                    for (int n = 0; n < 2; ++n) acc[a][b][m][n] = (f32x4){0.f, 0.f, 0.f, 0.f};
        cur = nxt; cA = nA; cB = nB; ++ui;
        if constexpr (ALIGN_EPI) { if (wr == 1) PG8_BAR; }
    }
    PG8_WAIT_V(0);
    if constexpr (!ALIGN_EPI) { if (wr == 0) PG8_BAR; }
    PG8_BAR;
    if constexpr (Epi::AFTER_DRAIN) { E.fused(acc, cur, wr, wc, fr, fq, lds, wid, lane); S.done(cur); }
#undef PG8_SA
#undef PG8_SB
#undef PG8_STAGE
#undef PG8_LDA
#undef PG8_LDB
#undef PG8_MMA
#undef PG8_WAIT_V
#undef PG8_WAIT_L
#undef PG8_BAR
#undef PG8_SCHED
}
}

#define LAS __attribute__((address_space(3)))
typedef unsigned short bf16_t;
typedef unsigned u32x4 __attribute__((ext_vector_type(4)));
typedef unsigned u32x2 __attribute__((ext_vector_type(2)));
typedef float f32x4 __attribute__((ext_vector_type(4)));
typedef float f32x16 __attribute__((ext_vector_type(16)));
typedef short bf16x8 __attribute__((ext_vector_type(8)));
typedef short s16x4 __attribute__((ext_vector_type(4)));

constexpr int D = 1024, NB = 32, SEQ = 2048, DB = 32, DS = 32, NH = 16, HD = 64, DFF = 2816;
constexpr int MP = NB * SEQ;
constexpr int MS = DB * DS;
constexpr int M = MP + MS;
constexpr int CROWS = 512;
constexpr float EPS = 1e-6f;
constexpr float LOG2E = 1.4426950408889634f;
constexpr float QSCALE = 0.125f * LOG2E;
constexpr int NWAVES = 8;

constexpr size_t O_Y = 0;
constexpr size_t O_CONVP = (size_t)M * D;
constexpr size_t O_CONVS = O_CONVP + 65536;
constexpr size_t O_KP = O_CONVS + 65536;
constexpr size_t O_VP = O_KP + (size_t)NB * CROWS * D;
constexpr size_t O_KS = O_VP + (size_t)NB * CROWS * D;
constexpr size_t O_VS = O_KS + (size_t)MS * D;
constexpr size_t O_END = O_VS + (size_t)MS * D;

constexpr size_t MiB = 1u << 20;
constexpr size_t WS_WIN = 0, WS_WOUT = 6 * MiB, WS_WGU0 = 8 * MiB, WS_WGU1 = 19 * MiB, WS_WD0 = 30 * MiB, WS_WD1 = 30 * MiB + 5632 * 1024,
                 WS_WQKV = 41 * MiB, WS_WO = 47 * MiB, WS_KC = 50 * MiB, WS_VC = 82 * MiB;
constexpr size_t WS_XN = 128 * MiB, WS_A = 258 * MiB, WS_B = 388 * MiB, WS_C = 518 * MiB, WS_MO = 648 * MiB, WS_O = 778 * MiB, WS_END = 908 * MiB;

constexpr int LDS_BYTES = 131072 + 8192;

__device__ __forceinline__ float bf2f(unsigned short b) { return __uint_as_float(((unsigned)b) << 16); }
__device__ __forceinline__ float bflo(unsigned w) { return __uint_as_float(w << 16); }
__device__ __forceinline__ float bfhi(unsigned w) { return __uint_as_float(w & 0xffff0000u); }
__device__ __forceinline__ unsigned pk2(float lo, float hi) { return pg8::cvt_pk_bf16(lo, hi); }
__device__ __forceinline__ float wave_sum(float v) {
#pragma unroll
    for (int o = 1; o < 64; o <<= 1) v += __shfl_xor(v, o);
    return v;
}

namespace pg8 {
struct EpiConvIn {
    static constexpr bool PERM = true, AFTER_DRAIN = false;
    bf16_t* Bg; bf16_t* U;
    __device__ __forceinline__ void operator()(const f32x4 (&acc)[2][2][4][2], const Unit& u, int wr, int wc, int fr, int fq) const {
        const int row0 = u.pm * BM + wr * 64 + fr;
        if (u.pn < 4) {
            const int col0 = u.pn * BM + wc * 32 + 8 * fq;
#pragma unroll
            for (int ai = 0; ai < 2; ++ai)
#pragma unroll
                for (int m = 0; m < 4; ++m) { bf16_t* rowp = Bg + (size_t)(row0 + ai * HALF + m * 16) * 1024 + col0;
#pragma unroll
                    for (int bj = 0; bj < 2; ++bj) { const f32x4 v0 = acc[ai][bj][m][0], v1 = acc[ai][bj][m][1];
                        u32x4 w; w.x = cvt_pk_bf16(v0[0], v0[1]); w.y = cvt_pk_bf16(v0[2], v0[3]); w.z = cvt_pk_bf16(v1[0], v1[1]); w.w = cvt_pk_bf16(v1[2], v1[3]);
                        *(u32x4*)(rowp + bj * HALF) = w; } }
        } else {
            const int col0 = (u.pn - 4) * HALF + wc * 32 + 8 * fq;
#pragma unroll
            for (int ai = 0; ai < 2; ++ai)
#pragma unroll
                for (int m = 0; m < 4; ++m) { bf16_t* rowp = U + (size_t)(row0 + ai * HALF + m * 16) * 1024 + col0;
                    const f32x4 v0 = acc[ai][0][m][0] * acc[ai][1][m][0], v1 = acc[ai][0][m][1] * acc[ai][1][m][1];
                    u32x4 w; w.x = cvt_pk_bf16(v0[0], v0[1]); w.y = cvt_pk_bf16(v0[2], v0[3]); w.z = cvt_pk_bf16(v1[0], v1[1]); w.w = cvt_pk_bf16(v1[2], v1[3]);
                    *(u32x4*)(rowp) = w; }
        }
    }
};
struct EpiSwiGLU {
    static constexpr bool PERM = true, AFTER_DRAIN = false;
    bf16_t* H;
    __device__ __forceinline__ float act(float g, float uu) const { return g * uu * __builtin_amdgcn_rcpf(1.0f + __builtin_amdgcn_exp2f(-1.4426950408889634f * g)); }
    __device__ __forceinline__ void operator()(const f32x4 (&acc)[2][2][4][2], const Unit& u, int wr, int wc, int fr, int fq) const {
        const int row0 = u.pm * BM + wr * 64 + fr;
        const int col0 = u.pn * HALF + wc * 32 + 8 * fq;
#pragma unroll
        for (int ai = 0; ai < 2; ++ai)
#pragma unroll
            for (int m = 0; m < 4; ++m) { bf16_t* rowp = H + (size_t)(row0 + ai * HALF + m * 16) * 2816 + col0;
                const f32x4 g0 = acc[ai][0][m][0], g1 = acc[ai][0][m][1], u0 = acc[ai][1][m][0], u1 = acc[ai][1][m][1];
                u32x4 w; w.x = cvt_pk_bf16(act(g0[0], u0[0]), act(g0[1], u0[1])); w.y = cvt_pk_bf16(act(g0[2], u0[2]), act(g0[3], u0[3]));
                w.z = cvt_pk_bf16(act(g1[0], u1[0]), act(g1[1], u1[1])); w.w = cvt_pk_bf16(act(g1[2], u1[2]), act(g1[3], u1[3]));
                *(u32x4*)(rowp) = w; }
    }
};
}

template <int MODE> __device__ __forceinline__ int dest_row(int n) {
    if (MODE == 1) { const int hh = n / DFF, rem = n - hh * DFF; return ((rem >> 7) << 8) + (hh << 7) + (rem & 127); }
    if (MODE == 2) { if (n < 1024) return n; const int np = n - 1024, hh = np >> 10, rem = np & 1023; return 1024 + ((rem >> 7) << 8) + (hh << 7) + (rem & 127); }
    return n;
}
template <int MODE> __device__ __forceinline__ void transpose_item(const float* W, int K, int N, bf16_t* WT, LAS float* scr, int item, int lane) {
    const int nblk = N / 32, kb = item / nblk, nb = item % nblk, k0 = 64 * kb, n0 = 32 * nb;
#pragma unroll 8
    for (int i = 0; i < 32; ++i) { const int kk = 2 * i + (lane >> 5); scr[kk * 33 + (lane & 31)] = W[(size_t)(k0 + kk) * N + n0 + (lane & 31)]; }
    asm volatile("s_waitcnt lgkmcnt(0)" ::: "memory");
    const int c = lane & 7; const int drow = dest_row<MODE>(n0);
#pragma unroll
    for (int j = 0; j < 4; ++j) { const int n = (lane >> 3) + 8 * j; const LAS float* s = scr + (8 * c) * 33 + n;
        u32x4 o; o.x = pk2(s[0 * 33], s[1 * 33]); o.y = pk2(s[2 * 33], s[3 * 33]); o.z = pk2(s[4 * 33], s[5 * 33]); o.w = pk2(s[6 * 33], s[7 * 33]);
        *(u32x4*)(WT + (size_t)(drow + n) * K + k0 + 8 * c) = o; }
    asm volatile("s_waitcnt lgkmcnt(0)" ::: "memory");
}

__device__ __forceinline__ void norm_row(const float* xrow, const float* g, bf16_t* orow, int lane) {
    const f32x4* xr = (const f32x4*)xrow + lane; const f32x4* gr = (const f32x4*)g + lane;
    f32x4 v[4]; float s = 0.f;
#pragma unroll
    for (int j = 0; j < 4; ++j) { v[j] = xr[64 * j]; s += (v[j].x * v[j].x + v[j].y * v[j].y) + (v[j].z * v[j].z + v[j].w * v[j].w); }
    const float inv = 1.0f / sqrtf(wave_sum(s) * (1.f / D) + EPS);
    u32x2* o8 = (u32x2*)orow + lane;
#pragma unroll
    for (int j = 0; j < 4; ++j) { const f32x4 gg = gr[64 * j]; u32x2 w; w.x = pk2(v[j].x * inv * gg.x, v[j].y * inv * gg.y); w.y = pk2(v[j].z * inv * gg.z, v[j].w * inv * gg.w); o8[64 * j] = w; }
}
__device__ __forceinline__ void res_row(const bf16_t* mrow, const float* xin, const float* gp, float* xout, const float* gn, bf16_t* xnrow, int lane) {
    const u32x2* mr = (const u32x2*)mrow + lane; const f32x4* xr = (const f32x4*)xin + lane; const f32x4* gr = (const f32x4*)gp + lane;
    f32x4 mv[4], xv[4]; float s = 0.f;
#pragma unroll
    for (int j = 0; j < 4; ++j) { const u32x2 w = mr[64 * j]; mv[j] = (f32x4){bflo(w.x), bfhi(w.x), bflo(w.y), bfhi(w.y)}; xv[j] = xr[64 * j];
        s += (mv[j].x * mv[j].x + mv[j].y * mv[j].y) + (mv[j].z * mv[j].z + mv[j].w * mv[j].w); }
    const float inv = 1.0f / sqrtf(wave_sum(s) * (1.f / D) + EPS);
    float s2 = 0.f; f32x4* xo = (f32x4*)xout + lane;
#pragma unroll
    for (int j = 0; j < 4; ++j) { const f32x4 gg = gr[64 * j]; xv[j] = xv[j] + mv[j] * inv * gg; xo[64 * j] = xv[j];
        s2 += (xv[j].x * xv[j].x + xv[j].y * xv[j].y) + (xv[j].z * xv[j].z + xv[j].w * xv[j].w); }
    if (gn) {
        const float inv2 = 1.0f / sqrtf(wave_sum(s2) * (1.f / D) + EPS);
        const f32x4* g2 = (const f32x4*)gn + lane; u32x2* o8 = (u32x2*)xnrow + lane;
#pragma unroll
        for (int j = 0; j < 4; ++j) { const f32x4 gg = g2[64 * j]; u32x2 w; w.x = pk2(xv[j].x * inv2 * gg.x, xv[j].y * inv2 * gg.y); w.y = pk2(xv[j].z * inv2 * gg.z, xv[j].w * inv2 * gg.w); o8[64 * j] = w; }
    }
}

namespace att {
__device__ __forceinline__ int crow(int i, int h) { return (i & 3) + 8 * (i >> 2) + 4 * h; }
typedef short v4i16_t __attribute__((ext_vector_type(4)));
__device__ __forceinline__ s16x4 vtr(const LAS unsigned char* p) { return __builtin_bit_cast(s16x4, __builtin_amdgcn_ds_read_tr16_b64_v4i16((LAS v4i16_t*)p)); }
struct Item { const bf16_t* q; const bf16_t* kc; const bf16_t* vc; const bf16_t* kn; const bf16_t* vn; bf16_t* o; int nc, kt0, kt1, qpos0, head; };

__device__ __forceinline__ void load_tile(const Item& it, int kt, int lane, bf16x8 (&kf)[4], u32x4 (&vr)[4]) {
    const int r = lane & 31, h = lane >> 5;
    const bf16_t* kp = kt < it.nc ? it.kc + (size_t)kt * 32 * 1024 : it.kn + (size_t)(kt - it.nc) * 32 * 1024;
    const bf16_t* vp = kt < it.nc ? it.vc + (size_t)kt * 32 * 1024 : it.vn + (size_t)(kt - it.nc) * 32 * 1024;
#pragma unroll
    for (int s = 0; s < 4; ++s) kf[s] = *(const bf16x8*)(kp + (size_t)r * 1024 + 16 * s + 8 * h);
#pragma unroll
    for (int i = 0; i < 4; ++i) vr[i] = *(const u32x4*)(vp + (size_t)((lane >> 3) + 8 * i) * 1024 + (lane & 7) * 8);
}

__device__ __forceinline__ void attn_item(const Item& it, LAS unsigned char* vlds, LAS float* tab, const float* table, int lane) {
    const int r = lane & 31, h = lane >> 5;
    asm volatile("s_waitcnt lgkmcnt(0)" ::: "memory");
    for (int i = lane; i < 257; i += 64) tab[i] = table[it.head * 257 + i] * LOG2E;
    bf16x8 qf[4];
#pragma unroll
    for (int s = 0; s < 4; ++s) qf[s] = *(const bf16x8*)(it.q + (size_t)r * 1024 + 16 * s + 8 * h);
    f32x16 o0, o1;
#pragma unroll
    for (int i = 0; i < 16; ++i) { o0[i] = 0.f; o1[i] = 0.f; }
    float mrun = -1e30f, lrun = 0.f;
    asm volatile("s_waitcnt lgkmcnt(0)" ::: "memory");
    const float cfar = tab[256];
    const int qpos = it.qpos0 + r;
    const int i16 = lane & 15, q4 = i16 >> 2, p4 = i16 & 3, g = (lane >> 4) & 1;
    const LAS unsigned char* trbase = vlds + (4 * h + q4) * 128 + (16 * g + 4 * p4) * 2;
    bf16x8 kf[4]; u32x4 vr[4];
    load_tile(it, it.kt0, lane, kf, vr);
    for (int kt = it.kt0; kt < it.kt1; ++kt) {
        bf16x8 kn_[4]; u32x4 vn_[4];
        if (kt + 1 < it.kt1) load_tile(it, kt + 1, lane, kn_, vn_);
        else {
#pragma unroll
            for (int s = 0; s < 4; ++s) { kn_[s] = kf[s]; vn_[s] = vr[s]; }
        }
        asm volatile("s_waitcnt lgkmcnt(0)" ::: "memory");
#pragma unroll
        for (int i = 0; i < 4; ++i) *(LAS u32x4*)(vlds + ((lane >> 3) + 8 * i) * 128 + (lane & 7) * 16) = vr[i];
        f32x16 p;
#pragma unroll
        for (int i = 0; i < 16; ++i) p[i] = 0.f;
#pragma unroll
        for (int s = 0; s < 4; ++s) p = __builtin_amdgcn_mfma_f32_32x32x16_bf16(kf[s], qf[s], p, 0, 0, 0);
        const int kb = 32 * kt;
        if (it.qpos0 - (kb + 31) >= 128) {
#pragma unroll
            for (int i = 0; i < 16; ++i) p[i] += cfar;
        } else {
#pragma unroll
            for (int i = 0; i < 16; ++i) { int dd = qpos - (kb + crow(i, h)); dd = dd < -128 ? -128 : (dd > 128 ? 128 : dd); p[i] += tab[dd + 128]; }
        }
        float tm = p[0];
#pragma unroll
        for (int i = 1; i < 16; ++i) tm = fmaxf(tm, p[i]);
        tm = fmaxf(tm, __shfl_xor(tm, 32));
        const float mnew = fmaxf(mrun, tm);
        const float sc = __builtin_amdgcn_exp2f(mrun - mnew);
        mrun = mnew;
        float ps = 0.f;
#pragma unroll
        for (int i = 0; i < 16; ++i) { p[i] = __builtin_amdgcn_exp2f(p[i] - mnew); ps += p[i]; }
        lrun = lrun * sc + ps;
#pragma unroll
        for (int i = 0; i < 16; ++i) { o0[i] *= sc; o1[i] *= sc; }
        u32x4 w0, w1;
        w0.x = pk2(p[0], p[1]); w0.y = pk2(p[2], p[3]); w0.z = pk2(p[4], p[5]); w0.w = pk2(p[6], p[7]);
        w1.x = pk2(p[8], p[9]); w1.y = pk2(p[10], p[11]); w1.z = pk2(p[12], p[13]); w1.w = pk2(p[14], p[15]);
        const bf16x8 pf0 = __builtin_bit_cast(bf16x8, w0), pf1 = __builtin_bit_cast(bf16x8, w1);
        asm volatile("s_waitcnt lgkmcnt(0)" ::: "memory");
#pragma unroll
        for (int s = 0; s < 2; ++s) {
            const s16x4 a_lo = vtr(trbase + (16 * s) * 128), a_hi = vtr(trbase + (16 * s + 8) * 128);
            const s16x4 b_lo = vtr(trbase + (16 * s) * 128 + 64), b_hi = vtr(trbase + (16 * s + 8) * 128 + 64);
            const bf16x8 va = __builtin_shufflevector(a_lo, a_hi, 0, 1, 2, 3, 4, 5, 6, 7), vb = __builtin_shufflevector(b_lo, b_hi, 0, 1, 2, 3, 4, 5, 6, 7);
            o0 = __builtin_amdgcn_mfma_f32_32x32x16_bf16(va, s == 0 ? pf0 : pf1, o0, 0, 0, 0);
            o1 = __builtin_amdgcn_mfma_f32_32x32x16_bf16(vb, s == 0 ? pf0 : pf1, o1, 0, 0, 0);
        }
#pragma unroll
        for (int s = 0; s < 4; ++s) { kf[s] = kn_[s]; vr[s] = vn_[s]; }
    }
    lrun += __shfl_xor(lrun, 32);
    const float inv = 1.0f / lrun;
    bf16_t* orow = it.o + (size_t)r * 1024 + 4 * h;
#pragma unroll
    for (int g4 = 0; g4 < 4; ++g4) {
        u32x2 a, b;
        a.x = pk2(o0[4 * g4] * inv, o0[4 * g4 + 1] * inv); a.y = pk2(o0[4 * g4 + 2] * inv, o0[4 * g4 + 3] * inv);
        b.x = pk2(o1[4 * g4] * inv, o1[4 * g4 + 1] * inv); b.y = pk2(o1[4 * g4 + 2] * inv, o1[4 * g4 + 3] * inv);
        *(u32x2*)(orow + 8 * g4) = a; *(u32x2*)(orow + 32 + 8 * g4) = b;
    }
}
}

struct Args {
    const float *x_prompt, *x_sample, *state_conv, *cache_k, *cache_v, *conv_w_in, *conv_kernel, *conv_w_out, *attn_w_qkv, *attn_w_o, *attn_rel_bias,
        *norm_mix_pre, *norm_mix_post, *norm_ffn_pre, *norm_ffn_post, *ffn_w_gate_up, *ffn_w_down;
    float* out; unsigned char* ws;
};

__global__ void __launch_bounds__(NWAVES * 64, 2) fwd_kernel(Args a) {
    extern __shared__ __attribute__((aligned(16))) unsigned char lds_raw[];
    cg::grid_group grid = cg::this_grid();
    LAS unsigned char* lds = (LAS unsigned char*)lds_raw;
    const int tid = threadIdx.x, lane = tid & 63, wave = __builtin_amdgcn_readfirstlane(tid >> 6);
    const int G = gridDim.x, gw = blockIdx.x * NWAVES + wave, NGW = G * NWAVES;
    unsigned char* ws = a.ws;
    bf16_t* Win_t = (bf16_t*)(ws + WS_WIN); bf16_t* Wout_t = (bf16_t*)(ws + WS_WOUT);
    bf16_t* Wgu_t0 = (bf16_t*)(ws + WS_WGU0); bf16_t* Wgu_t1 = (bf16_t*)(ws + WS_WGU1);
    bf16_t* Wd_t0 = (bf16_t*)(ws + WS_WD0); bf16_t* Wd_t1 = (bf16_t*)(ws + WS_WD1);
    bf16_t* Wqkv_t = (bf16_t*)(ws + WS_WQKV); bf16_t* Wo_t = (bf16_t*)(ws + WS_WO);
    bf16_t* KC = (bf16_t*)(ws + WS_KC); bf16_t* VC = (bf16_t*)(ws + WS_VC);
    bf16_t* XN = (bf16_t*)(ws + WS_XN); bf16_t* BA = (bf16_t*)(ws + WS_A); bf16_t* BB = (bf16_t*)(ws + WS_B); bf16_t* BC = (bf16_t*)(ws + WS_C);
    bf16_t* MO = (bf16_t*)(ws + WS_MO); bf16_t* OB = (bf16_t*)(ws + WS_O); bf16_t* HB = BA;
    float* Y = a.out + O_Y;

    {
        LAS float* scr = (LAS float*)(lds + wave * 16384);
        constexpr int I_IN = 16 * 96, I_OUT = 16 * 32, I_GU = 16 * 176, I_D = 44 * 32;
        constexpr int NITEMS = 2 * I_IN + 2 * I_OUT + 2 * I_GU + 2 * I_D;
        for (int it = gw; it < NITEMS; it += NGW) {
            int r = it;
            if (r < I_IN) { transpose_item<2>(a.conv_w_in, D, 3 * D, Win_t, scr, r, lane); continue; } r -= I_IN;
            if (r < I_OUT) { transpose_item<0>(a.conv_w_out, D, D, Wout_t, scr, r, lane); continue; } r -= I_OUT;
            if (r < I_GU) { transpose_item<1>(a.ffn_w_gate_up, D, 2 * DFF, Wgu_t0, scr, r, lane); continue; } r -= I_GU;
            if (r < I_GU) { transpose_item<1>(a.ffn_w_gate_up + (size_t)D * 2 * DFF, D, 2 * DFF, Wgu_t1, scr, r, lane); continue; } r -= I_GU;
            if (r < I_D) { transpose_item<0>(a.ffn_w_down, DFF, D, Wd_t0, scr, r, lane); continue; } r -= I_D;
            if (r < I_D) { transpose_item<0>(a.ffn_w_down + (size_t)DFF * D, DFF, D, Wd_t1, scr, r, lane); continue; } r -= I_D;
            if (r < I_IN) { transpose_item<0>(a.attn_w_qkv, D, 3 * D, Wqkv_t, scr, r, lane); continue; } r -= I_IN;
            transpose_item<0>(a.attn_w_o, D, D, Wo_t, scr, r, lane);
        }
        {
            const size_t n8 = (size_t)DB * CROWS * D / 8; const size_t gt = (size_t)blockIdx.x * (NWAVES * 64) + tid, NT = (size_t)G * NWAVES * 64;
            for (size_t i = gt; i < 2 * n8; i += NT) {
                const float* src = i < n8 ? a.cache_k + i * 8 : a.cache_v + (i - n8) * 8; bf16_t* dst = i < n8 ? KC + i * 8 : VC + (i - n8) * 8;
                const f32x4 v0 = *(const f32x4*)src, v1 = *(const f32x4*)(src + 4);
                u32x4 w; w.x = pk2(v0.x, v0.y); w.y = pk2(v0.z, v0.w); w.z = pk2(v1.x, v1.y); w.w = pk2(v1.z, v1.w);
                *(u32x4*)dst = w;
            }
        }
        for (int m = gw; m < M; m += NGW) { const float* xr = m < MP ? a.x_prompt + (size_t)m * D : a.x_sample + (size_t)(m - MP) * D; norm_row(xr, a.norm_mix_pre, XN + (size_t)m * D, lane); }
    }
    grid.sync();
    { pg8::Gemm g{XN, Win_t, M, 3 * D, D}; pg8::StaticOrder S; S.init(M, 3 * D, G, (int)blockIdx.x); pg8::EpiConvIn E{BA, BB};
      pg8::gemm_phase<pg8::EpiConvIn, pg8::StaticOrder, true, true>(lds, g, S, E); }
    grid.sync();
    for (int m = gw; m < M; m += NGW) {
        const bool samp = m >= MP; const int t = samp ? ((m - MP) & 31) : (m & 2047); const int b = samp ? ((m - MP) >> 5) : (m >> 11); const int T = samp ? DS : SEQ;
        const u32x2* u0p = (const u32x2*)(BB + (size_t)m * D) + lane; const u32x2* bgp = (const u32x2*)(BA + (size_t)m * D) + lane;
        const f32x4* w0 = (const f32x4*)a.conv_kernel + lane; const f32x4* w1 = w0 + 256; const f32x4* w2 = w0 + 512;
        const float* st = a.state_conv + (size_t)b * 2 * D;
        u32x2* yo = (u32x2*)(BC + (size_t)m * D) + lane;
        float* so = nullptr;
        if (t >= T - 2) so = a.out + (samp ? O_CONVS : O_CONVP) + ((size_t)b * 2 + (t - (T - 2))) * D;
#pragma unroll
        for (int j = 0; j < 4; ++j) {
            const u32x2 uw = u0p[64 * j]; const f32x4 u0 = (f32x4){bflo(uw.x), bfhi(uw.x), bflo(uw.y), bfhi(uw.y)};
            f32x4 u1 = (f32x4){0.f, 0.f, 0.f, 0.f}, u2 = u1;
            if (t >= 1) { const u32x2 w = u0p[64 * j - 256]; u1 = (f32x4){bflo(w.x), bfhi(w.x), bflo(w.y), bfhi(w.y)}; }
            else if (samp) u1 = *((const f32x4*)(st + D) + lane + 64 * j);
            if (t >= 2) { const u32x2 w = u0p[64 * j - 512]; u2 = (f32x4){bflo(w.x), bfhi(w.x), bflo(w.y), bfhi(w.y)}; }
            else if (samp) u2 = *((const f32x4*)(st + (t == 1 ? D : 0)) + lane + 64 * j);
            const u32x2 bw = bgp[64 * j]; const f32x4 bg = (f32x4){bflo(bw.x), bfhi(bw.x), bflo(bw.y), bfhi(bw.y)};
            const f32x4 y = bg * (w0[64 * j] * u2 + w1[64 * j] * u1 + w2[64 * j] * u0);
            u32x2 o; o.x = pk2(y.x, y.y); o.y = pk2(y.z, y.w); yo[64 * j] = o;
            if (so) *((f32x4*)so + lane + 64 * j) = u0;
        }
    }
    grid.sync();
    { pg8::Gemm g{BC, Wout_t, M, D, D}; pg8::StaticOrder S; S.init(M, D, G, (int)blockIdx.x); pg8::EpiBf16<0> E{MO, D, nullptr, 0, 0, 1.f};
      pg8::gemm_phase<pg8::EpiBf16<0>, pg8::StaticOrder, true, true>(lds, g, S, E); }
    grid.sync();
    for (int m = gw; m < M; m += NGW) { const float* xr = m < MP ? a.x_prompt + (size_t)m * D : a.x_sample + (size_t)(m - MP) * D;
        res_row(MO + (size_t)m * D, xr, a.norm_mix_post, Y + (size_t)m * D, a.norm_ffn_pre, XN + (size_t)m * D, lane); }
    grid.sync();
    { pg8::Gemm g{XN, Wgu_t0, M, 2 * DFF, D}; pg8::StaticOrder S; S.init(M, 2 * DFF, G, (int)blockIdx.x); pg8::EpiSwiGLU E{HB};
      pg8::gemm_phase<pg8::EpiSwiGLU, pg8::StaticOrder, true, true>(lds, g, S, E); }
    grid.sync();
    { pg8::Gemm g{HB, Wd_t0, M, D, DFF}; pg8::StaticOrder S; S.init(M, D, G, (int)blockIdx.x); pg8::EpiBf16<0> E{MO, D, nullptr, 0, 0, 1.f};
      pg8::gemm_phase<pg8::EpiBf16<0>, pg8::StaticOrder, true, true>(lds, g, S, E); }
    grid.sync();
    for (int m = gw; m < M; m += NGW) res_row(MO + (size_t)m * D, Y + (size_t)m * D, a.norm_ffn_post, Y + (size_t)m * D, a.norm_mix_pre + D, XN + (size_t)m * D, lane);
    grid.sync();
    { pg8::Gemm g{XN, Wqkv_t, M, 3 * D, D}; pg8::StaticOrder S; S.init(M, 3 * D, G, (int)blockIdx.x);
      pg8::EpiBf16<0> E{BA, D, nullptr, D, (size_t)(WS_B - WS_A) / 2, QSCALE};
      pg8::gemm_phase<pg8::EpiBf16<0>, pg8::StaticOrder, true, true>(lds, g, S, E); }
    grid.sync();
    {
        for (int i = gw; i < 2 * (NB * CROWS + MS); i += NGW) {
            const int kv = i >= (NB * CROWS + MS); const int j = kv ? i - (NB * CROWS + MS) : i;
            size_t srow; float* dst;
            if (j < NB * CROWS) { srow = (size_t)(j >> 9) * SEQ + (SEQ - CROWS) + (j & 511); dst = a.out + (kv ? O_VP : O_KP) + (size_t)j * D; }
            else { srow = (size_t)MP + (j - NB * CROWS); dst = a.out + (kv ? O_VS : O_KS) + (size_t)(j - NB * CROWS) * D; }
            const u32x2* sp = (const u32x2*)((kv ? BC : BB) + srow * D) + lane;
#pragma unroll
            for (int jj = 0; jj < 4; ++jj) { const u32x2 w = sp[64 * jj]; *((f32x4*)dst + lane + 64 * jj) = (f32x4){bflo(w.x), bfhi(w.x), bflo(w.y), bfhi(w.y)}; }
        }
        LAS unsigned char* vlds = lds + wave * 4096; LAS float* tab = (LAS float*)(lds + 32768 + wave * 1088);
        constexpr int NGP = NB * NH * 8, NGS = (DB * NH) / 8;
        for (int gi = blockIdx.x; gi < NGP + NGS; gi += G) {
            att::Item it;
            if (gi < NGP) {
                const int bh = gi >> 3, c = (gi & 7) * 4 + (wave >> 1), half = wave & 1, b = bh >> 4, hh = bh & 15;
                const size_t rb = (size_t)b * SEQ;
                it.q = BA + (rb + 64 * c + 32 * half) * D + hh * HD; it.o = OB + (rb + 64 * c + 32 * half) * D + hh * HD;
                it.kc = BB + rb * D + hh * HD; it.vc = BC + rb * D + hh * HD; it.kn = it.kc; it.vn = it.vc; it.nc = 1 << 28;
                it.kt0 = (2 * c - 16) > 0 ? (2 * c - 16) : 0; it.kt1 = 2 * c + 2; it.qpos0 = 64 * c + 32 * half; it.head = hh;
            } else {
                const int si = (gi - NGP) * 8 + wave, b = si >> 4, hh = si & 15;
                const size_t rb = (size_t)MP + (size_t)b * DS;
                it.q = BA + rb * D + hh * HD; it.o = OB + rb * D + hh * HD;
                it.kc = KC + (size_t)b * CROWS * D + hh * HD; it.vc = VC + (size_t)b * CROWS * D + hh * HD; it.kn = BB + rb * D + hh * HD; it.vn = BC + rb * D + hh * HD; it.nc = CROWS / 32;
                it.kt0 = 0; it.kt1 = CROWS / 32 + 1; it.qpos0 = CROWS; it.head = hh;
            }
            att::attn_item(it, vlds, tab, a.attn_rel_bias, lane);
        }
    }
    grid.sync();
    { pg8::Gemm g{OB, Wo_t, M, D, D}; pg8::StaticOrder S; S.init(M, D, G, (int)blockIdx.x); pg8::EpiBf16<0> E{MO, D, nullptr, 0, 0, 1.f};
      pg8::gemm_phase<pg8::EpiBf16<0>, pg8::StaticOrder, true, true>(lds, g, S, E); }
    grid.sync();
    for (int m = gw; m < M; m += NGW) res_row(MO + (size_t)m * D, Y + (size_t)m * D, a.norm_mix_post + D, Y + (size_t)m * D, a.norm_ffn_pre + D, XN + (size_t)m * D, lane);
    grid.sync();
    { pg8::Gemm g{XN, Wgu_t1, M, 2 * DFF, D}; pg8::StaticOrder S; S.init(M, 2 * DFF, G, (int)blockIdx.x); pg8::EpiSwiGLU E{HB};
      pg8::gemm_phase<pg8::EpiSwiGLU, pg8::StaticOrder, true, true>(lds, g, S, E); }
    grid.sync();
    { pg8::Gemm g{HB, Wd_t1, M, D, DFF}; pg8::StaticOrder S; S.init(M, D, G, (int)blockIdx.x); pg8::EpiBf16<0> E{MO, D, nullptr, 0, 0, 1.f};
      pg8::gemm_phase<pg8::EpiBf16<0>, pg8::StaticOrder, true, true>(lds, g, S, E); }
    grid.sync();
    for (int m = gw; m < M; m += NGW) res_row(MO + (size_t)m * D, Y + (size_t)m * D, a.norm_ffn_post + D, Y + (size_t)m * D, nullptr, nullptr, lane);
}

extern "C" void kernel_launch(void* const* d_in, const int* in_sizes, int n_in, void* d_out, int out_size, void* d_ws, size_t ws_size, hipStream_t stream) {
    static int grid = 0;
    if (grid == 0) {
        if (n_in != 17 || (size_t)out_size != O_END || ws_size < WS_END) { fprintf(stderr, "kernel_launch: unexpected shapes n_in %d out %d ws %zu\n", n_in, out_size, ws_size); grid = -1; return; }
        int dev = 0, cus = 0, per_cu = 0;
        hipGetDevice(&dev); hipDeviceGetAttribute(&cus, hipDeviceAttributeMultiprocessorCount, dev);
        if (hipFuncSetAttribute((const void*)fwd_kernel, hipFuncAttributeMaxDynamicSharedMemorySize, LDS_BYTES) != hipSuccess) { fprintf(stderr, "kernel_launch: hipFuncSetAttribute failed\n"); grid = -1; return; }
        if (hipOccupancyMaxActiveBlocksPerMultiprocessor(&per_cu, (const void*)fwd_kernel, NWAVES * 64, LDS_BYTES) != hipSuccess || per_cu < 1) { fprintf(stderr, "kernel_launch: occupancy query says %d\n", per_cu); per_cu = 1; }
        (void)hipGetLastError();
        grid = cus;
    }
    if (grid < 0) return;
    Args a{};
    const float** p = (const float**)&a;
    for (int i = 0; i < 17; ++i) p[i] = (const float*)d_in[i];
    a.out = (float*)d_out; a.ws = (unsigned char*)d_ws;
    void* args[] = {&a};
    hipError_t e = hipLaunchCooperativeKernel((const void*)fwd_kernel, dim3(grid), dim3(NWAVES * 64), args, LDS_BYTES, stream);
    if (e != hipSuccess) fprintf(stderr, "cooperative launch failed: %s (grid %d)\n", hipGetErrorString(e), grid);
}
```

```cpp
#include <hip/hip_runtime.h>
#include <hip/hip_cooperative_groups.h>
#include <cstdio>
#include <cstdint>
namespace cg = cooperative_groups;
namespace pg8 {
#define PG8_LAS __attribute__((address_space(3)))
typedef unsigned short bf16_t;
typedef short bf16x8 __attribute__((ext_vector_type(8)));
typedef float f32x4 __attribute__((ext_vector_type(4)));
typedef unsigned u32x4 __attribute__((ext_vector_type(4)));
constexpr int BM = 256, BK = 64, HALF = 128, HTB = HALF * BK * 2  , STAGE_BYTES = 8 * HTB, NXCD = 8, WGM = 8;

__host__ __device__ __forceinline__ int lds_byte(int r, int c) { const int st = (r >> 4) * 2 + (c >> 5), rr = r & 15, cc = c & 31, ob = rr * 64 + cc * 2; return st * 1024 + (ob ^ (((ob >> 9) & 1) << 5)); }
__host__ __device__ __forceinline__ void stage_rc(int b, int& R, int& C) { const int st = b / 1024, sb = b % 1024, swz = sb ^ (((sb >> 9) & 1) << 5); R = (st >> 1) * 16 + swz / 64; C = (st & 1) * 32 + (swz % 64) / 2; }
__host__ __device__ __forceinline__ int perm32(int rho) { const int n = rho >> 4, i = rho & 15; return 8 * (i >> 2) + 4 * n + (i & 3); }

struct Unit { int pm, pn; };
struct Gemm { const bf16_t* A; const bf16_t* Bt; int M, N, K; };

struct StaticOrder {
    int nM, nN, nwg, G, c;
    __host__ __device__ void init(int M, int N, int G_, int c_) { nM = M / BM; nN = N / BM; nwg = nM * nN; G = G_; c = c_; }
    __host__ __device__ bool next(int i, Unit& u) const {
        const long L = (long)i * G + c; if (L >= nwg) return false;
        int wgid = (int)L; { const int q = nwg / NXCD, r = nwg % NXCD, xcd = wgid % NXCD, off = wgid / NXCD; wgid = (xcd < r ? xcd * (q + 1) : r * (q + 1) + (xcd - r) * q) + off; }
        const int nig = WGM * nN, gid = wgid / nig, fm = gid * WGM, gsz = (nM - fm) < WGM ? (nM - fm) : WGM;
        u.pm = fm + ((wgid % nig) % gsz); u.pn = (wgid % nig) / gsz; return true;
    }
    __device__ __forceinline__ void a_ready(const Unit&) const {}
    __device__ __forceinline__ void done(const Unit&) const {}
};

__device__ __forceinline__ unsigned cvt_pk_bf16(float lo, float hi) { unsigned r; asm volatile("v_cvt_pk_bf16_f32 %0, %1, %2" : "=v"(r) : "v"(lo), "v"(hi)); return r; }
typedef float f32x2 __attribute__((ext_vector_type(2)));
__device__ __forceinline__ f32x2 gelu_pk(f32x2 v) {
    const f32x2 av = __builtin_elementwise_abs(v), d = av * 0.2316418882f + 1.0f;
    f32x2 t; t.x = __builtin_amdgcn_rcpf(d.x); t.y = __builtin_amdgcn_rcpf(d.y);
    f32x2 q = t * 0.5307027145f + (-0.7265760135f); q = q * t + 0.7107068705f; q = q * t + (-0.142248368f); q = q * t + 0.127414796f; q = q * t;
    const f32x2 s = (v * v) * (-0.72134752044f);
    f32x2 e; e.x = __builtin_amdgcn_exp2f(s.x); e.y = __builtin_amdgcn_exp2f(s.y);
    const f32x2 m = v * (q * e), r = v - m;
    f32x2 o; o.x = v.x < 0.f ? m.x : r.x; o.y = v.y < 0.f ? m.y : r.y; return o;
}

template <int ACT  > struct EpiBf16 {
    static constexpr bool PERM = true, AFTER_DRAIN = false; static_assert(ACT == 0 || ACT == 1, "EpiBf16: ACT is 0 (none) or 1 (gelu_pk)");
    bf16_t* O; int ldc; const float* bias; int split_cols; size_t split_stride; float scale0;
    __device__ __forceinline__ void operator()(const f32x4 (&acc)[2][2][4][2], const Unit& u, int wr, int wc, int fr, int fq) const {
        const int row0 = u.pm * BM + wr * 64 + fr; int colt = u.pn * BM; bf16_t* base = O;
        float sc = 1.f; if (split_cols) { const int t = colt / split_cols; base += (size_t)t * split_stride; colt -= t * split_cols; if (t == 0) sc = scale0; }
        const int col0 = colt + wc * 32 + 8 * fq, bcol0 = u.pn * BM + wc * 32 + 8 * fq;
        f32x4 bv[2][2];
#pragma unroll
        for (int bj = 0; bj < 2; ++bj)
#pragma unroll
            for (int n = 0; n < 2; ++n) bv[bj][n] = bias ? *(const f32x4*)(bias + bcol0 + bj * HALF + 4 * n) : (f32x4){0.f, 0.f, 0.f, 0.f};
#pragma unroll
        for (int ai = 0; ai < 2; ++ai)
#pragma unroll
            for (int m = 0; m < 4; ++m) { bf16_t* rowp = base + (size_t)(row0 + ai * HALF + m * 16) * ldc + col0;
#pragma unroll
                for (int bj = 0; bj < 2; ++bj) { f32x4 v0 = acc[ai][bj][m][0] + bv[bj][0], v1 = acc[ai][bj][m][1] + bv[bj][1];
                    if (ACT == 1) { f32x2 a = gelu_pk((f32x2){v0[0], v0[1]}), b = gelu_pk((f32x2){v0[2], v0[3]}), c = gelu_pk((f32x2){v1[0], v1[1]}), d = gelu_pk((f32x2){v1[2], v1[3]});
                        v0 = (f32x4){a.x, a.y, b.x, b.y}; v1 = (f32x4){c.x, c.y, d.x, d.y}; }
                    v0 = v0 * sc; v1 = v1 * sc; u32x4 w; w.x = cvt_pk_bf16(v0[0], v0[1]); w.y = cvt_pk_bf16(v0[2], v0[3]); w.z = cvt_pk_bf16(v1[0], v1[1]); w.w = cvt_pk_bf16(v1[2], v1[3]);
                    *(u32x4*)(rowp + bj * HALF) = w; } }
    }
};
template <class Epi, class Sched, bool ALIGN_EPI = false, bool SP2 = false>
__device__ __forceinline__ void gemm_phase(PG8_LAS unsigned char* lds, const Gemm g, const Sched& S, const Epi& E) {
    const int tid = threadIdx.x, wid = __builtin_amdgcn_readfirstlane(tid >> 6), lane = tid & 63, wr = wid >> 2, wc = wid & 3, fr = lane & 15, fq = lane >> 4;
    const int K = g.K, nt = K / BK;
    unsigned voffA[2], voffB[2];
#pragma unroll
    for (int i = 0; i < 2; ++i) { int R, C; stage_rc(tid * 16 + i * 8192, R, C); const int Rb = Epi::PERM ? ((R & ~31) + perm32(R & 31)) : R;
        voffA[i] = (unsigned)(R * K + C) * 2u; voffB[i] = (unsigned)(Rb * K + C) * 2u; }
    const size_t kstep = (size_t)(BK * 2);
    const size_t hstep = (size_t)HALF * K * 2;
    const size_t tstep = 2 * hstep;
    const unsigned ldsw = (unsigned)wid * 1024u;
    const int aoff = lds_byte(wr * 64 + fr, fq * 8), boff = lds_byte(wc * 32 + fr, fq * 8);
#define PG8_SA(b, h) (((b) * 2 + (h)) * HTB)
#define PG8_SB(b, h) ((4 + (b) * 2 + (h)) * HTB)
#define PG8_STAGE(bufoff, gbase, voff) do { _Pragma("unroll") for (int _i = 0; _i < 2; ++_i) \
        __builtin_amdgcn_global_load_lds((const unsigned*)((const char*)(gbase) + (voff)[_i]), (PG8_LAS unsigned*)(lds + (bufoff) + ldsw + _i * 8192), 16, 0, 0); } while (0)
#define PG8_LDA(dst, b, h) do { _Pragma("unroll") for (int m = 0; m < 4; ++m) _Pragma("unroll") for (int k = 0; k < 2; ++k) dst[m][k] = *(const PG8_LAS bf16x8*)(lds + PG8_SA(b, h) + aoff + m * 2048 + k * 1024); } while (0)
#define PG8_LDB(dst, b, h) do { _Pragma("unroll") for (int n = 0; n < 2; ++n) _Pragma("unroll") for (int k = 0; k < 2; ++k) dst[n][k] = *(const PG8_LAS bf16x8*)(lds + PG8_SB(b, h) + boff + n * 2048 + k * 1024); } while (0)
#define PG8_MMA(ai, bj, At, Bt) do { __builtin_amdgcn_s_setprio(1); _Pragma("unroll") for (int m = 0; m < 4; ++m) _Pragma("unroll") for (int n = 0; n < 2; ++n) _Pragma("unroll") for (int k = 0; k < 2; ++k) \
        acc[ai][bj][m][n] = __builtin_amdgcn_mfma_f32_16x16x32_bf16(Bt[n][k], At[m][k], acc[ai][bj][m][n], 0, 0, 0); __builtin_amdgcn_s_setprio(0); } while (0)
#define PG8_WAIT_V(n) asm volatile("s_waitcnt vmcnt(" #n ")" ::: "memory")
#define PG8_WAIT_L(n) asm volatile("s_waitcnt lgkmcnt(" #n ")" ::: "memory")
#define PG8_BAR __builtin_amdgcn_s_barrier()
#define PG8_SCHED __builtin_amdgcn_sched_barrier(0)
    Unit cur, nxt; int ui = 0;
    if (!S.next(0, cur)) return;
    f32x4 acc[2][2][4][2];
#pragma unroll
    for (int a = 0; a < 2; ++a)
#pragma unroll
        for (int b = 0; b < 2; ++b)
#pragma unroll
            for (int m = 0; m < 4; ++m)
#pragma unroll
                for (int n = 0; n < 2; ++n) acc[a][b][m][n] = (f32x4){0.f, 0.f, 0.f, 0.f};
    bf16x8 At[4][2], B0[2][2], B1[2][2];
    const char* cA = (const char*)g.A + (size_t)cur.pm * tstep; const char* cB = (const char*)g.Bt + (size_t)cur.pn * tstep;
    S.a_ready(cur);
    if constexpr (SP2) {
        PG8_STAGE(PG8_SB(0, 0), cB, voffB); PG8_STAGE(PG8_SB(0, 1), cB + hstep, voffB); PG8_STAGE(PG8_SA(0, 0), cA, voffA); PG8_STAGE(PG8_SA(0, 1), cA + hstep, voffA);
        if (wr == 1) PG8_BAR;
        PG8_WAIT_V(2); PG8_BAR;
        PG8_STAGE(PG8_SB(1, 0), cB + kstep, voffB); PG8_STAGE(PG8_SA(1, 0), cA + kstep, voffA); PG8_STAGE(PG8_SB(1, 1), cB + hstep + kstep, voffB);
        PG8_WAIT_V(6); PG8_BAR;
    } else {
        PG8_STAGE(PG8_SB(0, 0), cB, voffB); PG8_STAGE(PG8_SA(0, 0), cA, voffA); PG8_STAGE(PG8_SB(0, 1), cB + hstep, voffB); PG8_STAGE(PG8_SA(0, 1), cA + hstep, voffA);
        if (wr == 1) PG8_BAR;
        PG8_WAIT_V(4); PG8_BAR;
        PG8_STAGE(PG8_SB(1, 0), cB + kstep, voffB); PG8_STAGE(PG8_SA(1, 0), cA + kstep, voffA); PG8_STAGE(PG8_SB(1, 1), cB + hstep + kstep, voffB);
        PG8_WAIT_V(6); PG8_BAR;
    }
    for (;;) {
        const bool has_next = S.next(ui + 1, nxt);
        const char* nA = has_next ? (const char*)g.A + (size_t)nxt.pm * tstep : cA; const char* nB = has_next ? (const char*)g.Bt + (size_t)nxt.pn * tstep : cB;
        for (int t = 0; t < nt; t += 2) {
            const bool last = (t == nt - 2);
            const char* a1 = cA + (size_t)(t + 1) * kstep;
            const char* a2 = last ? nA : cA + (size_t)(t + 2) * kstep; const char* b2 = last ? nB : cB + (size_t)(t + 2) * kstep;
            const char* a3 = a2 + kstep; const char* b3 = b2 + kstep;
            if (last && has_next) S.a_ready(nxt);
            if constexpr (SP2) {
            PG8_LDB(B0, 0, 0); PG8_LDB(B1, 0, 1); PG8_SCHED; PG8_LDA(At, 0, 0); PG8_STAGE(PG8_SA(1, 1), a1 + hstep, voffA);
            PG8_WAIT_V(8); PG8_WAIT_L(0); PG8_BAR; PG8_MMA(0, 0, At, B0); PG8_MMA(0, 1, At, B1); PG8_BAR; PG8_SCHED;
            PG8_LDA(At, 0, 1); PG8_STAGE(PG8_SB(0, 0), b2, voffB); PG8_STAGE(PG8_SB(0, 1), b2 + hstep, voffB); PG8_STAGE(PG8_SA(0, 0), a2, voffA);
            PG8_WAIT_V(8); PG8_WAIT_L(0); PG8_BAR; PG8_MMA(1, 0, At, B0); PG8_MMA(1, 1, At, B1); PG8_BAR; PG8_SCHED;
            PG8_LDB(B0, 1, 0); PG8_LDB(B1, 1, 1); PG8_SCHED; PG8_LDA(At, 1, 0); PG8_STAGE(PG8_SA(0, 1), a2 + hstep, voffA);
            PG8_WAIT_V(8); PG8_WAIT_L(0); PG8_BAR; PG8_MMA(0, 0, At, B0); PG8_MMA(0, 1, At, B1); PG8_BAR; PG8_SCHED;
            PG8_LDA(At, 1, 1); PG8_STAGE(PG8_SB(1, 0), b3, voffB); PG8_STAGE(PG8_SB(1, 1), b3 + hstep, voffB); PG8_STAGE(PG8_SA(1, 0), a3, voffA);
            PG8_WAIT_V(8); PG8_WAIT_L(0); PG8_BAR; PG8_MMA(1, 0, At, B0); PG8_MMA(1, 1, At, B1); PG8_BAR; PG8_SCHED;
            } else {
            PG8_LDB(B0, 0, 0); PG8_SCHED; PG8_LDA(At, 0, 0); PG8_STAGE(PG8_SA(1, 1), a1 + hstep, voffA);
            PG8_WAIT_L(8); PG8_BAR; PG8_WAIT_L(0); PG8_MMA(0, 0, At, B0); PG8_BAR; PG8_SCHED;
            PG8_LDB(B1, 0, 1); PG8_STAGE(PG8_SB(0, 0), b2, voffB);
            PG8_BAR; PG8_WAIT_L(0); PG8_MMA(0, 1, At, B1); PG8_BAR;
            PG8_LDA(At, 0, 1); PG8_STAGE(PG8_SA(0, 0), a2, voffA);
            PG8_BAR; PG8_WAIT_L(0); PG8_MMA(1, 0, At, B0); PG8_BAR; PG8_SCHED;
            PG8_STAGE(PG8_SB(0, 1), b2 + hstep, voffB);
            PG8_WAIT_V(6); PG8_BAR; PG8_MMA(1, 1, At, B1); PG8_BAR;
            PG8_LDB(B0, 1, 0); PG8_SCHED; PG8_LDA(At, 1, 0); PG8_STAGE(PG8_SA(0, 1), a2 + hstep, voffA);
            PG8_WAIT_L(8); PG8_BAR; PG8_WAIT_L(0); PG8_MMA(0, 0, At, B0); PG8_BAR; PG8_SCHED;
            PG8_LDB(B1, 1, 1); PG8_STAGE(PG8_SB(1, 0), b3, voffB);
            PG8_BAR; PG8_WAIT_L(0); PG8_MMA(0, 1, At, B1); PG8_BAR;
            PG8_LDA(At, 1, 1); PG8_STAGE(PG8_SA(1, 0), a3, voffA);
            PG8_BAR; PG8_WAIT_L(0); PG8_MMA(1, 0, At, B0); PG8_BAR; PG8_SCHED;
            PG8_STAGE(PG8_SB(1, 1), b3 + hstep, voffB);
            PG8_WAIT_V(6); PG8_BAR; PG8_MMA(1, 1, At, B1); PG8_BAR;
            }
        }
        if constexpr (ALIGN_EPI) { if (wr == 0) PG8_BAR; }
        if constexpr (!Epi::AFTER_DRAIN) { E(acc, cur, wr, wc, fr, fq); S.done(cur); }
        if (!has_next) break;
#pragma unroll
        for (int a = 0; a < 2; ++a)
#pragma unroll
            for (int b = 0; b < 2; ++b)
#pragma unroll
                for (int m = 0; m < 4; ++m)
#pragma unroll
                    for (int n = 0; n < 2; ++n) acc[a][b][m][n] = (f32x4){0.f, 0.f, 0.f, 0.f};
        cur = nxt; cA = nA; cB = nB; ++ui;
        if constexpr (ALIGN_EPI) { if (wr == 1) PG8_BAR; }
    }
    PG8_WAIT_V(0);
    if constexpr (!ALIGN_EPI) { if (wr == 0) PG8_BAR; }
    PG8_BAR;
    if constexpr (Epi::AFTER_DRAIN) { E.fused(acc, cur, wr, wc, fr, fq, lds, wid, lane); S.done(cur); }
#undef PG8_SA
#undef PG8_SB
#undef PG8_STAGE
#undef PG8_LDA
#undef PG8_LDB
#undef PG8_MMA
#undef PG8_WAIT_V
#undef PG8_WAIT_L
#undef PG8_BAR
#undef PG8_SCHED
}
}

#define LAS __attribute__((address_space(3)))
typedef unsigned short bf16_t;
typedef unsigned u32x4 __attribute__((ext_vector_type(4)));
typedef unsigned u32x2 __attribute__((ext_vector_type(2)));
typedef float f32x4 __attribute__((ext_vector_type(4)));
typedef float f32x16 __attribute__((ext_vector_type(16)));
typedef short bf16x8 __attribute__((ext_vector_type(8)));
typedef short s16x4 __attribute__((ext_vector_type(4)));

constexpr int D = 1024, NB = 32, SEQ = 2048, DB = 32, DS = 32, NH = 16, HD = 64, DFF = 2816;
constexpr int MP = NB * SEQ;
constexpr int MS = DB * DS;
constexpr int M = MP + MS;
constexpr int CROWS = 512;
constexpr float EPS = 1e-6f;
constexpr float LOG2E = 1.4426950408889634f;
constexpr float QSCALE = 0.125f * LOG2E;
constexpr int NWAVES = 8;

constexpr size_t O_Y = 0;
constexpr size_t O_CONVP = (size_t)M * D;
constexpr size_t O_CONVS = O_CONVP + 65536;
constexpr size_t O_KP = O_CONVS + 65536;
constexpr size_t O_VP = O_KP + (size_t)NB * CROWS * D;
constexpr size_t O_KS = O_VP + (size_t)NB * CROWS * D;
constexpr size_t O_VS = O_KS + (size_t)MS * D;
constexpr size_t O_END = O_VS + (size_t)MS * D;

constexpr size_t MiB = 1u << 20;
constexpr size_t WS_WIN = 0, WS_WOUT = 6 * MiB, WS_WGU0 = 8 * MiB, WS_WGU1 = 19 * MiB, WS_WD0 = 30 * MiB, WS_WD1 = 30 * MiB + 5632 * 1024,
                 WS_WQKV = 41 * MiB, WS_WO = 47 * MiB, WS_KC = 50 * MiB, WS_VC = 82 * MiB, WS_CTL = 120 * MiB;
constexpr size_t WS_XN = 128 * MiB, WS_A = 258 * MiB, WS_B = 388 * MiB, WS_C = 518 * MiB, WS_MO = 648 * MiB, WS_O = 128 * MiB  , WS_XR = 778 * MiB, WS_END = 908 * MiB;

constexpr int LDS_BYTES = 131072 + 8192;

__device__ __forceinline__ float bf2f(unsigned short b) { return __uint_as_float(((unsigned)b) << 16); }
__device__ __forceinline__ float bflo(unsigned w) { return __uint_as_float(w << 16); }
__device__ __forceinline__ float bfhi(unsigned w) { return __uint_as_float(w & 0xffff0000u); }
__device__ __forceinline__ unsigned pk2(float lo, float hi) { return pg8::cvt_pk_bf16(lo, hi); }
__device__ __forceinline__ float wave_sum(float v) {
#pragma unroll
    for (int o = 1; o < 64; o <<= 1) v += __shfl_xor(v, o);
    return v;
}

namespace pg8 {
struct EpiConvIn {
    static constexpr bool PERM = true, AFTER_DRAIN = false;
    bf16_t* Bg; bf16_t* U;
    __device__ __forceinline__ void operator()(const f32x4 (&acc)[2][2][4][2], const Unit& u, int wr, int wc, int fr, int fq) const {
        const int row0 = u.pm * BM + wr * 64 + fr;
        if (u.pn < 4) {
            const int col0 = u.pn * BM + wc * 32 + 8 * fq;
#pragma unroll
            for (int ai = 0; ai < 2; ++ai)
#pragma unroll
                for (int m = 0; m < 4; ++m) { bf16_t* rowp = Bg + (size_t)(row0 + ai * HALF + m * 16) * 1024 + col0;
#pragma unroll
                    for (int bj = 0; bj < 2; ++bj) { const f32x4 v0 = acc[ai][bj][m][0], v1 = acc[ai][bj][m][1];
                        u32x4 w; w.x = cvt_pk_bf16(v0[0], v0[1]); w.y = cvt_pk_bf16(v0[2], v0[3]); w.z = cvt_pk_bf16(v1[0], v1[1]); w.w = cvt_pk_bf16(v1[2], v1[3]);
                        *(u32x4*)(rowp + bj * HALF) = w; } }
        } else {
            const int col0 = (u.pn - 4) * HALF + wc * 32 + 8 * fq;
#pragma unroll
            for (int ai = 0; ai < 2; ++ai)
#pragma unroll
                for (int m = 0; m < 4; ++m) { bf16_t* rowp = U + (size_t)(row0 + ai * HALF + m * 16) * 1024 + col0;
                    const f32x4 v0 = acc[ai][0][m][0] * acc[ai][1][m][0], v1 = acc[ai][0][m][1] * acc[ai][1][m][1];
                    u32x4 w; w.x = cvt_pk_bf16(v0[0], v0[1]); w.y = cvt_pk_bf16(v0[2], v0[3]); w.z = cvt_pk_bf16(v1[0], v1[1]); w.w = cvt_pk_bf16(v1[2], v1[3]);
                    *(u32x4*)(rowp) = w; }
        }
    }
};
struct EpiSwiGLU {
    static constexpr bool PERM = true, AFTER_DRAIN = false;
    bf16_t* H;
    __device__ __forceinline__ float act(float g, float uu) const { return g * uu * __builtin_amdgcn_rcpf(1.0f + __builtin_amdgcn_exp2f(-1.4426950408889634f * g)); }
    __device__ __forceinline__ void operator()(const f32x4 (&acc)[2][2][4][2], const Unit& u, int wr, int wc, int fr, int fq) const {
        const int row0 = u.pm * BM + wr * 64 + fr;
        const int col0 = u.pn * HALF + wc * 32 + 8 * fq;
#pragma unroll
        for (int ai = 0; ai < 2; ++ai)
#pragma unroll
            for (int m = 0; m < 4; ++m) { bf16_t* rowp = H + (size_t)(row0 + ai * HALF + m * 16) * 2816 + col0;
                const f32x4 g0 = acc[ai][0][m][0], g1 = acc[ai][0][m][1], u0 = acc[ai][1][m][0], u1 = acc[ai][1][m][1];
                u32x4 w; w.x = cvt_pk_bf16(act(g0[0], u0[0]), act(g0[1], u0[1])); w.y = cvt_pk_bf16(act(g0[2], u0[2]), act(g0[3], u0[3]));
                w.z = cvt_pk_bf16(act(g1[0], u1[0]), act(g1[1], u1[1])); w.w = cvt_pk_bf16(act(g1[2], u1[2]), act(g1[3], u1[3]));
                *(u32x4*)(rowp) = w; }
    }
};
}

struct Args {
    const float *x_prompt, *x_sample, *state_conv, *cache_k, *cache_v, *conv_w_in, *conv_kernel, *conv_w_out, *attn_w_qkv, *attn_w_o, *attn_rel_bias,
        *norm_mix_pre, *norm_mix_post, *norm_ffn_pre, *norm_ffn_post, *ffn_w_gate_up, *ffn_w_down;
    float* out; unsigned char* ws;
};

template <int MODE> __device__ __forceinline__ int dest_row(int n) {
    if (MODE == 1) { const int hh = n / DFF, rem = n - hh * DFF; return ((rem >> 7) << 8) + (hh << 7) + (rem & 127); }
    if (MODE == 2) { if (n < 1024) return n; const int np = n - 1024, hh = np >> 10, rem = np & 1023; return 1024 + ((rem >> 7) << 8) + (hh << 7) + (rem & 127); }
    return n;
}
template <int MODE> __device__ __forceinline__ void transpose_item(const float* W, int K, int N, bf16_t* WT, LAS float* scr, int item, int lane) {
    const int nblk = N / 32, kb = item / nblk, nb = item % nblk, k0 = 64 * kb, n0 = 32 * nb;
#pragma unroll 8
    for (int i = 0; i < 32; ++i) { const int kk = 2 * i + (lane >> 5); scr[kk * 33 + (lane & 31)] = W[(size_t)(k0 + kk) * N + n0 + (lane & 31)]; }
    asm volatile("s_waitcnt lgkmcnt(0)" ::: "memory");
    const int c = lane & 7; const int drow = dest_row<MODE>(n0);
#pragma unroll
    for (int j = 0; j < 4; ++j) { const int n = (lane >> 3) + 8 * j; const LAS float* s = scr + (8 * c) * 33 + n;
        u32x4 o; o.x = pk2(s[0 * 33], s[1 * 33]); o.y = pk2(s[2 * 33], s[3 * 33]); o.z = pk2(s[4 * 33], s[5 * 33]); o.w = pk2(s[6 * 33], s[7 * 33]);
        *(u32x4*)(WT + (size_t)(drow + n) * K + k0 + 8 * c) = o; }
    asm volatile("s_waitcnt lgkmcnt(0)" ::: "memory");
}

__device__ __forceinline__ void norm_row(const float* xrow, const float* g, bf16_t* orow, int lane) {
    const f32x4* xr = (const f32x4*)xrow + lane; const f32x4* gr = (const f32x4*)g + lane;
    f32x4 v[4]; float s = 0.f;
#pragma unroll
    for (int j = 0; j < 4; ++j) { v[j] = xr[64 * j]; s += (v[j].x * v[j].x + v[j].y * v[j].y) + (v[j].z * v[j].z + v[j].w * v[j].w); }
    const float inv = 1.0f / sqrtf(wave_sum(s) * (1.f / D) + EPS);
    u32x2* o8 = (u32x2*)orow + lane;
#pragma unroll
    for (int j = 0; j < 4; ++j) { const f32x4 gg = gr[64 * j]; u32x2 w; w.x = pk2(v[j].x * inv * gg.x, v[j].y * inv * gg.y); w.y = pk2(v[j].z * inv * gg.z, v[j].w * inv * gg.w); o8[64 * j] = w; }
}
template <int XIN, int XOUT> __device__ __forceinline__ void res_pass(const Args& a, const bf16_t* MO, bf16_t* XR, bf16_t* XN, float* Y, const float* gp, const float* gn, int gw, int NGW, int lane) {
    const f32x4* gr = (const f32x4*)gp + lane;
    for (int m0 = gw; m0 < M; m0 += 2 * NGW) {
        int mm[2]; mm[0] = m0; mm[1] = (m0 + NGW < M) ? m0 + NGW : m0;
        f32x4 mv[2][4], xv[2][4]; float s[2] = {0.f, 0.f};
#pragma unroll
        for (int k = 0; k < 2; ++k) {
            const int m = mm[k];
            const u32x2* mr = (const u32x2*)(MO + (size_t)m * D) + lane;
#pragma unroll
            for (int j = 0; j < 4; ++j) { const u32x2 w = mr[64 * j]; mv[k][j] = (f32x4){bflo(w.x), bfhi(w.x), bflo(w.y), bfhi(w.y)}; }
            if (XIN == 0) { const float* xr = m < MP ? a.x_prompt + (size_t)m * D : a.x_sample + (size_t)(m - MP) * D;
#pragma unroll
                for (int j = 0; j < 4; ++j) xv[k][j] = ((const f32x4*)xr + lane)[64 * j];
            } else { const u32x2* xr = (const u32x2*)(XR + (size_t)m * D) + lane;
#pragma unroll
                for (int j = 0; j < 4; ++j) { const u32x2 w = xr[64 * j]; xv[k][j] = (f32x4){bflo(w.x), bfhi(w.x), bflo(w.y), bfhi(w.y)}; } }
        }
#pragma unroll
        for (int k = 0; k < 2; ++k)
#pragma unroll
            for (int j = 0; j < 4; ++j) s[k] += (mv[k][j].x * mv[k][j].x + mv[k][j].y * mv[k][j].y) + (mv[k][j].z * mv[k][j].z + mv[k][j].w * mv[k][j].w);
        float inv[2], s2[2] = {0.f, 0.f};
#pragma unroll
        for (int k = 0; k < 2; ++k) inv[k] = 1.0f / sqrtf(wave_sum(s[k]) * (1.f / D) + EPS);
#pragma unroll
        for (int k = 0; k < 2; ++k)
#pragma unroll
            for (int j = 0; j < 4; ++j) { const f32x4 gg = gr[64 * j]; xv[k][j] = xv[k][j] + mv[k][j] * inv[k] * gg;
                s2[k] += (xv[k][j].x * xv[k][j].x + xv[k][j].y * xv[k][j].y) + (xv[k][j].z * xv[k][j].z + xv[k][j].w * xv[k][j].w); }
        if (XOUT == 1) {
#pragma unroll
            for (int k = 0; k < 2; ++k) { f32x4* xo = (f32x4*)(Y + (size_t)mm[k] * D) + lane;
#pragma unroll
                for (int j = 0; j < 4; ++j) xo[64 * j] = xv[k][j]; }
        } else {
            const f32x4* g2 = (const f32x4*)gn + lane;
#pragma unroll
            for (int k = 0; k < 2; ++k) {
                const float inv2 = 1.0f / sqrtf(wave_sum(s2[k]) * (1.f / D) + EPS);
                u32x2* xo = (u32x2*)(XR + (size_t)mm[k] * D) + lane; u32x2* o8 = (u32x2*)(XN + (size_t)mm[k] * D) + lane;
#pragma unroll
                for (int j = 0; j < 4; ++j) { const f32x4 gg = g2[64 * j]; const f32x4 x = xv[k][j];
                    u32x2 wx; wx.x = pk2(x.x, x.y); wx.y = pk2(x.z, x.w); xo[64 * j] = wx;
                    u32x2 w; w.x = pk2(x.x * inv2 * gg.x, x.y * inv2 * gg.y); w.y = pk2(x.z * inv2 * gg.z, x.w * inv2 * gg.w); o8[64 * j] = w; }
            }
        }
    }
}

namespace att {
__device__ __forceinline__ int crow(int i, int h) { return (i & 3) + 8 * (i >> 2) + 4 * h; }
typedef short v4i16_t __attribute__((ext_vector_type(4)));
__device__ __forceinline__ s16x4 vtr(const LAS unsigned char* p) { return __builtin_bit_cast(s16x4, __builtin_amdgcn_ds_read_tr16_b64_v4i16((LAS v4i16_t*)p)); }
struct Item { const bf16_t* q; const bf16_t* kc; const bf16_t* vc; const bf16_t* kn; const bf16_t* vn; bf16_t* o; int nc, kt0, kt1, qpos0, head; };

__device__ __forceinline__ void load_tile(const Item& it, int kt, int lane, bf16x8 (&kf)[4], u32x4 (&vr)[4]) {
    const int r = lane & 31, h = lane >> 5;
    const bf16_t* kp = kt < it.nc ? it.kc + (size_t)kt * 32 * 1024 : it.kn + (size_t)(kt - it.nc) * 32 * 1024;
    const bf16_t* vp = kt < it.nc ? it.vc + (size_t)kt * 32 * 1024 : it.vn + (size_t)(kt - it.nc) * 32 * 1024;
#pragma unroll
    for (int s = 0; s < 4; ++s) kf[s] = *(const bf16x8*)(kp + (size_t)r * 1024 + 16 * s + 8 * h);
#pragma unroll
    for (int i = 0; i < 4; ++i) vr[i] = *(const u32x4*)(vp + (size_t)((lane >> 3) + 8 * i) * 1024 + (lane & 7) * 8);
}

__device__ __forceinline__ void attn_item(const Item& it, LAS unsigned char* vlds, LAS float* tab, const float* table, int lane) {
    const int r = lane & 31, h = lane >> 5;
    asm volatile("s_waitcnt lgkmcnt(0)" ::: "memory");
    for (int i = lane; i < 257; i += 64) tab[i] = table[it.head * 257 + i] * LOG2E;
    bf16x8 qf[4];
#pragma unroll
    for (int s = 0; s < 4; ++s) qf[s] = *(const bf16x8*)(it.q + (size_t)r * 1024 + 16 * s + 8 * h);
    f32x16 o0, o1;
#pragma unroll
    for (int i = 0; i < 16; ++i) { o0[i] = 0.f; o1[i] = 0.f; }
    float mrun = -1e30f, lrun = 0.f;
    asm volatile("s_waitcnt lgkmcnt(0)" ::: "memory");
    const float cfar = tab[256];
    const int qpos = it.qpos0 + r;
    const int i16 = lane & 15, q4 = i16 >> 2, p4 = i16 & 3, g = (lane >> 4) & 1;
    const LAS unsigned char* trbase = vlds + (4 * h + q4) * 128 + (16 * g + 4 * p4) * 2;
    bf16x8 kf[4]; u32x4 vr[4];
    load_tile(it, it.kt0, lane, kf, vr);
    for (int kt = it.kt0; kt < it.kt1; ++kt) {
        bf16x8 kn_[4]; u32x4 vn_[4];
        if (kt + 1 < it.kt1) load_tile(it, kt + 1, lane, kn_, vn_);
        else {
#pragma unroll
            for (int s = 0; s < 4; ++s) { kn_[s] = kf[s]; vn_[s] = vr[s]; }
        }
        asm volatile("s_waitcnt lgkmcnt(0)" ::: "memory");
#pragma unroll
        for (int i = 0; i < 4; ++i) *(LAS u32x4*)(vlds + ((lane >> 3) + 8 * i) * 128 + (lane & 7) * 16) = vr[i];
        f32x16 p;
#pragma unroll
        for (int i = 0; i < 16; ++i) p[i] = 0.f;
#pragma unroll
        for (int s = 0; s < 4; ++s) p = __builtin_amdgcn_mfma_f32_32x32x16_bf16(kf[s], qf[s], p, 0, 0, 0);
        const int kb = 32 * kt;
        if (it.qpos0 - (kb + 31) >= 128) {
#pragma unroll
            for (int i = 0; i < 16; ++i) p[i] += cfar;
        } else {
#pragma unroll
            for (int i = 0; i < 16; ++i) { int dd = qpos - (kb + crow(i, h)); dd = dd < -128 ? -128 : (dd > 128 ? 128 : dd); p[i] += tab[dd + 128]; }
        }
        float tm = p[0];
#pragma unroll
        for (int i = 1; i < 16; ++i) tm = fmaxf(tm, p[i]);
        tm = fmaxf(tm, __shfl_xor(tm, 32));
        const float mnew = fmaxf(mrun, tm);
        const float sc = __builtin_amdgcn_exp2f(mrun - mnew);
        mrun = mnew;
        float ps = 0.f;
#pragma unroll
        for (int i = 0; i < 16; ++i) { p[i] = __builtin_amdgcn_exp2f(p[i] - mnew); ps += p[i]; }
        lrun = lrun * sc + ps;
#pragma unroll
        for (int i = 0; i < 16; ++i) { o0[i] *= sc; o1[i] *= sc; }
        u32x4 w0, w1;
        w0.x = pk2(p[0], p[1]); w0.y = pk2(p[2], p[3]); w0.z = pk2(p[4], p[5]); w0.w = pk2(p[6], p[7]);
        w1.x = pk2(p[8], p[9]); w1.y = pk2(p[10], p[11]); w1.z = pk2(p[12], p[13]); w1.w = pk2(p[14], p[15]);
        const bf16x8 pf0 = __builtin_bit_cast(bf16x8, w0), pf1 = __builtin_bit_cast(bf16x8, w1);
        asm volatile("s_waitcnt lgkmcnt(0)" ::: "memory");
#pragma unroll
        for (int s = 0; s < 2; ++s) {
            const s16x4 a_lo = vtr(trbase + (16 * s) * 128), a_hi = vtr(trbase + (16 * s + 8) * 128);
            const s16x4 b_lo = vtr(trbase + (16 * s) * 128 + 64), b_hi = vtr(trbase + (16 * s + 8) * 128 + 64);
            const bf16x8 va = __builtin_shufflevector(a_lo, a_hi, 0, 1, 2, 3, 4, 5, 6, 7), vb = __builtin_shufflevector(b_lo, b_hi, 0, 1, 2, 3, 4, 5, 6, 7);
            o0 = __builtin_amdgcn_mfma_f32_32x32x16_bf16(va, s == 0 ? pf0 : pf1, o0, 0, 0, 0);
            o1 = __builtin_amdgcn_mfma_f32_32x32x16_bf16(vb, s == 0 ? pf0 : pf1, o1, 0, 0, 0);
        }
#pragma unroll
        for (int s = 0; s < 4; ++s) { kf[s] = kn_[s]; vr[s] = vn_[s]; }
    }
    lrun += __shfl_xor(lrun, 32);
    const float inv = 1.0f / lrun;
    bf16_t* orow = it.o + (size_t)r * 1024 + 4 * h;
#pragma unroll
    for (int g4 = 0; g4 < 4; ++g4) {
        u32x2 a, b;
        a.x = pk2(o0[4 * g4] * inv, o0[4 * g4 + 1] * inv); a.y = pk2(o0[4 * g4 + 2] * inv, o0[4 * g4 + 3] * inv);
        b.x = pk2(o1[4 * g4] * inv, o1[4 * g4 + 1] * inv); b.y = pk2(o1[4 * g4 + 2] * inv, o1[4 * g4 + 3] * inv);
        *(u32x2*)(orow + 8 * g4) = a; *(u32x2*)(orow + 32 + 8 * g4) = b;
    }
}

constexpr int KROW = 144, KTILE = 64 * KROW, VTILE = 64 * 128, A_K = 0, A_V = 2 * KTILE, A_TAB = A_V + 2 * VTILE, A_SLOT = A_TAB + 1040;
__device__ __forceinline__ void attn_unit(int b, int hh, int cq, const bf16_t* Qg, const bf16_t* Kg, const bf16_t* Vg, bf16_t* Og, const float* table, LAS unsigned char* lds, int tid, int lane, int wave) {
    const int r = lane & 31, h = lane >> 5;
    const int c = 4 * cq + (wave >> 1), half = wave & 1;
    const int j0 = (4 * cq - 8) > 0 ? (4 * cq - 8) : 0, j1 = 4 * cq + 3;
    const size_t rb = (size_t)b * SEQ;
    LAS float* tab = (LAS float*)(lds + A_TAB);
    if (tid < 257) tab[tid] = table[hh * 257 + tid] * LOG2E;
    const int lrow = tid >> 3, lch = tid & 7;
    const bf16_t* kgp = Kg + (rb + lrow) * D + hh * HD + lch * 8; const bf16_t* vgp = Vg + (rb + lrow) * D + hh * HD + lch * 8;
    const int kwoff = A_K + lrow * KROW + lch * 16, vwoff = A_V + lrow * 128 + ((lch ^ (((lrow >> 1) & 1) << 2)) << 4);
    u32x4 kreg = *(const u32x4*)(kgp + (size_t)j0 * 64 * D), vreg = *(const u32x4*)(vgp + (size_t)j0 * 64 * D);
    bf16x8 qf[4];
    const bf16_t* qp = Qg + (rb + 64 * c + 32 * half + r) * D + hh * HD + 8 * h;
#pragma unroll
    for (int s = 0; s < 4; ++s) qf[s] = *(const bf16x8*)(qp + 16 * s);
    *(LAS u32x4*)(lds + kwoff) = kreg; *(LAS u32x4*)(lds + vwoff) = vreg;
    f32x16 o0, o1;
#pragma unroll
    for (int i = 0; i < 16; ++i) { o0[i] = 0.f; o1[i] = 0.f; }
    float mrun = 0.f, lrun = 0.f;
    const int i16 = lane & 15, q4 = i16 >> 2, p4 = i16 & 3, g = (lane >> 4) & 1;
    const int troff = A_V + (4 * h + q4) * 128 + ((32 * g) ^ (((q4 >> 1) & 1) << 6)) + 8 * p4;
    const int kroff = A_K + r * KROW + 16 * h;
    __syncthreads();
    const float cfar = tab[256];
    const int qpos = 64 * c + 32 * half + r;
    for (int j = j0; j <= j1; ++j) {
        const int bufk = ((j - j0) & 1) * KTILE, bufv = ((j - j0) & 1) * VTILE;
        if (j < j1) { kreg = *(const u32x4*)(kgp + (size_t)(j + 1) * 64 * D); vreg = *(const u32x4*)(vgp + (size_t)(j + 1) * 64 * D); }
        if (j >= c - 8 && j <= c) {
            f32x16 p0, p1;
            if (j <= c - 3) {
                const float ci = cfar - mrun;
#pragma unroll
                for (int i = 0; i < 16; ++i) { p0[i] = ci; p1[i] = ci; }
            } else {
                const int d0 = qpos - 64 * j - 4 * h + 128;
#pragma unroll
                for (int i = 0; i < 16; ++i) { int a0 = d0 - (i & 3) - 8 * (i >> 2), a1 = a0 - 32; a0 = a0 < 0 ? 0 : (a0 > 256 ? 256 : a0); a1 = a1 < 0 ? 0 : (a1 > 256 ? 256 : a1);
                    p0[i] = tab[a0] - mrun; p1[i] = tab[a1] - mrun; }
            }
#pragma unroll
            for (int s = 0; s < 4; ++s) {
                const bf16x8 ka = *(const LAS bf16x8*)(lds + bufk + kroff + 32 * s), kb = *(const LAS bf16x8*)(lds + bufk + kroff + 32 * KROW + 32 * s);
                p0 = __builtin_amdgcn_mfma_f32_32x32x16_bf16(ka, qf[s], p0, 0, 0, 0);
                p1 = __builtin_amdgcn_mfma_f32_32x32x16_bf16(kb, qf[s], p1, 0, 0, 0);
            }
            float tm = fmaxf(p0[0], p1[0]);
#pragma unroll
            for (int i = 1; i < 16; ++i) tm = fmaxf(tm, fmaxf(p0[i], p1[i]));
            { auto rr = __builtin_amdgcn_permlane32_swap(__float_as_uint(tm), __float_as_uint(tm), false, false); tm = fmaxf(__uint_as_float(rr[0]), __uint_as_float(rr[1])); }
            if (__any(tm > 0.f)) {
                const float dl = fmaxf(tm, 0.f); mrun += dl;
                const float sc = __builtin_amdgcn_exp2f(-dl); lrun *= sc;
#pragma unroll
                for (int i = 0; i < 16; ++i) { p0[i] -= dl; p1[i] -= dl; o0[i] *= sc; o1[i] *= sc; }
            }
            float ps = 0.f;
#pragma unroll
            for (int i = 0; i < 16; ++i) { p0[i] = __builtin_amdgcn_exp2f(p0[i]); p1[i] = __builtin_amdgcn_exp2f(p1[i]); ps += p0[i] + p1[i]; }
            lrun += ps;
            u32x4 w0, w1, w2, w3;
            w0.x = pk2(p0[0], p0[1]); w0.y = pk2(p0[2], p0[3]); w0.z = pk2(p0[4], p0[5]); w0.w = pk2(p0[6], p0[7]);
            w1.x = pk2(p0[8], p0[9]); w1.y = pk2(p0[10], p0[11]); w1.z = pk2(p0[12], p0[13]); w1.w = pk2(p0[14], p0[15]);
            w2.x = pk2(p1[0], p1[1]); w2.y = pk2(p1[2], p1[3]); w2.z = pk2(p1[4], p1[5]); w2.w = pk2(p1[6], p1[7]);
            w3.x = pk2(p1[8], p1[9]); w3.y = pk2(p1[10], p1[11]); w3.z = pk2(p1[12], p1[13]); w3.w = pk2(p1[14], p1[15]);
            const bf16x8 pf[4] = {__builtin_bit_cast(bf16x8, w0), __builtin_bit_cast(bf16x8, w1), __builtin_bit_cast(bf16x8, w2), __builtin_bit_cast(bf16x8, w3)};
#pragma unroll
            for (int ks = 0; ks < 4; ++ks) {
                const LAS unsigned char* tb = lds + bufv + troff + ks * 16 * 128;
                const s16x4 a_lo = vtr(tb), a_hi = vtr(tb + 8 * 128);
                const LAS unsigned char* tb1 = lds + bufv + (troff ^ 64) + ks * 16 * 128;
                const s16x4 b_lo = vtr(tb1), b_hi = vtr(tb1 + 8 * 128);
                const bf16x8 va = __builtin_shufflevector(a_lo, a_hi, 0, 1, 2, 3, 4, 5, 6, 7), vb = __builtin_shufflevector(b_lo, b_hi, 0, 1, 2, 3, 4, 5, 6, 7);
                o0 = __builtin_amdgcn_mfma_f32_32x32x16_bf16(va, pf[ks], o0, 0, 0, 0);
                o1 = __builtin_amdgcn_mfma_f32_32x32x16_bf16(vb, pf[ks], o1, 0, 0, 0);
            }
        }
        if (j < j1) { const int nbk = ((j + 1 - j0) & 1) * KTILE, nbv = ((j + 1 - j0) & 1) * VTILE; *(LAS u32x4*)(lds + nbk + kwoff) = kreg; *(LAS u32x4*)(lds + nbv + vwoff) = vreg; }
        __syncthreads();
    }
    lrun += __shfl_xor(lrun, 32);
    const float inv = 1.0f / lrun;
    bf16_t* orow = Og + (rb + 64 * c + 32 * half + r) * D + hh * HD + 4 * h;
#pragma unroll
    for (int g4 = 0; g4 < 4; ++g4) {
        u32x2 x, y;
        x.x = pk2(o0[4 * g4] * inv, o0[4 * g4 + 1] * inv); x.y = pk2(o0[4 * g4 + 2] * inv, o0[4 * g4 + 3] * inv);
        y.x = pk2(o1[4 * g4] * inv, o1[4 * g4 + 1] * inv); y.y = pk2(o1[4 * g4 + 2] * inv, o1[4 * g4 + 3] * inv);
        *(u32x2*)(orow + 8 * g4) = x; *(u32x2*)(orow + 32 + 8 * g4) = y;
    }
}
}


__global__ void __launch_bounds__(NWAVES * 64, 2) fwd_kernel(Args a) {
    extern __shared__ __attribute__((aligned(16))) unsigned char lds_raw[];
    cg::grid_group grid = cg::this_grid();
    LAS unsigned char* lds = (LAS unsigned char*)lds_raw;
    const int tid = threadIdx.x, lane = tid & 63, wave = __builtin_amdgcn_readfirstlane(tid >> 6);
    const int G = gridDim.x, gw = blockIdx.x * NWAVES + wave, NGW = G * NWAVES;
    unsigned char* ws = a.ws;
    bf16_t* Win_t = (bf16_t*)(ws + WS_WIN); bf16_t* Wout_t = (bf16_t*)(ws + WS_WOUT);
    bf16_t* Wgu_t0 = (bf16_t*)(ws + WS_WGU0); bf16_t* Wgu_t1 = (bf16_t*)(ws + WS_WGU1);
    bf16_t* Wd_t0 = (bf16_t*)(ws + WS_WD0); bf16_t* Wd_t1 = (bf16_t*)(ws + WS_WD1);
    bf16_t* Wqkv_t = (bf16_t*)(ws + WS_WQKV); bf16_t* Wo_t = (bf16_t*)(ws + WS_WO);
    bf16_t* KC = (bf16_t*)(ws + WS_KC); bf16_t* VC = (bf16_t*)(ws + WS_VC);
    bf16_t* XN = (bf16_t*)(ws + WS_XN); bf16_t* BA = (bf16_t*)(ws + WS_A); bf16_t* BB = (bf16_t*)(ws + WS_B); bf16_t* BC = (bf16_t*)(ws + WS_C);
    bf16_t* MO = (bf16_t*)(ws + WS_MO); bf16_t* OB = (bf16_t*)(ws + WS_O); bf16_t* HB = BA; bf16_t* XR = (bf16_t*)(ws + WS_XR);
    float* Y = a.out + O_Y;
    unsigned* qctr = (unsigned*)(ws + WS_CTL);

    {
        LAS float* scr = (LAS float*)(lds + wave * 16384);
        if (blockIdx.x == 0 && tid == 0) *qctr = 0u;
        constexpr int I_IN = 16 * 96, I_OUT = 16 * 32, I_GU = 16 * 176, I_D = 44 * 32;
        constexpr int NITEMS = 2 * I_IN + 2 * I_OUT + 2 * I_GU + 2 * I_D;
        for (int it = gw; it < NITEMS; it += NGW) {
            int r = it;
            if (r < I_IN) { transpose_item<2>(a.conv_w_in, D, 3 * D, Win_t, scr, r, lane); continue; } r -= I_IN;
            if (r < I_OUT) { transpose_item<0>(a.conv_w_out, D, D, Wout_t, scr, r, lane); continue; } r -= I_OUT;
            if (r < I_GU) { transpose_item<1>(a.ffn_w_gate_up, D, 2 * DFF, Wgu_t0, scr, r, lane); continue; } r -= I_GU;
            if (r < I_GU) { transpose_item<1>(a.ffn_w_gate_up + (size_t)D * 2 * DFF, D, 2 * DFF, Wgu_t1, scr, r, lane); continue; } r -= I_GU;
            if (r < I_D) { transpose_item<0>(a.ffn_w_down, DFF, D, Wd_t0, scr, r, lane); continue; } r -= I_D;
            if (r < I_D) { transpose_item<0>(a.ffn_w_down + (size_t)DFF * D, DFF, D, Wd_t1, scr, r, lane); continue; } r -= I_D;
            if (r < I_IN) { transpose_item<0>(a.attn_w_qkv, D, 3 * D, Wqkv_t, scr, r, lane); continue; } r -= I_IN;
            transpose_item<0>(a.attn_w_o, D, D, Wo_t, scr, r, lane);
        }
        {
            const size_t n8 = (size_t)DB * CROWS * D / 8; const size_t gt = (size_t)blockIdx.x * (NWAVES * 64) + tid, NT = (size_t)G * NWAVES * 64;
            for (size_t i = gt; i < 2 * n8; i += NT) {
                const float* src = i < n8 ? a.cache_k + i * 8 : a.cache_v + (i - n8) * 8; bf16_t* dst = i < n8 ? KC + i * 8 : VC + (i - n8) * 8;
                const f32x4 v0 = *(const f32x4*)src, v1 = *(const f32x4*)(src + 4);
                u32x4 w; w.x = pk2(v0.x, v0.y); w.y = pk2(v0.z, v0.w); w.z = pk2(v1.x, v1.y); w.w = pk2(v1.z, v1.w);
                *(u32x4*)dst = w;
            }
        }
        for (int m = gw; m < M; m += NGW) { const float* xr = m < MP ? a.x_prompt + (size_t)m * D : a.x_sample + (size_t)(m - MP) * D; norm_row(xr, a.norm_mix_pre, XN + (size_t)m * D, lane); }
    }
    grid.sync();
    { pg8::Gemm g{XN, Win_t, M, 3 * D, D}; pg8::StaticOrder S; S.init(M, 3 * D, G, (int)blockIdx.x); pg8::EpiConvIn E{BA, BB};
      pg8::gemm_phase<pg8::EpiConvIn, pg8::StaticOrder, true, true>(lds, g, S, E); }
    grid.sync();
    for (int m = gw; m < M; m += NGW) {
        const bool samp = m >= MP; const int t = samp ? ((m - MP) & 31) : (m & 2047); const int b = samp ? ((m - MP) >> 5) : (m >> 11); const int T = samp ? DS : SEQ;
        const u32x2* u0p = (const u32x2*)(BB + (size_t)m * D) + lane; const u32x2* bgp = (const u32x2*)(BA + (size_t)m * D) + lane;
        const f32x4* w0 = (const f32x4*)a.conv_kernel + lane; const f32x4* w1 = w0 + 256; const f32x4* w2 = w0 + 512;
        const float* st = a.state_conv + (size_t)b * 2 * D;
        u32x2* yo = (u32x2*)(BC + (size_t)m * D) + lane;
        float* so = nullptr;
        if (t >= T - 2) so = a.out + (samp ? O_CONVS : O_CONVP) + ((size_t)b * 2 + (t - (T - 2))) * D;
#pragma unroll
        for (int j = 0; j < 4; ++j) {
            const u32x2 uw = u0p[64 * j]; const f32x4 u0 = (f32x4){bflo(uw.x), bfhi(uw.x), bflo(uw.y), bfhi(uw.y)};
            f32x4 u1 = (f32x4){0.f, 0.f, 0.f, 0.f}, u2 = u1;
            if (t >= 1) { const u32x2 w = u0p[64 * j - 256]; u1 = (f32x4){bflo(w.x), bfhi(w.x), bflo(w.y), bfhi(w.y)}; }
            else if (samp) u1 = *((const f32x4*)(st + D) + lane + 64 * j);
            if (t >= 2) { const u32x2 w = u0p[64 * j - 512]; u2 = (f32x4){bflo(w.x), bfhi(w.x), bflo(w.y), bfhi(w.y)}; }
            else if (samp) u2 = *((const f32x4*)(st + (t == 1 ? D : 0)) + lane + 64 * j);
            const u32x2 bw = bgp[64 * j]; const f32x4 bg = (f32x4){bflo(bw.x), bfhi(bw.x), bflo(bw.y), bfhi(bw.y)};
            const f32x4 y = bg * (w0[64 * j] * u2 + w1[64 * j] * u1 + w2[64 * j] * u0);
            u32x2 o; o.x = pk2(y.x, y.y); o.y = pk2(y.z, y.w); yo[64 * j] = o;
            if (so) *((f32x4*)so + lane + 64 * j) = u0;
        }
    }
    grid.sync();
    { pg8::Gemm g{BC, Wout_t, M, D, D}; pg8::StaticOrder S; S.init(M, D, G, (int)blockIdx.x); pg8::EpiBf16<0> E{MO, D, nullptr, 0, 0, 1.f};
      pg8::gemm_phase<pg8::EpiBf16<0>, pg8::StaticOrder, true, true>(lds, g, S, E); }
    grid.sync();
    res_pass<0, 0>(a, MO, XR, XN, Y, a.norm_mix_post, a.norm_ffn_pre, gw, NGW, lane);
    grid.sync();
    { pg8::Gemm g{XN, Wgu_t0, M, 2 * DFF, D}; pg8::StaticOrder S; S.init(M, 2 * DFF, G, (int)blockIdx.x); pg8::EpiSwiGLU E{HB};
      pg8::gemm_phase<pg8::EpiSwiGLU, pg8::StaticOrder, true, true>(lds, g, S, E); }
    grid.sync();
    { pg8::Gemm g{HB, Wd_t0, M, D, DFF}; pg8::StaticOrder S; S.init(M, D, G, (int)blockIdx.x); pg8::EpiBf16<0> E{MO, D, nullptr, 0, 0, 1.f};
      pg8::gemm_phase<pg8::EpiBf16<0>, pg8::StaticOrder, true, true>(lds, g, S, E); }
    grid.sync();
    res_pass<1, 0>(a, MO, XR, XN, Y, a.norm_ffn_post, a.norm_mix_pre + D, gw, NGW, lane);
    grid.sync();
    { pg8::Gemm g{XN, Wqkv_t, M, 3 * D, D}; pg8::StaticOrder S; S.init(M, 3 * D, G, (int)blockIdx.x);
      pg8::EpiBf16<0> E{BA, D, nullptr, D, (size_t)(WS_B - WS_A) / 2, QSCALE};
      pg8::gemm_phase<pg8::EpiBf16<0>, pg8::StaticOrder, true, true>(lds, g, S, E); }
    grid.sync();
    {
        for (int i = gw; i < 2 * (NB * CROWS + MS); i += NGW) {
            const int kv = i >= (NB * CROWS + MS); const int j = kv ? i - (NB * CROWS + MS) : i;
            size_t srow; float* dst;
            if (j < NB * CROWS) { srow = (size_t)(j >> 9) * SEQ + (SEQ - CROWS) + (j & 511); dst = a.out + (kv ? O_VP : O_KP) + (size_t)j * D; }
            else { srow = (size_t)MP + (j - NB * CROWS); dst = a.out + (kv ? O_VS : O_KS) + (size_t)(j - NB * CROWS) * D; }
            const u32x2* sp = (const u32x2*)((kv ? BC : BB) + srow * D) + lane;
#pragma unroll
            for (int jj = 0; jj < 4; ++jj) { const u32x2 w = sp[64 * jj]; *((f32x4*)dst + lane + 64 * jj) = (f32x4){bflo(w.x), bfhi(w.x), bflo(w.y), bfhi(w.y)}; }
        }
        constexpr int NGS = (DB * NH) / 8, NPU = NB * NH * 8;
        LAS unsigned char* vlds = lds + wave * 4096; LAS float* tabw = (LAS float*)(lds + 32768 + wave * 1088);
        volatile LAS int* slot = (volatile LAS int*)(lds + 65536);
        for (;;) {
            if (tid == 0) *slot = (int)atomicAdd(qctr, 1u);
            __syncthreads();
            const int wi = *slot;
            __syncthreads();
            if (wi >= NGS + NPU) break;
            if (wi < NGS) {
                att::Item it;
                const int si = wi * 8 + wave, b = si >> 4, hh = si & 15;
                const size_t rb = (size_t)MP + (size_t)b * DS;
                it.q = BA + rb * D + hh * HD; it.o = OB + rb * D + hh * HD;
                it.kc = KC + (size_t)b * CROWS * D + hh * HD; it.vc = VC + (size_t)b * CROWS * D + hh * HD; it.kn = BB + rb * D + hh * HD; it.vn = BC + rb * D + hh * HD; it.nc = CROWS / 32;
                it.kt0 = 0; it.kt1 = CROWS / 32 + 1; it.qpos0 = CROWS; it.head = hh;
                att::attn_item(it, vlds, tabw, a.attn_rel_bias, lane);
                __syncthreads();
            } else {
                const int u = wi - NGS, bh = u >> 3, cq = 7 - (u & 7);
                att::attn_unit(bh >> 4, bh & 15, cq, BA, BB, BC, OB, a.attn_rel_bias, lds, tid, lane, wave);
            }
        }
    }
    grid.sync();
    { pg8::Gemm g{OB, Wo_t, M, D, D}; pg8::StaticOrder S; S.init(M, D, G, (int)blockIdx.x); pg8::EpiBf16<0> E{MO, D, nullptr, 0, 0, 1.f};
      pg8::gemm_phase<pg8::EpiBf16<0>, pg8::StaticOrder, true, true>(lds, g, S, E); }
    grid.sync();
    res_pass<1, 0>(a, MO, XR, XN, Y, a.norm_mix_post + D, a.norm_ffn_pre + D, gw, NGW, lane);
    grid.sync();
    { pg8::Gemm g{XN, Wgu_t1, M, 2 * DFF, D}; pg8::StaticOrder S; S.init(M, 2 * DFF, G, (int)blockIdx.x); pg8::EpiSwiGLU E{HB};
      pg8::gemm_phase<pg8::EpiSwiGLU, pg8::StaticOrder, true, true>(lds, g, S, E); }
    grid.sync();
    { pg8::Gemm g{HB, Wd_t1, M, D, DFF}; pg8::StaticOrder S; S.init(M, D, G, (int)blockIdx.x); pg8::EpiBf16<0> E{MO, D, nullptr, 0, 0, 1.f};
      pg8::gemm_phase<pg8::EpiBf16<0>, pg8::StaticOrder, true, true>(lds, g, S, E); }
    grid.sync();
    res_pass<1, 1>(a, MO, XR, XN, Y, a.norm_ffn_post + D, nullptr, gw, NGW, lane);
}

extern "C" void kernel_launch(void* const* d_in, const int* in_sizes, int n_in, void* d_out, int out_size, void* d_ws, size_t ws_size, hipStream_t stream) {
    static int grid = 0;
    if (grid == 0) {
        if (n_in != 17 || (size_t)out_size != O_END || ws_size < WS_END) { fprintf(stderr, "kernel_launch: unexpected shapes n_in %d out %d ws %zu\n", n_in, out_size, ws_size); grid = -1; return; }
        int dev = 0, cus = 0, per_cu = 0;
        hipGetDevice(&dev); hipDeviceGetAttribute(&cus, hipDeviceAttributeMultiprocessorCount, dev);
        if (hipFuncSetAttribute((const void*)fwd_kernel, hipFuncAttributeMaxDynamicSharedMemorySize, LDS_BYTES) != hipSuccess) { fprintf(stderr, "kernel_launch: hipFuncSetAttribute failed\n"); grid = -1; return; }
        if (hipOccupancyMaxActiveBlocksPerMultiprocessor(&per_cu, (const void*)fwd_kernel, NWAVES * 64, LDS_BYTES) != hipSuccess || per_cu < 1) { fprintf(stderr, "kernel_launch: occupancy query says %d\n", per_cu); per_cu = 1; }
        (void)hipGetLastError();
        grid = cus;
    }
    if (grid < 0) return;
    Args a{};
    const float** p = (const float**)&a;
    for (int i = 0; i < 17; ++i) p[i] = (const float*)d_in[i];
    a.out = (float*)d_out; a.ws = (unsigned char*)d_ws;
    void* args[] = {&a};
    hipError_t e = hipLaunchCooperativeKernel((const void*)fwd_kernel, dim3(grid), dim3(NWAVES * 64), args, LDS_BYTES, stream);
    if (e != hipSuccess) fprintf(stderr, "cooperative launch failed: %s (grid %d)\n", hipGetErrorString(e), grid);
}
```

```cpp
#include <hip/hip_runtime.h>
#include <hip/hip_cooperative_groups.h>
#include <cstdio>
#include <cstdint>
namespace cg = cooperative_groups;
namespace pg8 {
#define PG8_LAS __attribute__((address_space(3)))
typedef unsigned short bf16_t;
typedef short bf16x8 __attribute__((ext_vector_type(8)));
typedef float f32x4 __attribute__((ext_vector_type(4)));
typedef unsigned u32x4 __attribute__((ext_vector_type(4)));
constexpr int BM = 256, BK = 64, HALF = 128, HTB = HALF * BK * 2  , STAGE_BYTES = 8 * HTB, NXCD = 8, WGM = 8;

__host__ __device__ __forceinline__ int lds_byte(int r, int c) { const int st = (r >> 4) * 2 + (c >> 5), rr = r & 15, cc = c & 31, ob = rr * 64 + cc * 2; return st * 1024 + (ob ^ (((ob >> 9) & 1) << 5)); }
__host__ __device__ __forceinline__ void stage_rc(int b, int& R, int& C) { const int st = b / 1024, sb = b % 1024, swz = sb ^ (((sb >> 9) & 1) << 5); R = (st >> 1) * 16 + swz / 64; C = (st & 1) * 32 + (swz % 64) / 2; }
__host__ __device__ __forceinline__ int perm32(int rho) { const int n = rho >> 4, i = rho & 15; return 8 * (i >> 2) + 4 * n + (i & 3); }

struct Unit { int pm, pn; };
struct Gemm { const bf16_t* A; const bf16_t* Bt; int M, N, K; };

struct StaticOrder {
    int nM, nN, nwg, G, c;
    __host__ __device__ void init(int M, int N, int G_, int c_) { nM = M / BM; nN = N / BM; nwg = nM * nN; G = G_; c = c_; }
    __host__ __device__ bool next(int i, Unit& u) const {
        const long L = (long)i * G + c; if (L >= nwg) return false;
        int wgid = (int)L; { const int q = nwg / NXCD, r = nwg % NXCD, xcd = wgid % NXCD, off = wgid / NXCD; wgid = (xcd < r ? xcd * (q + 1) : r * (q + 1) + (xcd - r) * q) + off; }
        const int nig = WGM * nN, gid = wgid / nig, fm = gid * WGM, gsz = (nM - fm) < WGM ? (nM - fm) : WGM;
        u.pm = fm + ((wgid % nig) % gsz); u.pn = (wgid % nig) / gsz; return true;
    }
    __device__ __forceinline__ void a_ready(const Unit&) const {}
    __device__ __forceinline__ void done(const Unit&) const {}
};

__device__ __forceinline__ unsigned cvt_pk_bf16(float lo, float hi) { unsigned r; asm volatile("v_cvt_pk_bf16_f32 %0, %1, %2" : "=v"(r) : "v"(lo), "v"(hi)); return r; }
typedef float f32x2 __attribute__((ext_vector_type(2)));
__device__ __forceinline__ f32x2 gelu_pk(f32x2 v) {
    const f32x2 av = __builtin_elementwise_abs(v), d = av * 0.2316418882f + 1.0f;
    f32x2 t; t.x = __builtin_amdgcn_rcpf(d.x); t.y = __builtin_amdgcn_rcpf(d.y);
    f32x2 q = t * 0.5307027145f + (-0.7265760135f); q = q * t + 0.7107068705f; q = q * t + (-0.142248368f); q = q * t + 0.127414796f; q = q * t;
    const f32x2 s = (v * v) * (-0.72134752044f);
    f32x2 e; e.x = __builtin_amdgcn_exp2f(s.x); e.y = __builtin_amdgcn_exp2f(s.y);
    const f32x2 m = v * (q * e), r = v - m;
    f32x2 o; o.x = v.x < 0.f ? m.x : r.x; o.y = v.y < 0.f ? m.y : r.y; return o;
}

template <int ACT  > struct EpiBf16 {
    static constexpr bool PERM = true, AFTER_DRAIN = false; static_assert(ACT == 0 || ACT == 1, "EpiBf16: ACT is 0 (none) or 1 (gelu_pk)");
    bf16_t* O; int ldc; const float* bias; int split_cols; size_t split_stride; float scale0;
    __device__ __forceinline__ void operator()(const f32x4 (&acc)[2][2][4][2], const Unit& u, int wr, int wc, int fr, int fq) const {
        const int row0 = u.pm * BM + wr * 64 + fr; int colt = u.pn * BM; bf16_t* base = O;
        float sc = 1.f; if (split_cols) { const int t = colt / split_cols; base += (size_t)t * split_stride; colt -= t * split_cols; if (t == 0) sc = scale0; }
        const int col0 = colt + wc * 32 + 8 * fq, bcol0 = u.pn * BM + wc * 32 + 8 * fq;
        f32x4 bv[2][2];
#pragma unroll
        for (int bj = 0; bj < 2; ++bj)
#pragma unroll
            for (int n = 0; n < 2; ++n) bv[bj][n] = bias ? *(const f32x4*)(bias + bcol0 + bj * HALF + 4 * n) : (f32x4){0.f, 0.f, 0.f, 0.f};
#pragma unroll
        for (int ai = 0; ai < 2; ++ai)
#pragma unroll
            for (int m = 0; m < 4; ++m) { bf16_t* rowp = base + (size_t)(row0 + ai * HALF + m * 16) * ldc + col0;
#pragma unroll
                for (int bj = 0; bj < 2; ++bj) { f32x4 v0 = acc[ai][bj][m][0] + bv[bj][0], v1 = acc[ai][bj][m][1] + bv[bj][1];
                    if (ACT == 1) { f32x2 a = gelu_pk((f32x2){v0[0], v0[1]}), b = gelu_pk((f32x2){v0[2], v0[3]}), c = gelu_pk((f32x2){v1[0], v1[1]}), d = gelu_pk((f32x2){v1[2], v1[3]});
                        v0 = (f32x4){a.x, a.y, b.x, b.y}; v1 = (f32x4){c.x, c.y, d.x, d.y}; }
                    v0 = v0 * sc; v1 = v1 * sc; u32x4 w; w.x = cvt_pk_bf16(v0[0], v0[1]); w.y = cvt_pk_bf16(v0[2], v0[3]); w.z = cvt_pk_bf16(v1[0], v1[1]); w.w = cvt_pk_bf16(v1[2], v1[3]);
                    *(u32x4*)(rowp + bj * HALF) = w; } }
    }
};
template <class Epi, class Sched, bool ALIGN_EPI = false, bool SP2 = false>
__device__ __forceinline__ void gemm_phase(PG8_LAS unsigned char* lds, const Gemm g, const Sched& S, const Epi& E) {
    int tid_ = threadIdx.x; asm volatile("" : "+v"(tid_)); const int tid = tid_, wid = __builtin_amdgcn_readfirstlane(tid >> 6), lane = tid & 63, wr = wid >> 2, wc = wid & 3, fr = lane & 15, fq = lane >> 4;
    const int K = g.K, nt = K / BK;
    unsigned voffA[2], voffB[2];
#pragma unroll
    for (int i = 0; i < 2; ++i) { int R, C; stage_rc(tid * 16 + i * 8192, R, C); const int Rb = Epi::PERM ? ((R & ~31) + perm32(R & 31)) : R;
        voffA[i] = (unsigned)(R * K + C) * 2u; voffB[i] = (unsigned)(Rb * K + C) * 2u; }
    const size_t kstep = (size_t)(BK * 2);
    const size_t hstep = (size_t)HALF * K * 2;
    const size_t tstep = 2 * hstep;
    const unsigned ldsw = (unsigned)wid * 1024u;
    const int aoff = lds_byte(wr * 64 + fr, fq * 8), boff = lds_byte(wc * 32 + fr, fq * 8);
#define PG8_SA(b, h) (((b) * 2 + (h)) * HTB)
#define PG8_SB(b, h) ((4 + (b) * 2 + (h)) * HTB)
#define PG8_STAGE(bufoff, gbase, voff) do { _Pragma("unroll") for (int _i = 0; _i < 2; ++_i) \
        __builtin_amdgcn_global_load_lds((const unsigned*)((const char*)(gbase) + (voff)[_i]), (PG8_LAS unsigned*)(lds + (bufoff) + ldsw + _i * 8192), 16, 0, 0); } while (0)
#define PG8_LDA(dst, b, h) do { _Pragma("unroll") for (int m = 0; m < 4; ++m) _Pragma("unroll") for (int k = 0; k < 2; ++k) dst[m][k] = *(const PG8_LAS bf16x8*)(lds + PG8_SA(b, h) + aoff + m * 2048 + k * 1024); } while (0)
#define PG8_LDB(dst, b, h) do { _Pragma("unroll") for (int n = 0; n < 2; ++n) _Pragma("unroll") for (int k = 0; k < 2; ++k) dst[n][k] = *(const PG8_LAS bf16x8*)(lds + PG8_SB(b, h) + boff + n * 2048 + k * 1024); } while (0)
#define PG8_MMA(ai, bj, At, Bt) do { __builtin_amdgcn_s_setprio(1); _Pragma("unroll") for (int m = 0; m < 4; ++m) _Pragma("unroll") for (int n = 0; n < 2; ++n) _Pragma("unroll") for (int k = 0; k < 2; ++k) \
        acc[ai][bj][m][n] = __builtin_amdgcn_mfma_f32_16x16x32_bf16(Bt[n][k], At[m][k], acc[ai][bj][m][n], 0, 0, 0); __builtin_amdgcn_s_setprio(0); } while (0)
#define PG8_WAIT_V(n) asm volatile("s_waitcnt vmcnt(" #n ")" ::: "memory")
#define PG8_WAIT_L(n) asm volatile("s_waitcnt lgkmcnt(" #n ")" ::: "memory")
#define PG8_BAR __builtin_amdgcn_s_barrier()
#define PG8_SCHED __builtin_amdgcn_sched_barrier(0)
    Unit cur, nxt; int ui = 0;
    if (!S.next(0, cur)) return;
    f32x4 acc[2][2][4][2];
#pragma unroll
    for (int a = 0; a < 2; ++a)
#pragma unroll
        for (int b = 0; b < 2; ++b)
#pragma unroll
            for (int m = 0; m < 4; ++m)
#pragma unroll
                for (int n = 0; n < 2; ++n) acc[a][b][m][n] = (f32x4){0.f, 0.f, 0.f, 0.f};
    bf16x8 At[4][2], B0[2][2], B1[2][2];
    const char* cA = (const char*)g.A + (size_t)cur.pm * tstep; const char* cB = (const char*)g.Bt + (size_t)cur.pn * tstep;
    S.a_ready(cur);
    if constexpr (SP2) {
        PG8_STAGE(PG8_SB(0, 0), cB, voffB); PG8_STAGE(PG8_SB(0, 1), cB + hstep, voffB); PG8_STAGE(PG8_SA(0, 0), cA, voffA); PG8_STAGE(PG8_SA(0, 1), cA + hstep, voffA);
        if (wr == 1) PG8_BAR;
        PG8_WAIT_V(2); PG8_BAR;
        PG8_STAGE(PG8_SB(1, 0), cB + kstep, voffB); PG8_STAGE(PG8_SA(1, 0), cA + kstep, voffA); PG8_STAGE(PG8_SB(1, 1), cB + hstep + kstep, voffB);
        PG8_WAIT_V(6); PG8_BAR;
    } else {
        PG8_STAGE(PG8_SB(0, 0), cB, voffB); PG8_STAGE(PG8_SA(0, 0), cA, voffA); PG8_STAGE(PG8_SB(0, 1), cB + hstep, voffB); PG8_STAGE(PG8_SA(0, 1), cA + hstep, voffA);
        if (wr == 1) PG8_BAR;
        PG8_WAIT_V(4); PG8_BAR;
        PG8_STAGE(PG8_SB(1, 0), cB + kstep, voffB); PG8_STAGE(PG8_SA(1, 0), cA + kstep, voffA); PG8_STAGE(PG8_SB(1, 1), cB + hstep + kstep, voffB);
        PG8_WAIT_V(6); PG8_BAR;
    }
    for (;;) {
        const bool has_next = S.next(ui + 1, nxt);
        const char* nA = has_next ? (const char*)g.A + (size_t)nxt.pm * tstep : cA; const char* nB = has_next ? (const char*)g.Bt + (size_t)nxt.pn * tstep : cB;
        for (int t = 0; t < nt; t += 2) {
            const bool last = (t == nt - 2);
            const char* a1 = cA + (size_t)(t + 1) * kstep;
            const char* a2 = last ? nA : cA + (size_t)(t + 2) * kstep; const char* b2 = last ? nB : cB + (size_t)(t + 2) * kstep;
            const char* a3 = a2 + kstep; const char* b3 = b2 + kstep;
            if (last && has_next) S.a_ready(nxt);
            if constexpr (SP2) {
            PG8_LDB(B0, 0, 0); PG8_LDB(B1, 0, 1); PG8_SCHED; PG8_LDA(At, 0, 0); PG8_STAGE(PG8_SA(1, 1), a1 + hstep, voffA);
            PG8_WAIT_V(8); PG8_WAIT_L(0); PG8_BAR; PG8_MMA(0, 0, At, B0); PG8_MMA(0, 1, At, B1); PG8_BAR; PG8_SCHED;
            PG8_LDA(At, 0, 1); PG8_STAGE(PG8_SB(0, 0), b2, voffB); PG8_STAGE(PG8_SB(0, 1), b2 + hstep, voffB); PG8_STAGE(PG8_SA(0, 0), a2, voffA);
            PG8_WAIT_V(8); PG8_WAIT_L(0); PG8_BAR; PG8_MMA(1, 0, At, B0); PG8_MMA(1, 1, At, B1); PG8_BAR; PG8_SCHED;
            PG8_LDB(B0, 1, 0); PG8_LDB(B1, 1, 1); PG8_SCHED; PG8_LDA(At, 1, 0); PG8_STAGE(PG8_SA(0, 1), a2 + hstep, voffA);
            PG8_WAIT_V(8); PG8_WAIT_L(0); PG8_BAR; PG8_MMA(0, 0, At, B0); PG8_MMA(0, 1, At, B1); PG8_BAR; PG8_SCHED;
            PG8_LDA(At, 1, 1); PG8_STAGE(PG8_SB(1, 0), b3, voffB); PG8_STAGE(PG8_SB(1, 1), b3 + hstep, voffB); PG8_STAGE(PG8_SA(1, 0), a3, voffA);
            PG8_WAIT_V(8); PG8_WAIT_L(0); PG8_BAR; PG8_MMA(1, 0, At, B0); PG8_MMA(1, 1, At, B1); PG8_BAR; PG8_SCHED;
            } else {
            PG8_LDB(B0, 0, 0); PG8_SCHED; PG8_LDA(At, 0, 0); PG8_STAGE(PG8_SA(1, 1), a1 + hstep, voffA);
            PG8_WAIT_L(8); PG8_BAR; PG8_WAIT_L(0); PG8_MMA(0, 0, At, B0); PG8_BAR; PG8_SCHED;
            PG8_LDB(B1, 0, 1); PG8_STAGE(PG8_SB(0, 0), b2, voffB);
            PG8_BAR; PG8_WAIT_L(0); PG8_MMA(0, 1, At, B1); PG8_BAR;
            PG8_LDA(At, 0, 1); PG8_STAGE(PG8_SA(0, 0), a2, voffA);
            PG8_BAR; PG8_WAIT_L(0); PG8_MMA(1, 0, At, B0); PG8_BAR; PG8_SCHED;
            PG8_STAGE(PG8_SB(0, 1), b2 + hstep, voffB);
            PG8_WAIT_V(6); PG8_BAR; PG8_MMA(1, 1, At, B1); PG8_BAR;
            PG8_LDB(B0, 1, 0); PG8_SCHED; PG8_LDA(At, 1, 0); PG8_STAGE(PG8_SA(0, 1), a2 + hstep, voffA);
            PG8_WAIT_L(8); PG8_BAR; PG8_WAIT_L(0); PG8_MMA(0, 0, At, B0); PG8_BAR; PG8_SCHED;
            PG8_LDB(B1, 1, 1); PG8_STAGE(PG8_SB(1, 0), b3, voffB);
            PG8_BAR; PG8_WAIT_L(0); PG8_MMA(0, 1, At, B1); PG8_BAR;
            PG8_LDA(At, 1, 1); PG8_STAGE(PG8_SA(1, 0), a3, voffA);
            PG8_BAR; PG8_WAIT_L(0); PG8_MMA(1, 0, At, B0); PG8_BAR; PG8_SCHED;
            PG8_STAGE(PG8_SB(1, 1), b3 + hstep, voffB);
            PG8_WAIT_V(6); PG8_BAR; PG8_MMA(1, 1, At, B1); PG8_BAR;
            }
        }
        if constexpr (ALIGN_EPI) { if (wr == 0) PG8_BAR; }
        if constexpr (!Epi::AFTER_DRAIN) { E(acc, cur, wr, wc, fr, fq); S.done(cur); }
        if (!has_next) break;
#pragma unroll
        for (int a = 0; a < 2; ++a)
#pragma unroll
            for (int b = 0; b < 2; ++b)
#pragma unroll
                for (int m = 0; m < 4; ++m)
#pragma unroll
                    for (int n = 0; n < 2; ++n) acc[a][b][m][n] = (f32x4){0.f, 0.f, 0.f, 0.f};
        cur = nxt; cA = nA; cB = nB; ++ui;
        if constexpr (ALIGN_EPI) { if (wr == 1) PG8_BAR; }
    }
    PG8_WAIT_V(0);
    if constexpr (!ALIGN_EPI) { if (wr == 0) PG8_BAR; }
    PG8_BAR;
    if constexpr (Epi::AFTER_DRAIN) { E.fused(acc, cur, wr, wc, fr, fq, lds, wid, lane); S.done(cur); }
#undef PG8_SA
#undef PG8_SB
#undef PG8_STAGE
#undef PG8_LDA
#undef PG8_LDB
#undef PG8_MMA
#undef PG8_WAIT_V
#undef PG8_WAIT_L
#undef PG8_BAR
#undef PG8_SCHED
}
}

#define LAS __attribute__((address_space(3)))
typedef unsigned short bf16_t;
typedef unsigned u32x4 __attribute__((ext_vector_type(4)));
typedef unsigned u32x2 __attribute__((ext_vector_type(2)));
typedef float f32x4 __attribute__((ext_vector_type(4)));
typedef float f32x16 __attribute__((ext_vector_type(16)));
typedef short bf16x8 __attribute__((ext_vector_type(8)));
typedef short s16x4 __attribute__((ext_vector_type(4)));

constexpr int D = 1024, NB = 32, SEQ = 2048, DB = 32, DS = 32, NH = 16, HD = 64, DFF = 2816;
constexpr int MP = NB * SEQ;
constexpr int MS = DB * DS;
constexpr int M = MP + MS;
constexpr int CROWS = 512;
constexpr float EPS = 1e-6f;
constexpr float LOG2E = 1.4426950408889634f;
constexpr float QSCALE = 0.125f * LOG2E;
constexpr int NWAVES = 8;
#ifndef REP_KVOUT
#define REP_KVOUT 1
#endif
#ifndef REP_SAMPLE
#define REP_SAMPLE 1
#endif
#ifndef REP_PROMPT
#define REP_PROMPT 1
#endif

constexpr size_t O_Y = 0;
constexpr size_t O_CONVP = (size_t)M * D;
constexpr size_t O_CONVS = O_CONVP + 65536;
constexpr size_t O_KP = O_CONVS + 65536;
constexpr size_t O_VP = O_KP + (size_t)NB * CROWS * D;
constexpr size_t O_KS = O_VP + (size_t)NB * CROWS * D;
constexpr size_t O_VS = O_KS + (size_t)MS * D;
constexpr size_t O_END = O_VS + (size_t)MS * D;

constexpr size_t MiB = 1u << 20;
constexpr size_t WS_WIN = 0, WS_WOUT = 6 * MiB, WS_WGU0 = 8 * MiB, WS_WGU1 = 19 * MiB, WS_WD0 = 30 * MiB, WS_WD1 = 30 * MiB + 5632 * 1024,
                 WS_WQKV = 41 * MiB, WS_WO = 47 * MiB, WS_KC = 50 * MiB, WS_VC = 82 * MiB, WS_CTL = 120 * MiB;
constexpr size_t WS_XN = 128 * MiB, WS_A = 258 * MiB, WS_B = 388 * MiB, WS_C = 518 * MiB, WS_MO = 648 * MiB, WS_O = 128 * MiB  , WS_XR = 778 * MiB, WS_END = 908 * MiB;

constexpr int LDS_BYTES = 131072 + 8192;

__device__ __forceinline__ float bf2f(unsigned short b) { return __uint_as_float(((unsigned)b) << 16); }
__device__ __forceinline__ float bflo(unsigned w) { return __uint_as_float(w << 16); }
__device__ __forceinline__ float bfhi(unsigned w) { return __uint_as_float(w & 0xffff0000u); }
__device__ __forceinline__ unsigned pk2(float lo, float hi) { return pg8::cvt_pk_bf16(lo, hi); }
__device__ __forceinline__ float wave_sum(float v) {
#pragma unroll
    for (int o = 1; o < 64; o <<= 1) v += __shfl_xor(v, o);
    return v;
}

namespace pg8 {
struct EpiConvIn {
    static constexpr bool PERM = true, AFTER_DRAIN = false;
    bf16_t* Bg; bf16_t* U;
    __device__ __forceinline__ void operator()(const f32x4 (&acc)[2][2][4][2], const Unit& u, int wr, int wc, int fr, int fq) const {
        const int row0 = u.pm * BM + wr * 64 + fr;
        if (u.pn < 4) {
            const int col0 = u.pn * BM + wc * 32 + 8 * fq;
#pragma unroll
            for (int ai = 0; ai < 2; ++ai)
#pragma unroll
                for (int m = 0; m < 4; ++m) { bf16_t* rowp = Bg + (size_t)(row0 + ai * HALF + m * 16) * 1024 + col0;
#pragma unroll
                    for (int bj = 0; bj < 2; ++bj) { const f32x4 v0 = acc[ai][bj][m][0], v1 = acc[ai][bj][m][1];
                        u32x4 w; w.x = cvt_pk_bf16(v0[0], v0[1]); w.y = cvt_pk_bf16(v0[2], v0[3]); w.z = cvt_pk_bf16(v1[0], v1[1]); w.w = cvt_pk_bf16(v1[2], v1[3]);
                        *(u32x4*)(rowp + bj * HALF) = w; } }
        } else {
            const int col0 = (u.pn - 4) * HALF + wc * 32 + 8 * fq;
#pragma unroll
            for (int ai = 0; ai < 2; ++ai)
#pragma unroll
                for (int m = 0; m < 4; ++m) { bf16_t* rowp = U + (size_t)(row0 + ai * HALF + m * 16) * 1024 + col0;
                    const f32x4 v0 = acc[ai][0][m][0] * acc[ai][1][m][0], v1 = acc[ai][0][m][1] * acc[ai][1][m][1];
                    u32x4 w; w.x = cvt_pk_bf16(v0[0], v0[1]); w.y = cvt_pk_bf16(v0[2], v0[3]); w.z = cvt_pk_bf16(v1[0], v1[1]); w.w = cvt_pk_bf16(v1[2], v1[3]);
                    *(u32x4*)(rowp) = w; }
        }
    }
};
struct EpiSwiGLU {
    static constexpr bool PERM = true, AFTER_DRAIN = false;
    bf16_t* H;
    __device__ __forceinline__ float act(float g, float uu) const { return g * uu * __builtin_amdgcn_rcpf(1.0f + __builtin_amdgcn_exp2f(-1.4426950408889634f * g)); }
    __device__ __forceinline__ void operator()(const f32x4 (&acc)[2][2][4][2], const Unit& u, int wr, int wc, int fr, int fq) const {
        const int row0 = u.pm * BM + wr * 64 + fr;
        const int col0 = u.pn * HALF + wc * 32 + 8 * fq;
#pragma unroll
        for (int ai = 0; ai < 2; ++ai)
#pragma unroll
            for (int m = 0; m < 4; ++m) { bf16_t* rowp = H + (size_t)(row0 + ai * HALF + m * 16) * 2816 + col0;
                const f32x4 g0 = acc[ai][0][m][0], g1 = acc[ai][0][m][1], u0 = acc[ai][1][m][0], u1 = acc[ai][1][m][1];
                u32x4 w; w.x = cvt_pk_bf16(act(g0[0], u0[0]), act(g0[1], u0[1])); w.y = cvt_pk_bf16(act(g0[2], u0[2]), act(g0[3], u0[3]));
                w.z = cvt_pk_bf16(act(g1[0], u1[0]), act(g1[1], u1[1])); w.w = cvt_pk_bf16(act(g1[2], u1[2]), act(g1[3], u1[3]));
                *(u32x4*)(rowp) = w; }
    }
};
}

struct Args {
    const float *x_prompt, *x_sample, *state_conv, *cache_k, *cache_v, *conv_w_in, *conv_kernel, *conv_w_out, *attn_w_qkv, *attn_w_o, *attn_rel_bias,
        *norm_mix_pre, *norm_mix_post, *norm_ffn_pre, *norm_ffn_post, *ffn_w_gate_up, *ffn_w_down;
    float* out; unsigned char* ws;
};

template <int MODE> __device__ __forceinline__ int dest_row(int n) {
    if (MODE == 1) { const int hh = n / DFF, rem = n - hh * DFF; return ((rem >> 7) << 8) + (hh << 7) + (rem & 127); }
    if (MODE == 2) { if (n < 1024) return n; const int np = n - 1024, hh = np >> 10, rem = np & 1023; return 1024 + ((rem >> 7) << 8) + (hh << 7) + (rem & 127); }
    return n;
}
template <int MODE> __device__ __forceinline__ void transpose_item(const float* W, int K, int N, bf16_t* WT, LAS float* scr, int item, int lane) {
    const int nblk = N / 32, kb = item / nblk, nb = item % nblk, k0 = 64 * kb, n0 = 32 * nb;
#pragma unroll 8
    for (int i = 0; i < 32; ++i) { const int kk = 2 * i + (lane >> 5); scr[kk * 33 + (lane & 31)] = W[(size_t)(k0 + kk) * N + n0 + (lane & 31)]; }
    asm volatile("s_waitcnt lgkmcnt(0)" ::: "memory");
    const int c = lane & 7; const int drow = dest_row<MODE>(n0);
#pragma unroll
    for (int j = 0; j < 4; ++j) { const int n = (lane >> 3) + 8 * j; const LAS float* s = scr + (8 * c) * 33 + n;
        u32x4 o; o.x = pk2(s[0 * 33], s[1 * 33]); o.y = pk2(s[2 * 33], s[3 * 33]); o.z = pk2(s[4 * 33], s[5 * 33]); o.w = pk2(s[6 * 33], s[7 * 33]);
        *(u32x4*)(WT + (size_t)(drow + n) * K + k0 + 8 * c) = o; }
    asm volatile("s_waitcnt lgkmcnt(0)" ::: "memory");
}

__device__ __forceinline__ void norm_row(const float* xrow, const float* g, bf16_t* orow, int lane) {
    const f32x4* xr = (const f32x4*)xrow + lane; const f32x4* gr = (const f32x4*)g + lane;
    f32x4 v[4]; float s = 0.f;
#pragma unroll
    for (int j = 0; j < 4; ++j) { v[j] = xr[64 * j]; s += (v[j].x * v[j].x + v[j].y * v[j].y) + (v[j].z * v[j].z + v[j].w * v[j].w); }
    const float inv = 1.0f / sqrtf(wave_sum(s) * (1.f / D) + EPS);
    u32x2* o8 = (u32x2*)orow + lane;
#pragma unroll
    for (int j = 0; j < 4; ++j) { const f32x4 gg = gr[64 * j]; u32x2 w; w.x = pk2(v[j].x * inv * gg.x, v[j].y * inv * gg.y); w.y = pk2(v[j].z * inv * gg.z, v[j].w * inv * gg.w); o8[64 * j] = w; }
}
template <int XIN, int XOUT> __device__ __forceinline__ void res_pass(const Args& a, const bf16_t* MO, bf16_t* XR, bf16_t* XN, float* Y, const float* gp, const float* gn, int gw, int NGW, int lane) {
    const f32x4* gr = (const f32x4*)gp + lane;
    for (int m0 = gw; m0 < M; m0 += 2 * NGW) {
        int mm[2]; mm[0] = m0; mm[1] = (m0 + NGW < M) ? m0 + NGW : m0;
        f32x4 mv[2][4], xv[2][4]; float s[2] = {0.f, 0.f};
#pragma unroll
        for (int k = 0; k < 2; ++k) {
            const int m = mm[k];
            const u32x2* mr = (const u32x2*)(MO + (size_t)m * D) + lane;
#pragma unroll
            for (int j = 0; j < 4; ++j) { const u32x2 w = mr[64 * j]; mv[k][j] = (f32x4){bflo(w.x), bfhi(w.x), bflo(w.y), bfhi(w.y)}; }
            if (XIN == 0) { const float* xr = m < MP ? a.x_prompt + (size_t)m * D : a.x_sample + (size_t)(m - MP) * D;
#pragma unroll
                for (int j = 0; j < 4; ++j) xv[k][j] = ((const f32x4*)xr + lane)[64 * j];
            } else { const u32x2* xr = (const u32x2*)(XR + (size_t)m * D) + lane;
#pragma unroll
                for (int j = 0; j < 4; ++j) { const u32x2 w = xr[64 * j]; xv[k][j] = (f32x4){bflo(w.x), bfhi(w.x), bflo(w.y), bfhi(w.y)}; } }
        }
#pragma unroll
        for (int k = 0; k < 2; ++k)
#pragma unroll
            for (int j = 0; j < 4; ++j) s[k] += (mv[k][j].x * mv[k][j].x + mv[k][j].y * mv[k][j].y) + (mv[k][j].z * mv[k][j].z + mv[k][j].w * mv[k][j].w);
        float inv[2], s2[2] = {0.f, 0.f};
#pragma unroll
        for (int k = 0; k < 2; ++k) inv[k] = 1.0f / sqrtf(wave_sum(s[k]) * (1.f / D) + EPS);
#pragma unroll
        for (int k = 0; k < 2; ++k)
#pragma unroll
            for (int j = 0; j < 4; ++j) { const f32x4 gg = gr[64 * j]; xv[k][j] = xv[k][j] + mv[k][j] * inv[k] * gg;
                s2[k] += (xv[k][j].x * xv[k][j].x + xv[k][j].y * xv[k][j].y) + (xv[k][j].z * xv[k][j].z + xv[k][j].w * xv[k][j].w); }
        if (XOUT == 1) {
#pragma unroll
            for (int k = 0; k < 2; ++k) { f32x4* xo = (f32x4*)(Y + (size_t)mm[k] * D) + lane;
#pragma unroll
                for (int j = 0; j < 4; ++j) xo[64 * j] = xv[k][j]; }
        } else {
            const f32x4* g2 = (const f32x4*)gn + lane;
#pragma unroll
            for (int k = 0; k < 2; ++k) {
                const float inv2 = 1.0f / sqrtf(wave_sum(s2[k]) * (1.f / D) + EPS);
                u32x2* xo = (u32x2*)(XR + (size_t)mm[k] * D) + lane; u32x2* o8 = (u32x2*)(XN + (size_t)mm[k] * D) + lane;
#pragma unroll
                for (int j = 0; j < 4; ++j) { const f32x4 gg = g2[64 * j]; const f32x4 x = xv[k][j];
                    u32x2 wx; wx.x = pk2(x.x, x.y); wx.y = pk2(x.z, x.w); xo[64 * j] = wx;
                    u32x2 w; w.x = pk2(x.x * inv2 * gg.x, x.y * inv2 * gg.y); w.y = pk2(x.z * inv2 * gg.z, x.w * inv2 * gg.w); o8[64 * j] = w; }
            }
        }
    }
}

namespace att {
__device__ __forceinline__ int crow(int i, int h) { return (i & 3) + 8 * (i >> 2) + 4 * h; }
typedef short v4i16_t __attribute__((ext_vector_type(4)));
__device__ __forceinline__ s16x4 vtr(const LAS unsigned char* p) { return __builtin_bit_cast(s16x4, __builtin_amdgcn_ds_read_tr16_b64_v4i16((LAS v4i16_t*)p)); }
struct Item { const bf16_t* q; const bf16_t* kc; const bf16_t* vc; const bf16_t* kn; const bf16_t* vn; bf16_t* o; float* kso; float* vso; int nc, kt0, kt1, qpos0, head; };

__device__ __forceinline__ void load_tile(const Item& it, int kt, int lane, bf16x8 (&kf)[4], u32x4 (&vr)[4]) {
    const int r = lane & 31, h = lane >> 5;
    const bf16_t* kp = kt < it.nc ? it.kc + (size_t)kt * 32 * 1024 : it.kn + (size_t)(kt - it.nc) * 32 * 1024;
    const bf16_t* vp = kt < it.nc ? it.vc + (size_t)kt * 32 * 1024 : it.vn + (size_t)(kt - it.nc) * 32 * 1024;
#pragma unroll
    for (int s = 0; s < 4; ++s) kf[s] = *(const bf16x8*)(kp + (size_t)r * 1024 + 16 * s + 8 * h);
#pragma unroll
    for (int i = 0; i < 4; ++i) vr[i] = *(const u32x4*)(vp + (size_t)((lane >> 3) + 8 * i) * 1024 + (lane & 7) * 8);
}

__device__ __forceinline__ void attn_item(const Item& it, LAS unsigned char* vlds, LAS float* tab, const float* table, int lane) {
    const int r = lane & 31, h = lane >> 5;
    asm volatile("s_waitcnt lgkmcnt(0)" ::: "memory");
    for (int i = lane; i < 257; i += 64) tab[i] = table[it.head * 257 + i] * LOG2E;
    bf16x8 qf[4];
#pragma unroll
    for (int s = 0; s < 4; ++s) qf[s] = *(const bf16x8*)(it.q + (size_t)r * 1024 + 16 * s + 8 * h);
    f32x16 o0, o1;
#pragma unroll
    for (int i = 0; i < 16; ++i) { o0[i] = 0.f; o1[i] = 0.f; }
    float mrun = -1e30f, lrun = 0.f;
    asm volatile("s_waitcnt lgkmcnt(0)" ::: "memory");
    const float cfar = tab[256];
    const int qpos = it.qpos0 + r;
    const int i16 = lane & 15, q4 = i16 >> 2, p4 = i16 & 3, g = (lane >> 4) & 1;
    const LAS unsigned char* trbase = vlds + (4 * h + q4) * 128 + (16 * g + 4 * p4) * 2;
    bf16x8 kf[4]; u32x4 vr[4];
    load_tile(it, it.kt0, lane, kf, vr);
    for (int kt = it.kt0; kt < it.kt1; ++kt) {
        bf16x8 kn_[4]; u32x4 vn_[4];
        if (kt + 1 < it.kt1) load_tile(it, kt + 1, lane, kn_, vn_);
        else {
#pragma unroll
            for (int s = 0; s < 4; ++s) { kn_[s] = kf[s]; vn_[s] = vr[s]; }
        }
        asm volatile("s_waitcnt lgkmcnt(0)" ::: "memory");
#pragma unroll
        for (int i = 0; i < 4; ++i) *(LAS u32x4*)(vlds + ((lane >> 3) + 8 * i) * 128 + (lane & 7) * 16) = vr[i];
        f32x16 p;
#pragma unroll
        for (int i = 0; i < 16; ++i) p[i] = 0.f;
#pragma unroll
        for (int s = 0; s < 4; ++s) p = __builtin_amdgcn_mfma_f32_32x32x16_bf16(kf[s], qf[s], p, 0, 0, 0);
        const int kb = 32 * kt;
        if (it.qpos0 - (kb + 31) >= 128) {
#pragma unroll
            for (int i = 0; i < 16; ++i) p[i] += cfar;
        } else {
#pragma unroll
            for (int i = 0; i < 16; ++i) { int dd = qpos - (kb + crow(i, h)); dd = dd < -128 ? -128 : (dd > 128 ? 128 : dd); p[i] += tab[dd + 128]; }
        }
        float tm = p[0];
#pragma unroll
        for (int i = 1; i < 16; ++i) tm = fmaxf(tm, p[i]);
        tm = fmaxf(tm, __shfl_xor(tm, 32));
        const float mnew = fmaxf(mrun, tm);
        const float sc = __builtin_amdgcn_exp2f(mrun - mnew);
        mrun = mnew;
        float ps = 0.f;
#pragma unroll
        for (int i = 0; i < 16; ++i) { p[i] = __builtin_amdgcn_exp2f(p[i] - mnew); ps += p[i]; }
        lrun = lrun * sc + ps;
#pragma unroll
        for (int i = 0; i < 16; ++i) { o0[i] *= sc; o1[i] *= sc; }
        u32x4 w0, w1;
        w0.x = pk2(p[0], p[1]); w0.y = pk2(p[2], p[3]); w0.z = pk2(p[4], p[5]); w0.w = pk2(p[6], p[7]);
        w1.x = pk2(p[8], p[9]); w1.y = pk2(p[10], p[11]); w1.z = pk2(p[12], p[13]); w1.w = pk2(p[14], p[15]);
        const bf16x8 pf0 = __builtin_bit_cast(bf16x8, w0), pf1 = __builtin_bit_cast(bf16x8, w1);
        asm volatile("s_waitcnt lgkmcnt(0)" ::: "memory");
#pragma unroll
        for (int s = 0; s < 2; ++s) {
            const s16x4 a_lo = vtr(trbase + (16 * s) * 128), a_hi = vtr(trbase + (16 * s + 8) * 128);
            const s16x4 b_lo = vtr(trbase + (16 * s) * 128 + 64), b_hi = vtr(trbase + (16 * s + 8) * 128 + 64);
            const bf16x8 va = __builtin_shufflevector(a_lo, a_hi, 0, 1, 2, 3, 4, 5, 6, 7), vb = __builtin_shufflevector(b_lo, b_hi, 0, 1, 2, 3, 4, 5, 6, 7);
            o0 = __builtin_amdgcn_mfma_f32_32x32x16_bf16(va, s == 0 ? pf0 : pf1, o0, 0, 0, 0);
            o1 = __builtin_amdgcn_mfma_f32_32x32x16_bf16(vb, s == 0 ? pf0 : pf1, o1, 0, 0, 0);
        }
#pragma unroll
        for (int s = 0; s < 4; ++s) { kf[s] = kn_[s]; vr[s] = vn_[s]; }
    }
    if (it.kso) {
        load_tile(it, it.nc, lane, kf, vr);
#pragma unroll
        for (int s = 0; s < 4; ++s) { const u32x4 w = __builtin_bit_cast(u32x4, kf[s]); float* d = it.kso + (size_t)r * 1024 + 16 * s + 8 * h;
            *(f32x4*)d = (f32x4){bflo(w.x), bfhi(w.x), bflo(w.y), bfhi(w.y)}; *(f32x4*)(d + 4) = (f32x4){bflo(w.z), bfhi(w.z), bflo(w.w), bfhi(w.w)}; }
#pragma unroll
        for (int i = 0; i < 4; ++i) { const u32x4 w = vr[i]; float* d = it.vso + (size_t)((lane >> 3) + 8 * i) * 1024 + (lane & 7) * 8;
            *(f32x4*)d = (f32x4){bflo(w.x), bfhi(w.x), bflo(w.y), bfhi(w.y)}; *(f32x4*)(d + 4) = (f32x4){bflo(w.z), bfhi(w.z), bflo(w.w), bfhi(w.w)}; }
    }
    lrun += __shfl_xor(lrun, 32);
    const float inv = 1.0f / lrun;
    bf16_t* orow = it.o + (size_t)r * 1024 + 4 * h;
#pragma unroll
    for (int g4 = 0; g4 < 4; ++g4) {
        u32x2 a, b;
        a.x = pk2(o0[4 * g4] * inv, o0[4 * g4 + 1] * inv); a.y = pk2(o0[4 * g4 + 2] * inv, o0[4 * g4 + 3] * inv);
        b.x = pk2(o1[4 * g4] * inv, o1[4 * g4 + 1] * inv); b.y = pk2(o1[4 * g4 + 2] * inv, o1[4 * g4 + 3] * inv);
        *(u32x2*)(orow + 8 * g4) = a; *(u32x2*)(orow + 32 + 8 * g4) = b;
    }
}

constexpr int KROW = 144, KTILE = 64 * KROW, VTILE = 64 * 128, A_K = 0, A_V = 2 * KTILE, A_TAB = A_V + 2 * VTILE, A_SLOT = A_TAB + 1296;
__device__ __forceinline__ float max3f(float a, float b, float c) { float r; asm("v_max3_f32 %0, %1, %2, %3" : "=v"(r) : "v"(a), "v"(b), "v"(c)); return r; }
__device__ __forceinline__ void attn_unit(int b, int hh, int cq, const bf16_t* Qg, const bf16_t* Kg, const bf16_t* Vg, bf16_t* Og, float* kout, float* vout, const float* table, LAS unsigned char* lds, int tid, int lane, int wave) {
    constexpr float THR = 8.0f;
    const int r = lane & 31, h = lane >> 5;
    const int c = 4 * cq + (wave >> 1), half = wave & 1;
    const int j0 = (4 * cq - 8) > 0 ? (4 * cq - 8) : 0, j1 = 4 * cq + 3;
    const size_t rb = (size_t)b * SEQ;
    LAS float* tab = (LAS float*)(lds + A_TAB);
    if (tid < 324) tab[tid] = table[hh * 257 + (tid < 256 ? tid : 256)] * LOG2E;
    const int lrow = tid >> 3, lch = tid & 7;
    const bf16_t* kgp = Kg + (rb + lrow) * D + hh * HD + lch * 8; const bf16_t* vgp = Vg + (rb + lrow) * D + hh * HD + lch * 8;
    const int kwoff = A_K + lrow * KROW + lch * 16, vwoff = A_V + lrow * 128 + ((lch ^ (((lrow >> 1) & 1) << 2)) << 4);
    const long korow = (long)b * CROWS - (SEQ - CROWS) + lrow; float* kop = kout + korow * D + hh * HD + lch * 8; float* vop = vout + korow * D + hh * HD + lch * 8;
#define ATT_KVOUT(tile) do { if (cq >= 6 && (tile) >= 4 * cq) { float* kd = kop + (long)(tile) * 64 * D; float* vd = vop + (long)(tile) * 64 * D; \
        *(f32x4*)kd = (f32x4){bflo(kreg.x), bfhi(kreg.x), bflo(kreg.y), bfhi(kreg.y)}; *(f32x4*)(kd + 4) = (f32x4){bflo(kreg.z), bfhi(kreg.z), bflo(kreg.w), bfhi(kreg.w)}; \
        *(f32x4*)vd = (f32x4){bflo(vreg.x), bfhi(vreg.x), bflo(vreg.y), bfhi(vreg.y)}; *(f32x4*)(vd + 4) = (f32x4){bflo(vreg.z), bfhi(vreg.z), bflo(vreg.w), bfhi(vreg.w)}; } } while (0)
    u32x4 kreg = *(const u32x4*)(kgp + (size_t)j0 * 64 * D), vreg = *(const u32x4*)(vgp + (size_t)j0 * 64 * D);
    bf16x8 qf[4];
    const bf16_t* qp = Qg + (rb + 64 * c + 32 * half + r) * D + hh * HD + 8 * h;
#pragma unroll
    for (int s = 0; s < 4; ++s) qf[s] = *(const bf16x8*)(qp + 16 * s);
    *(LAS u32x4*)(lds + kwoff) = kreg; *(LAS u32x4*)(lds + vwoff) = vreg;
    ATT_KVOUT(j0);
    kreg = *(const u32x4*)(kgp + (size_t)(j0 + 1) * 64 * D); vreg = *(const u32x4*)(vgp + (size_t)(j0 + 1) * 64 * D);
    f32x16 o0, o1;
#pragma unroll
    for (int i = 0; i < 16; ++i) { o0[i] = 0.f; o1[i] = 0.f; }
    float mrun = 0.f, lrun = 0.f;
    const int i16 = lane & 15, q4 = i16 >> 2, p4 = i16 & 3, g = (lane >> 4) & 1;
    const int troff = A_V + (4 * h + q4) * 128 + ((32 * g) ^ (((q4 >> 1) & 1) << 6)) + 8 * p4;
    const int kroff = A_K + r * KROW + 16 * h;
    __syncthreads();
    const float cfar = tab[256];
    f32x16 negf;
#pragma unroll
    for (int i = 0; i < 16; ++i) negf[i] = cfar;
    asm volatile("" : "+v"(negf));
    const int qpos = 64 * c + 32 * half + r;
    bool first = true;
    for (int j = j0; j <= j1; ++j) {
        const int bufk = ((j - j0) & 1) * KTILE, bufv = ((j - j0) & 1) * VTILE;
        if (j < j1) { const int nbk = ((j + 1 - j0) & 1) * KTILE, nbv = ((j + 1 - j0) & 1) * VTILE; *(LAS u32x4*)(lds + nbk + kwoff) = kreg; *(LAS u32x4*)(lds + nbv + vwoff) = vreg; ATT_KVOUT(j + 1); }
        if (j + 2 <= j1) { kreg = *(const u32x4*)(kgp + (size_t)(j + 2) * 64 * D); vreg = *(const u32x4*)(vgp + (size_t)(j + 2) * 64 * D); }
        if (j >= c - 8 && j <= c) {
            f32x16 p0, p1;
            bf16x8 ka[4], kb[4];
#pragma unroll
            for (int s = 0; s < 4; ++s) { ka[s] = *(const LAS bf16x8*)(lds + bufk + kroff + 32 * s); kb[s] = *(const LAS bf16x8*)(lds + bufk + kroff + 32 * KROW + 32 * s); }
            if (j <= c - 3) {
                p0 = __builtin_amdgcn_mfma_f32_32x32x16_bf16(ka[0], qf[0], negf, 0, 0, 0);
                p1 = __builtin_amdgcn_mfma_f32_32x32x16_bf16(kb[0], qf[0], negf, 0, 0, 0);
            } else {
                const LAS float* tb = tab + (qpos - 64 * j - 4 * h + 128 - 59);
#pragma unroll
                for (int i = 0; i < 16; ++i) { p0[i] = tb[59 - ((i & 3) + 8 * (i >> 2))] - mrun; p1[i] = tb[59 - 32 - ((i & 3) + 8 * (i >> 2))] - mrun; }
                p0 = __builtin_amdgcn_mfma_f32_32x32x16_bf16(ka[0], qf[0], p0, 0, 0, 0);
                p1 = __builtin_amdgcn_mfma_f32_32x32x16_bf16(kb[0], qf[0], p1, 0, 0, 0);
            }
#pragma unroll
            for (int s = 1; s < 4; ++s) {
                p0 = __builtin_amdgcn_mfma_f32_32x32x16_bf16(ka[s], qf[s], p0, 0, 0, 0);
                p1 = __builtin_amdgcn_mfma_f32_32x32x16_bf16(kb[s], qf[s], p1, 0, 0, 0);
            }
            float ta = max3f(p0[0], p0[1], p1[0]), tb2 = max3f(p0[2], p0[3], p1[1]);
            ta = max3f(ta, p1[2], p1[3]);
#pragma unroll
            for (int i = 4; i < 16; i += 4) { ta = max3f(ta, p0[i], p0[i + 1]); tb2 = max3f(tb2, p0[i + 2], p0[i + 3]); ta = max3f(ta, p1[i], p1[i + 1]); tb2 = max3f(tb2, p1[i + 2], p1[i + 3]); }
            float tm = fmaxf(ta, tb2);
            { auto rr = __builtin_amdgcn_permlane32_swap(__float_as_uint(tm), __float_as_uint(tm), false, false); tm = fmaxf(__uint_as_float(rr[0]), __uint_as_float(rr[1])); }
            if (first || __any(tm > THR)) {
                const float dl = first ? tm : fmaxf(tm, 0.f); mrun += dl;
                const float sc = __builtin_amdgcn_exp2f(-dl); lrun *= sc;
#pragma unroll
                for (int i = 0; i < 16; ++i) { p0[i] -= dl; p1[i] -= dl; o0[i] *= sc; o1[i] *= sc; negf[i] = cfar - mrun; }
                asm volatile("" : "+v"(negf));
                first = false;
            }
            float ps0 = 0.f, ps1 = 0.f;
#pragma unroll
            for (int i = 0; i < 16; ++i) { p0[i] = __builtin_amdgcn_exp2f(p0[i]); p1[i] = __builtin_amdgcn_exp2f(p1[i]); ps0 += p0[i]; ps1 += p1[i]; }
            lrun += ps0 + ps1;
            u32x4 w0, w1, w2, w3;
            w0.x = pk2(p0[0], p0[1]); w0.y = pk2(p0[2], p0[3]); w0.z = pk2(p0[4], p0[5]); w0.w = pk2(p0[6], p0[7]);
            w1.x = pk2(p0[8], p0[9]); w1.y = pk2(p0[10], p0[11]); w1.z = pk2(p0[12], p0[13]); w1.w = pk2(p0[14], p0[15]);
            w2.x = pk2(p1[0], p1[1]); w2.y = pk2(p1[2], p1[3]); w2.z = pk2(p1[4], p1[5]); w2.w = pk2(p1[6], p1[7]);
            w3.x = pk2(p1[8], p1[9]); w3.y = pk2(p1[10], p1[11]); w3.z = pk2(p1[12], p1[13]); w3.w = pk2(p1[14], p1[15]);
            const bf16x8 pf[4] = {__builtin_bit_cast(bf16x8, w0), __builtin_bit_cast(bf16x8, w1), __builtin_bit_cast(bf16x8, w2), __builtin_bit_cast(bf16x8, w3)};
#pragma unroll
            for (int ks = 0; ks < 4; ++ks) {
                const LAS unsigned char* tb = lds + bufv + troff + ks * 16 * 128;
                const s16x4 a_lo = vtr(tb), a_hi = vtr(tb + 8 * 128);
                const LAS unsigned char* tb1 = lds + bufv + (troff ^ 64) + ks * 16 * 128;
                const s16x4 b_lo = vtr(tb1), b_hi = vtr(tb1 + 8 * 128);
                const bf16x8 va = __builtin_shufflevector(a_lo, a_hi, 0, 1, 2, 3, 4, 5, 6, 7), vb = __builtin_shufflevector(b_lo, b_hi, 0, 1, 2, 3, 4, 5, 6, 7);
                o0 = __builtin_amdgcn_mfma_f32_32x32x16_bf16(va, pf[ks], o0, 0, 0, 0);
                o1 = __builtin_amdgcn_mfma_f32_32x32x16_bf16(vb, pf[ks], o1, 0, 0, 0);
            }
        }
        asm volatile("s_waitcnt lgkmcnt(0)\n\ts_barrier" ::: "memory");
    }
    lrun += __shfl_xor(lrun, 32);
    const float inv = 1.0f / lrun;
    bf16_t* orow = Og + (rb + 64 * c + 32 * half + r) * D + hh * HD + 4 * h;
#pragma unroll
    for (int g4 = 0; g4 < 4; ++g4) {
        u32x2 x, y;
        x.x = pk2(o0[4 * g4] * inv, o0[4 * g4 + 1] * inv); x.y = pk2(o0[4 * g4 + 2] * inv, o0[4 * g4 + 3] * inv);
        y.x = pk2(o1[4 * g4] * inv, o1[4 * g4 + 1] * inv); y.y = pk2(o1[4 * g4 + 2] * inv, o1[4 * g4 + 3] * inv);
        *(u32x2*)(orow + 8 * g4) = x; *(u32x2*)(orow + 32 + 8 * g4) = y;
    }
#undef ATT_KVOUT
}
}


__global__ void __launch_bounds__(NWAVES * 64, 2) fwd_kernel(Args a) {
    extern __shared__ __attribute__((aligned(16))) unsigned char lds_raw[];
    cg::grid_group grid = cg::this_grid();
    LAS unsigned char* lds = (LAS unsigned char*)lds_raw;
    const int tid = threadIdx.x, lane = tid & 63, wave = __builtin_amdgcn_readfirstlane(tid >> 6);
    const int G = gridDim.x, gw = blockIdx.x * NWAVES + wave, NGW = G * NWAVES;
    unsigned char* ws = a.ws;
    bf16_t* Win_t = (bf16_t*)(ws + WS_WIN); bf16_t* Wout_t = (bf16_t*)(ws + WS_WOUT);
    bf16_t* Wgu_t0 = (bf16_t*)(ws + WS_WGU0); bf16_t* Wgu_t1 = (bf16_t*)(ws + WS_WGU1);
    bf16_t* Wd_t0 = (bf16_t*)(ws + WS_WD0); bf16_t* Wd_t1 = (bf16_t*)(ws + WS_WD1);
    bf16_t* Wqkv_t = (bf16_t*)(ws + WS_WQKV); bf16_t* Wo_t = (bf16_t*)(ws + WS_WO);
    bf16_t* KC = (bf16_t*)(ws + WS_KC); bf16_t* VC = (bf16_t*)(ws + WS_VC);
    bf16_t* XN = (bf16_t*)(ws + WS_XN); bf16_t* BA = (bf16_t*)(ws + WS_A); bf16_t* BB = (bf16_t*)(ws + WS_B); bf16_t* BC = (bf16_t*)(ws + WS_C);
    bf16_t* MO = (bf16_t*)(ws + WS_MO); bf16_t* OB = (bf16_t*)(ws + WS_O); bf16_t* HB = BA; bf16_t* XR = (bf16_t*)(ws + WS_XR);
    float* Y = a.out + O_Y;
    unsigned* qctr = (unsigned*)(ws + WS_CTL);

    {
        LAS float* scr = (LAS float*)(lds + wave * 16384);
        if (blockIdx.x == 0 && tid == 0) *qctr = 0u;
        constexpr int I_IN = 16 * 96, I_OUT = 16 * 32, I_GU = 16 * 176, I_D = 44 * 32;
        constexpr int NITEMS = 2 * I_IN + 2 * I_OUT + 2 * I_GU + 2 * I_D;
        for (int it = gw; it < NITEMS; it += NGW) {
            int r = it;
            if (r < I_IN) { transpose_item<2>(a.conv_w_in, D, 3 * D, Win_t, scr, r, lane); continue; } r -= I_IN;
            if (r < I_OUT) { transpose_item<0>(a.conv_w_out, D, D, Wout_t, scr, r, lane); continue; } r -= I_OUT;
            if (r < I_GU) { transpose_item<1>(a.ffn_w_gate_up, D, 2 * DFF, Wgu_t0, scr, r, lane); continue; } r -= I_GU;
            if (r < I_GU) { transpose_item<1>(a.ffn_w_gate_up + (size_t)D * 2 * DFF, D, 2 * DFF, Wgu_t1, scr, r, lane); continue; } r -= I_GU;
            if (r < I_D) { transpose_item<0>(a.ffn_w_down, DFF, D, Wd_t0, scr, r, lane); continue; } r -= I_D;
            if (r < I_D) { transpose_item<0>(a.ffn_w_down + (size_t)DFF * D, DFF, D, Wd_t1, scr, r, lane); continue; } r -= I_D;
            if (r < I_IN) { transpose_item<0>(a.attn_w_qkv, D, 3 * D, Wqkv_t, scr, r, lane); continue; } r -= I_IN;
            transpose_item<0>(a.attn_w_o, D, D, Wo_t, scr, r, lane);
        }
        {
            const size_t n8 = (size_t)DB * CROWS * D / 8; const size_t gt = (size_t)blockIdx.x * (NWAVES * 64) + tid, NT = (size_t)G * NWAVES * 64;
            for (size_t i = gt; i < 2 * n8; i += NT) {
                const float* src = i < n8 ? a.cache_k + i * 8 : a.cache_v + (i - n8) * 8; bf16_t* dst = i < n8 ? KC + i * 8 : VC + (i - n8) * 8;
                const f32x4 v0 = *(const f32x4*)src, v1 = *(const f32x4*)(src + 4);
                u32x4 w; w.x = pk2(v0.x, v0.y); w.y = pk2(v0.z, v0.w); w.z = pk2(v1.x, v1.y); w.w = pk2(v1.z, v1.w);
                *(u32x4*)dst = w;
            }
        }
        for (int m = gw; m < M; m += NGW) { const float* xr = m < MP ? a.x_prompt + (size_t)m * D : a.x_sample + (size_t)(m - MP) * D; norm_row(xr, a.norm_mix_pre, XN + (size_t)m * D, lane); }
    }
    grid.sync();
    { pg8::Gemm g{XN, Win_t, M, 3 * D, D}; pg8::StaticOrder S; S.init(M, 3 * D, G, (int)blockIdx.x); pg8::EpiConvIn E{BA, BB};
      pg8::gemm_phase<pg8::EpiConvIn, pg8::StaticOrder, true, true>(lds, g, S, E); }
    grid.sync();
    {
        const f32x4* wp = (const f32x4*)a.conv_kernel + lane;
        f32x4 w0[4], w1[4], w2[4];
#pragma unroll
        for (int j = 0; j < 4; ++j) { w0[j] = wp[64 * j]; w1[j] = wp[256 + 64 * j]; w2[j] = wp[512 + 64 * j]; }
        for (int blk = gw; blk < M / 4; blk += NGW) {
            const int m0 = blk * 4; const bool samp = m0 >= MP; const int t0 = samp ? ((m0 - MP) & 31) : (m0 & 2047); const int b = samp ? ((m0 - MP) >> 5) : (m0 >> 11); const int T = samp ? DS : SEQ;
            const u32x2* up = (const u32x2*)(BB + (size_t)m0 * D) + lane; const u32x2* bp = (const u32x2*)(BA + (size_t)m0 * D) + lane;
            u32x2 ur[6][4], br[4][4];
#pragma unroll
            for (int k = 2; k < 6; ++k)
#pragma unroll
                for (int j = 0; j < 4; ++j) { ur[k][j] = up[(k - 2) * 256 + 64 * j]; br[k - 2][j] = bp[(k - 2) * 256 + 64 * j]; }
            f32x4 h0[4], h1[4];
            if (t0 > 0) {
#pragma unroll
                for (int j = 0; j < 4; ++j) { const u32x2 a0 = up[64 * j - 512], a1 = up[64 * j - 256];
                    h0[j] = (f32x4){bflo(a0.x), bfhi(a0.x), bflo(a0.y), bfhi(a0.y)}; h1[j] = (f32x4){bflo(a1.x), bfhi(a1.x), bflo(a1.y), bfhi(a1.y)}; }
            } else if (samp) {
                const f32x4* st = (const f32x4*)(a.state_conv + (size_t)b * 2 * D) + lane;
#pragma unroll
                for (int j = 0; j < 4; ++j) { h0[j] = st[64 * j]; h1[j] = st[256 + 64 * j]; }
            } else {
#pragma unroll
                for (int j = 0; j < 4; ++j) { h0[j] = (f32x4){0.f, 0.f, 0.f, 0.f}; h1[j] = h0[j]; }
            }
            u32x2* yo = (u32x2*)(BC + (size_t)m0 * D) + lane;
            float* so = (t0 == T - 4) ? a.out + (samp ? O_CONVS : O_CONVP) + (size_t)b * 2 * D : nullptr;
#pragma unroll
            for (int j = 0; j < 4; ++j) {
                f32x4 u2 = h0[j], u1 = h1[j];
#pragma unroll
                for (int k = 0; k < 4; ++k) {
                    const u32x2 uw = ur[k + 2][j]; const f32x4 u0 = (f32x4){bflo(uw.x), bfhi(uw.x), bflo(uw.y), bfhi(uw.y)};
                    const u32x2 bw = br[k][j]; const f32x4 bg = (f32x4){bflo(bw.x), bfhi(bw.x), bflo(bw.y), bfhi(bw.y)};
                    const f32x4 y = bg * (w0[j] * u2 + w1[j] * u1 + w2[j] * u0);
                    u32x2 o; o.x = pk2(y.x, y.y); o.y = pk2(y.z, y.w); yo[k * 256 + 64 * j] = o;
                    if (so && k >= 2) *((f32x4*)(so + (size_t)(k - 2) * D) + lane + 64 * j) = u0;
                    u2 = u1; u1 = u0;
                }
            }
        }
    }
    grid.sync();
    { pg8::Gemm g{BC, Wout_t, M, D, D}; pg8::StaticOrder S; S.init(M, D, G, (int)blockIdx.x); pg8::EpiBf16<0> E{MO, D, nullptr, 0, 0, 1.f};
      pg8::gemm_phase<pg8::EpiBf16<0>, pg8::StaticOrder, true, true>(lds, g, S, E); }
    grid.sync();
    res_pass<0, 0>(a, MO, XR, XN, Y, a.norm_mix_post, a.norm_ffn_pre, gw, NGW, lane);
    grid.sync();
    { pg8::Gemm g{XN, Wgu_t0, M, 2 * DFF, D}; pg8::StaticOrder S; S.init(M, 2 * DFF, G, (int)blockIdx.x); pg8::EpiSwiGLU E{HB};
      pg8::gemm_phase<pg8::EpiSwiGLU, pg8::StaticOrder, true, true>(lds, g, S, E); }
    grid.sync();
    { pg8::Gemm g{HB, Wd_t0, M, D, DFF}; pg8::StaticOrder S; S.init(M, D, G, (int)blockIdx.x); pg8::EpiBf16<0> E{MO, D, nullptr, 0, 0, 1.f};
      pg8::gemm_phase<pg8::EpiBf16<0>, pg8::StaticOrder, true, true>(lds, g, S, E); }
    grid.sync();
    res_pass<1, 0>(a, MO, XR, XN, Y, a.norm_ffn_post, a.norm_mix_pre + D, gw, NGW, lane);
    grid.sync();
    { pg8::Gemm g{XN, Wqkv_t, M, 3 * D, D}; pg8::StaticOrder S; S.init(M, 3 * D, G, (int)blockIdx.x);
      pg8::EpiBf16<0> E{BA, D, nullptr, D, (size_t)(WS_B - WS_A) / 2, QSCALE};
      pg8::gemm_phase<pg8::EpiBf16<0>, pg8::StaticOrder, true, true>(lds, g, S, E); }
    grid.sync();
    {
        constexpr int NGS1 = (DB * NH) / 8, NPU1 = NB * NH * 8, NGS = NGS1 * REP_SAMPLE, NPU = NPU1 * REP_PROMPT;
        LAS unsigned char* vlds = lds + wave * 4096; LAS float* tabw = (LAS float*)(lds + 32768 + wave * 1088);
        volatile LAS int* slot = (volatile LAS int*)(lds + 65536);
        if (tid == 0) *slot = (int)atomicAdd(qctr, 1u);
        __syncthreads();
        int wi = *slot;
        __syncthreads();
        while (wi < NGS + NPU) {
            int nxt = 0;
            if (tid == 0) nxt = (int)atomicAdd(qctr, 1u);
            if (wi < NGS) {
                att::Item it;
                const int si = (wi % NGS1) * 8 + wave, b = si >> 4, hh = si & 15;
                const size_t rb = (size_t)MP + (size_t)b * DS;
                it.q = BA + rb * D + hh * HD; it.o = OB + rb * D + hh * HD;
                it.kc = KC + (size_t)b * CROWS * D + hh * HD; it.vc = VC + (size_t)b * CROWS * D + hh * HD; it.kn = BB + rb * D + hh * HD; it.vn = BC + rb * D + hh * HD; it.nc = CROWS / 32;
                it.kt0 = 0; it.kt1 = CROWS / 32 + 1; it.qpos0 = CROWS; it.head = hh;
                it.kso = (wi < NGS1) ? a.out + O_KS + (size_t)b * DS * D + hh * HD : nullptr; it.vso = a.out + O_VS + (size_t)b * DS * D + hh * HD;
                att::attn_item(it, vlds, tabw, a.attn_rel_bias, lane);
            } else {
                const int u = (wi - NGS) % NPU1, bh = u >> 3, cq = 7 - (u & 7);
                att::attn_unit(bh >> 4, bh & 15, cq, BA, BB, BC, OB, a.out + O_KP, a.out + O_VP, a.attn_rel_bias, lds, tid, lane, wave);
            }
            __syncthreads();
            if (tid == 0) *slot = nxt;
            __syncthreads();
            wi = *slot;
        }
    }
    grid.sync();
    { pg8::Gemm g{OB, Wo_t, M, D, D}; pg8::StaticOrder S; S.init(M, D, G, (int)blockIdx.x); pg8::EpiBf16<0> E{MO, D, nullptr, 0, 0, 1.f};
      pg8::gemm_phase<pg8::EpiBf16<0>, pg8::StaticOrder, true, true>(lds, g, S, E); }
    grid.sync();
    res_pass<1, 0>(a, MO, XR, XN, Y, a.norm_mix_post + D, a.norm_ffn_pre + D, gw, NGW, lane);
    grid.sync();
    { pg8::Gemm g{XN, Wgu_t1, M, 2 * DFF, D}; pg8::StaticOrder S; S.init(M, 2 * DFF, G, (int)blockIdx.x); pg8::EpiSwiGLU E{HB};
      pg8::gemm_phase<pg8::EpiSwiGLU, pg8::StaticOrder, true, true>(lds, g, S, E); }
    grid.sync();
    { pg8::Gemm g{HB, Wd_t1, M, D, DFF}; pg8::StaticOrder S; S.init(M, D, G, (int)blockIdx.x); pg8::EpiBf16<0> E{MO, D, nullptr, 0, 0, 1.f};
      pg8::gemm_phase<pg8::EpiBf16<0>, pg8::StaticOrder, true, true>(lds, g, S, E); }
    grid.sync();
    res_pass<1, 1>(a, MO, XR, XN, Y, a.norm_ffn_post + D, nullptr, gw, NGW, lane);
}

extern "C" void kernel_launch(void* const* d_in, const int* in_sizes, int n_in, void* d_out, int out_size, void* d_ws, size_t ws_size, hipStream_t stream) {
    static int grid = 0;
    if (grid == 0) {
        if (n_in != 17 || (size_t)out_size != O_END || ws_size < WS_END) { fprintf(stderr, "kernel_launch: unexpected shapes n_in %d out %d ws %zu\n", n_in, out_size, ws_size); grid = -1; return; }
        int dev = 0, cus = 0, per_cu = 0;
        hipGetDevice(&dev); hipDeviceGetAttribute(&cus, hipDeviceAttributeMultiprocessorCount, dev);
        if (hipFuncSetAttribute((const void*)fwd_kernel, hipFuncAttributeMaxDynamicSharedMemorySize, LDS_BYTES) != hipSuccess) { fprintf(stderr, "kernel_launch: hipFuncSetAttribute failed\n"); grid = -1; return; }
        if (hipOccupancyMaxActiveBlocksPerMultiprocessor(&per_cu, (const void*)fwd_kernel, NWAVES * 64, LDS_BYTES) != hipSuccess || per_cu < 1) { fprintf(stderr, "kernel_launch: occupancy query says %d\n", per_cu); per_cu = 1; }
        (void)hipGetLastError();
        grid = cus;
    }
    if (grid < 0) return;
    Args a{};
    const float** p = (const float**)&a;
    for (int i = 0; i < 17; ++i) p[i] = (const float*)d_in[i];
    a.out = (float*)d_out; a.ws = (unsigned char*)d_ws;
    void* args[] = {&a};
    hipError_t e = hipLaunchCooperativeKernel((const void*)fwd_kernel, dim3(grid), dim3(NWAVES * 64), args, LDS_BYTES, stream);
    if (e != hipSuccess) fprintf(stderr, "cooperative launch failed: %s (grid %d)\n", hipGetErrorString(e), grid);
}
```

```cpp
#include <hip/hip_runtime.h>
#include <hip/hip_cooperative_groups.h>
#include <cstdio>
#include <cstdint>
namespace cg = cooperative_groups;
namespace pg8 {
#define PG8_LAS __attribute__((address_space(3)))
typedef unsigned short bf16_t;
typedef short bf16x8 __attribute__((ext_vector_type(8)));
typedef float f32x4 __attribute__((ext_vector_type(4)));
typedef unsigned u32x4 __attribute__((ext_vector_type(4)));
constexpr int BM = 256, BK = 64, HALF = 128, HTB = HALF * BK * 2  , STAGE_BYTES = 8 * HTB, NXCD = 8, WGM = 8;

__host__ __device__ __forceinline__ int lds_byte(int r, int c) { const int st = (r >> 4) * 2 + (c >> 5), rr = r & 15, cc = c & 31, ob = rr * 64 + cc * 2; return st * 1024 + (ob ^ (((ob >> 9) & 1) << 5)); }
__host__ __device__ __forceinline__ void stage_rc(int b, int& R, int& C) { const int st = b / 1024, sb = b % 1024, swz = sb ^ (((sb >> 9) & 1) << 5); R = (st >> 1) * 16 + swz / 64; C = (st & 1) * 32 + (swz % 64) / 2; }
__host__ __device__ __forceinline__ int perm32(int rho) { const int n = rho >> 4, i = rho & 15; return 8 * (i >> 2) + 4 * n + (i & 3); }

struct Unit { int pm, pn; };
struct Gemm { const bf16_t* A; const bf16_t* Bt; int M, N, K; };

struct StaticOrder {
    int nM, nN, nwg, G, c;
    __host__ __device__ void init(int M, int N, int G_, int c_) { nM = M / BM; nN = N / BM; nwg = nM * nN; G = G_; c = c_; }
    __host__ __device__ bool next(int i, Unit& u) const {
        const long L = (long)i * G + c; if (L >= nwg) return false;
        int wgid = (int)L; { const int q = nwg / NXCD, r = nwg % NXCD, xcd = wgid % NXCD, off = wgid / NXCD; wgid = (xcd < r ? xcd * (q + 1) : r * (q + 1) + (xcd - r) * q) + off; }
        const int nig = WGM * nN, gid = wgid / nig, fm = gid * WGM, gsz = (nM - fm) < WGM ? (nM - fm) : WGM;
        u.pm = fm + ((wgid % nig) % gsz); u.pn = (wgid % nig) / gsz; return true;
    }
    __device__ __forceinline__ void a_ready(const Unit&) const {}
    __device__ __forceinline__ void done(const Unit&) const {}
};

__device__ __forceinline__ unsigned cvt_pk_bf16(float lo, float hi) { unsigned r; asm volatile("v_cvt_pk_bf16_f32 %0, %1, %2" : "=v"(r) : "v"(lo), "v"(hi)); return r; }
typedef float f32x2 __attribute__((ext_vector_type(2)));
__device__ __forceinline__ f32x2 gelu_pk(f32x2 v) {
    const f32x2 av = __builtin_elementwise_abs(v), d = av * 0.2316418882f + 1.0f;
    f32x2 t; t.x = __builtin_amdgcn_rcpf(d.x); t.y = __builtin_amdgcn_rcpf(d.y);
    f32x2 q = t * 0.5307027145f + (-0.7265760135f); q = q * t + 0.7107068705f; q = q * t + (-0.142248368f); q = q * t + 0.127414796f; q = q * t;
    const f32x2 s = (v * v) * (-0.72134752044f);
    f32x2 e; e.x = __builtin_amdgcn_exp2f(s.x); e.y = __builtin_amdgcn_exp2f(s.y);
    const f32x2 m = v * (q * e), r = v - m;
    f32x2 o; o.x = v.x < 0.f ? m.x : r.x; o.y = v.y < 0.f ? m.y : r.y; return o;
}

template <int ACT  > struct EpiBf16 {
    static constexpr bool PERM = true, AFTER_DRAIN = false; static_assert(ACT == 0 || ACT == 1, "EpiBf16: ACT is 0 (none) or 1 (gelu_pk)");
    bf16_t* O; int ldc; const float* bias; int split_cols; size_t split_stride; float scale0;
    __device__ __forceinline__ void operator()(const f32x4 (&acc)[2][2][4][2], const Unit& u, int wr, int wc, int fr, int fq) const {
        const int row0 = u.pm * BM + wr * 64 + fr; int colt = u.pn * BM; bf16_t* base = O;
        float sc = 1.f; if (split_cols) { const int t = colt / split_cols; base += (size_t)t * split_stride; colt -= t * split_cols; if (t == 0) sc = scale0; }
        const int col0 = colt + wc * 32 + 8 * fq, bcol0 = u.pn * BM + wc * 32 + 8 * fq;
        f32x4 bv[2][2];
#pragma unroll
        for (int bj = 0; bj < 2; ++bj)
#pragma unroll
            for (int n = 0; n < 2; ++n) bv[bj][n] = bias ? *(const f32x4*)(bias + bcol0 + bj * HALF + 4 * n) : (f32x4){0.f, 0.f, 0.f, 0.f};
#pragma unroll
        for (int ai = 0; ai < 2; ++ai)
#pragma unroll
            for (int m = 0; m < 4; ++m) { bf16_t* rowp = base + (size_t)(row0 + ai * HALF + m * 16) * ldc + col0;
#pragma unroll
                for (int bj = 0; bj < 2; ++bj) { f32x4 v0 = acc[ai][bj][m][0] + bv[bj][0], v1 = acc[ai][bj][m][1] + bv[bj][1];
                    if (ACT == 1) { f32x2 a = gelu_pk((f32x2){v0[0], v0[1]}), b = gelu_pk((f32x2){v0[2], v0[3]}), c = gelu_pk((f32x2){v1[0], v1[1]}), d = gelu_pk((f32x2){v1[2], v1[3]});
                        v0 = (f32x4){a.x, a.y, b.x, b.y}; v1 = (f32x4){c.x, c.y, d.x, d.y}; }
                    v0 = v0 * sc; v1 = v1 * sc; u32x4 w; w.x = cvt_pk_bf16(v0[0], v0[1]); w.y = cvt_pk_bf16(v0[2], v0[3]); w.z = cvt_pk_bf16(v1[0], v1[1]); w.w = cvt_pk_bf16(v1[2], v1[3]);
                    *(u32x4*)(rowp + bj * HALF) = w; } }
    }
};
template <class Epi, class Sched, bool ALIGN_EPI = false, bool SP2 = false>
__device__ __forceinline__ void gemm_phase(PG8_LAS unsigned char* lds, const Gemm g, const Sched& S, const Epi& E) {
    int tid_ = threadIdx.x; asm volatile("" : "+v"(tid_)); const int tid = tid_, wid = __builtin_amdgcn_readfirstlane(tid >> 6), lane = tid & 63, wr = wid >> 2, wc = wid & 3, fr = lane & 15, fq = lane >> 4;
    const int K = g.K, nt = K / BK;
    unsigned voffA[2], voffB[2];
#pragma unroll
    for (int i = 0; i < 2; ++i) { int R, C; stage_rc(tid * 16 + i * 8192, R, C); const int Rb = Epi::PERM ? ((R & ~31) + perm32(R & 31)) : R;
        voffA[i] = (unsigned)(R * K + C) * 2u; voffB[i] = (unsigned)(Rb * K + C) * 2u; }
    const size_t kstep = (size_t)(BK * 2);
    const size_t hstep = (size_t)HALF * K * 2;
    const size_t tstep = 2 * hstep;
    const unsigned ldsw = (unsigned)wid * 1024u;
    const int aoff = lds_byte(wr * 64 + fr, fq * 8), boff = lds_byte(wc * 32 + fr, fq * 8);
#define PG8_SA(b, h) (((b) * 2 + (h)) * HTB)
#define PG8_SB(b, h) ((4 + (b) * 2 + (h)) * HTB)
#define PG8_STAGE(bufoff, gbase, voff) do { _Pragma("unroll") for (int _i = 0; _i < 2; ++_i) \
        __builtin_amdgcn_global_load_lds((const unsigned*)((const char*)(gbase) + (voff)[_i]), (PG8_LAS unsigned*)(lds + (bufoff) + ldsw + _i * 8192), 16, 0, 0); } while (0)
#define PG8_LDA(dst, b, h) do { _Pragma("unroll") for (int m = 0; m < 4; ++m) _Pragma("unroll") for (int k = 0; k < 2; ++k) dst[m][k] = *(const PG8_LAS bf16x8*)(lds + PG8_SA(b, h) + aoff + m * 2048 + k * 1024); } while (0)
#define PG8_LDB(dst, b, h) do { _Pragma("unroll") for (int n = 0; n < 2; ++n) _Pragma("unroll") for (int k = 0; k < 2; ++k) dst[n][k] = *(const PG8_LAS bf16x8*)(lds + PG8_SB(b, h) + boff + n * 2048 + k * 1024); } while (0)
#define PG8_MMA(ai, bj, At, Bt) do { __builtin_amdgcn_s_setprio(1); _Pragma("unroll") for (int m = 0; m < 4; ++m) _Pragma("unroll") for (int n = 0; n < 2; ++n) _Pragma("unroll") for (int k = 0; k < 2; ++k) \
        acc[ai][bj][m][n] = __builtin_amdgcn_mfma_f32_16x16x32_bf16(Bt[n][k], At[m][k], acc[ai][bj][m][n], 0, 0, 0); __builtin_amdgcn_s_setprio(0); } while (0)
#define PG8_WAIT_V(n) asm volatile("s_waitcnt vmcnt(" #n ")" ::: "memory")
#define PG8_WAIT_L(n) asm volatile("s_waitcnt lgkmcnt(" #n ")" ::: "memory")
#define PG8_BAR __builtin_amdgcn_s_barrier()
#define PG8_SCHED __builtin_amdgcn_sched_barrier(0)
    Unit cur, nxt; int ui = 0;
    if (!S.next(0, cur)) return;
    f32x4 acc[2][2][4][2];
#pragma unroll
    for (int a = 0; a < 2; ++a)
#pragma unroll
        for (int b = 0; b < 2; ++b)
#pragma unroll
            for (int m = 0; m < 4; ++m)
#pragma unroll
                for (int n = 0; n < 2; ++n) acc[a][b][m][n] = (f32x4){0.f, 0.f, 0.f, 0.f};
    bf16x8 At[4][2], B0[2][2], B1[2][2];
    const char* cA = (const char*)g.A + (size_t)cur.pm * tstep; const char* cB = (const char*)g.Bt + (size_t)cur.pn * tstep;
    S.a_ready(cur);
    if constexpr (SP2) {
        PG8_STAGE(PG8_SB(0, 0), cB, voffB); PG8_STAGE(PG8_SB(0, 1), cB + hstep, voffB); PG8_STAGE(PG8_SA(0, 0), cA, voffA); PG8_STAGE(PG8_SA(0, 1), cA + hstep, voffA);
        if (wr == 1) PG8_BAR;
        PG8_WAIT_V(2); PG8_BAR;
        PG8_STAGE(PG8_SB(1, 0), cB + kstep, voffB); PG8_STAGE(PG8_SA(1, 0), cA + kstep, voffA); PG8_STAGE(PG8_SB(1, 1), cB + hstep + kstep, voffB);
        PG8_WAIT_V(6); PG8_BAR;
    } else {
        PG8_STAGE(PG8_SB(0, 0), cB, voffB); PG8_STAGE(PG8_SA(0, 0), cA, voffA); PG8_STAGE(PG8_SB(0, 1), cB + hstep, voffB); PG8_STAGE(PG8_SA(0, 1), cA + hstep, voffA);
        if (wr == 1) PG8_BAR;
        PG8_WAIT_V(4); PG8_BAR;
        PG8_STAGE(PG8_SB(1, 0), cB + kstep, voffB); PG8_STAGE(PG8_SA(1, 0), cA + kstep, voffA); PG8_STAGE(PG8_SB(1, 1), cB + hstep + kstep, voffB);
        PG8_WAIT_V(6); PG8_BAR;
    }
    for (;;) {
        const bool has_next = S.next(ui + 1, nxt);
        const char* nA = has_next ? (const char*)g.A + (size_t)nxt.pm * tstep : cA; const char* nB = has_next ? (const char*)g.Bt + (size_t)nxt.pn * tstep : cB;
        for (int t = 0; t < nt; t += 2) {
            const bool last = (t == nt - 2);
            const char* a1 = cA + (size_t)(t + 1) * kstep;
            const char* a2 = last ? nA : cA + (size_t)(t + 2) * kstep; const char* b2 = last ? nB : cB + (size_t)(t + 2) * kstep;
            const char* a3 = a2 + kstep; const char* b3 = b2 + kstep;
            if (last && has_next) S.a_ready(nxt);
            if constexpr (SP2) {
            PG8_LDB(B0, 0, 0); PG8_LDB(B1, 0, 1); PG8_SCHED; PG8_LDA(At, 0, 0); PG8_STAGE(PG8_SA(1, 1), a1 + hstep, voffA);
            PG8_WAIT_V(8); PG8_WAIT_L(0); PG8_BAR; PG8_MMA(0, 0, At, B0); PG8_MMA(0, 1, At, B1); PG8_BAR; PG8_SCHED;
            PG8_LDA(At, 0, 1); PG8_STAGE(PG8_SB(0, 0), b2, voffB); PG8_STAGE(PG8_SB(0, 1), b2 + hstep, voffB); PG8_STAGE(PG8_SA(0, 0), a2, voffA);
            PG8_WAIT_V(8); PG8_WAIT_L(0); PG8_BAR; PG8_MMA(1, 0, At, B0); PG8_MMA(1, 1, At, B1); PG8_BAR; PG8_SCHED;
            PG8_LDB(B0, 1, 0); PG8_LDB(B1, 1, 1); PG8_SCHED; PG8_LDA(At, 1, 0); PG8_STAGE(PG8_SA(0, 1), a2 + hstep, voffA);
            PG8_WAIT_V(8); PG8_WAIT_L(0); PG8_BAR; PG8_MMA(0, 0, At, B0); PG8_MMA(0, 1, At, B1); PG8_BAR; PG8_SCHED;
            PG8_LDA(At, 1, 1); PG8_STAGE(PG8_SB(1, 0), b3, voffB); PG8_STAGE(PG8_SB(1, 1), b3 + hstep, voffB); PG8_STAGE(PG8_SA(1, 0), a3, voffA);
            PG8_WAIT_V(8); PG8_WAIT_L(0); PG8_BAR; PG8_MMA(1, 0, At, B0); PG8_MMA(1, 1, At, B1); PG8_BAR; PG8_SCHED;
            } else {
            PG8_LDB(B0, 0, 0); PG8_SCHED; PG8_LDA(At, 0, 0); PG8_STAGE(PG8_SA(1, 1), a1 + hstep, voffA);
            PG8_WAIT_L(8); PG8_BAR; PG8_WAIT_L(0); PG8_MMA(0, 0, At, B0); PG8_BAR; PG8_SCHED;
            PG8_LDB(B1, 0, 1); PG8_STAGE(PG8_SB(0, 0), b2, voffB);
            PG8_BAR; PG8_WAIT_L(0); PG8_MMA(0, 1, At, B1); PG8_BAR;
            PG8_LDA(At, 0, 1); PG8_STAGE(PG8_SA(0, 0), a2, voffA);
            PG8_BAR; PG8_WAIT_L(0); PG8_MMA(1, 0, At, B0); PG8_BAR; PG8_SCHED;
            PG8_STAGE(PG8_SB(0, 1), b2 + hstep, voffB);
            PG8_WAIT_V(6); PG8_BAR; PG8_MMA(1, 1, At, B1); PG8_BAR;
            PG8_LDB(B0, 1, 0); PG8_SCHED; PG8_LDA(At, 1, 0); PG8_STAGE(PG8_SA(0, 1), a2 + hstep, voffA);
            PG8_WAIT_L(8); PG8_BAR; PG8_WAIT_L(0); PG8_MMA(0, 0, At, B0); PG8_BAR; PG8_SCHED;
            PG8_LDB(B1, 1, 1); PG8_STAGE(PG8_SB(1, 0), b3, voffB);
            PG8_BAR; PG8_WAIT_L(0); PG8_MMA(0, 1, At, B1); PG8_BAR;
            PG8_LDA(At, 1, 1); PG8_STAGE(PG8_SA(1, 0), a3, voffA);
            PG8_BAR; PG8_WAIT_L(0); PG8_MMA(1, 0, At, B0); PG8_BAR; PG8_SCHED;
            PG8_STAGE(PG8_SB(1, 1), b3 + hstep, voffB);
            PG8_WAIT_V(6); PG8_BAR; PG8_MMA(1, 1, At, B1); PG8_BAR;
            }
        }
        if constexpr (ALIGN_EPI) { if (wr == 0) PG8_BAR; }
        if constexpr (!Epi::AFTER_DRAIN) { E(acc, cur, wr, wc, fr, fq); S.done(cur); }
        if (!has_next) break;
#pragma unroll
        for (int a = 0; a < 2; ++a)
#pragma unroll
            for (int b = 0; b < 2; ++b)
#pragma unroll
                for (int m = 0; m < 4; ++m)
#pragma unroll
                    for (int n = 0; n < 2; ++n) acc[a][b][m][n] = (f32x4){0.f, 0.f, 0.f, 0.f};
        cur = nxt; cA = nA; cB = nB; ++ui;
        if constexpr (ALIGN_EPI) { if (wr == 1) PG8_BAR; }
    }
    PG8_WAIT_V(0);
    if constexpr (!ALIGN_EPI) { if (wr == 0) PG8_BAR; }
    PG8_BAR;
    if constexpr (Epi::AFTER_DRAIN) { E.fused(acc, cur, wr, wc, fr, fq, lds, wid, lane); S.done(cur); }
#undef PG8_SA
#undef PG8_SB
#undef PG8_STAGE
#undef PG8_LDA
#undef PG8_LDB
#undef PG8_MMA
#undef PG8_WAIT_V
#undef PG8_WAIT_L
#undef PG8_BAR
#undef PG8_SCHED
}
}

#define LAS __attribute__((address_space(3)))
typedef unsigned short bf16_t;
typedef unsigned u32x4 __attribute__((ext_vector_type(4)));
typedef unsigned u32x2 __attribute__((ext_vector_type(2)));
typedef float f32x4 __attribute__((ext_vector_type(4)));
typedef float f32x16 __attribute__((ext_vector_type(16)));
typedef short bf16x8 __attribute__((ext_vector_type(8)));
typedef short s16x4 __attribute__((ext_vector_type(4)));

constexpr int D = 1024, NB = 32, SEQ = 2048, DB = 32, DS = 32, NH = 16, HD = 64, DFF = 2816;
constexpr int MP = NB * SEQ;
constexpr int MS = DB * DS;
constexpr int M = MP + MS;
constexpr int CROWS = 512;
constexpr float EPS = 1e-6f;
constexpr float LOG2E = 1.4426950408889634f;
constexpr float QSCALE = 0.125f * LOG2E;
constexpr int NWAVES = 8;
#ifndef REP_KVOUT
#define REP_KVOUT 1
#endif
#ifndef REP_SAMPLE
#define REP_SAMPLE 1
#endif
#ifndef REP_PROMPT
#define REP_PROMPT 1
#endif

constexpr size_t O_Y = 0;
constexpr size_t O_CONVP = (size_t)M * D;
constexpr size_t O_CONVS = O_CONVP + 65536;
constexpr size_t O_KP = O_CONVS + 65536;
constexpr size_t O_VP = O_KP + (size_t)NB * CROWS * D;
constexpr size_t O_KS = O_VP + (size_t)NB * CROWS * D;
constexpr size_t O_VS = O_KS + (size_t)MS * D;
constexpr size_t O_END = O_VS + (size_t)MS * D;

constexpr size_t MiB = 1u << 20;
constexpr size_t WS_WIN = 0, WS_WOUT = 6 * MiB, WS_WGU0 = 8 * MiB, WS_WGU1 = 19 * MiB, WS_WD0 = 30 * MiB, WS_WD1 = 30 * MiB + 5632 * 1024,
                 WS_WQKV = 41 * MiB, WS_WO = 47 * MiB, WS_KC = 50 * MiB, WS_VC = 82 * MiB, WS_CTL = 120 * MiB;
constexpr size_t WS_XN = 128 * MiB, WS_A = 258 * MiB, WS_B = 388 * MiB, WS_C = 518 * MiB, WS_MO = 648 * MiB, WS_O = 128 * MiB  , WS_XR = 778 * MiB, WS_END = 908 * MiB;

constexpr int LDS_BYTES = 131072 + 8192, MISC_OFF = 131072 + 4096, CW_BAR = 4096  , CTL_BYTES = 65536;

__device__ __forceinline__ float bf2f(unsigned short b) { return __uint_as_float(((unsigned)b) << 16); }
__device__ __forceinline__ float bflo(unsigned w) { return __uint_as_float(w << 16); }
__device__ __forceinline__ float bfhi(unsigned w) { return __uint_as_float(w & 0xffff0000u); }
__device__ __forceinline__ unsigned pk2(float lo, float hi) { return pg8::cvt_pk_bf16(lo, hi); }
__device__ __forceinline__ float wave_sum(float v) {
#pragma unroll
    for (int o = 1; o < 64; o <<= 1) v += __shfl_xor(v, o);
    return v;
}

namespace pg8 {
struct EpiConvIn {
    static constexpr bool PERM = true, AFTER_DRAIN = false;
    bf16_t* Bg; bf16_t* U;
    __device__ __forceinline__ void operator()(const f32x4 (&acc)[2][2][4][2], const Unit& u, int wr, int wc, int fr, int fq) const {
        const int row0 = u.pm * BM + wr * 64 + fr;
        if (u.pn < 4) {
            const int col0 = u.pn * BM + wc * 32 + 8 * fq;
#pragma unroll
            for (int ai = 0; ai < 2; ++ai)
#pragma unroll
                for (int m = 0; m < 4; ++m) { bf16_t* rowp = Bg + (size_t)(row0 + ai * HALF + m * 16) * 1024 + col0;
#pragma unroll
                    for (int bj = 0; bj < 2; ++bj) { const f32x4 v0 = acc[ai][bj][m][0], v1 = acc[ai][bj][m][1];
                        u32x4 w; w.x = cvt_pk_bf16(v0[0], v0[1]); w.y = cvt_pk_bf16(v0[2], v0[3]); w.z = cvt_pk_bf16(v1[0], v1[1]); w.w = cvt_pk_bf16(v1[2], v1[3]);
                        *(u32x4*)(rowp + bj * HALF) = w; } }
        } else {
            const int col0 = (u.pn - 4) * HALF + wc * 32 + 8 * fq;
#pragma unroll
            for (int ai = 0; ai < 2; ++ai)
#pragma unroll
                for (int m = 0; m < 4; ++m) { bf16_t* rowp = U + (size_t)(row0 + ai * HALF + m * 16) * 1024 + col0;
                    const f32x4 v0 = acc[ai][0][m][0] * acc[ai][1][m][0], v1 = acc[ai][0][m][1] * acc[ai][1][m][1];
                    u32x4 w; w.x = cvt_pk_bf16(v0[0], v0[1]); w.y = cvt_pk_bf16(v0[2], v0[3]); w.z = cvt_pk_bf16(v1[0], v1[1]); w.w = cvt_pk_bf16(v1[2], v1[3]);
                    *(u32x4*)(rowp) = w; }
        }
    }
};
struct EpiSwiGLU {
    static constexpr bool PERM = true, AFTER_DRAIN = false;
    bf16_t* H;
    __device__ __forceinline__ float act(float g, float uu) const { return g * uu * __builtin_amdgcn_rcpf(1.0f + __builtin_amdgcn_exp2f(-1.4426950408889634f * g)); }
    __device__ __forceinline__ void operator()(const f32x4 (&acc)[2][2][4][2], const Unit& u, int wr, int wc, int fr, int fq) const {
        const int row0 = u.pm * BM + wr * 64 + fr;
        const int col0 = u.pn * HALF + wc * 32 + 8 * fq;
#pragma unroll
        for (int ai = 0; ai < 2; ++ai)
#pragma unroll
            for (int m = 0; m < 4; ++m) { bf16_t* rowp = H + (size_t)(row0 + ai * HALF + m * 16) * 2816 + col0;
                const f32x4 g0 = acc[ai][0][m][0], g1 = acc[ai][0][m][1], u0 = acc[ai][1][m][0], u1 = acc[ai][1][m][1];
                u32x4 w; w.x = cvt_pk_bf16(act(g0[0], u0[0]), act(g0[1], u0[1])); w.y = cvt_pk_bf16(act(g0[2], u0[2]), act(g0[3], u0[3]));
                w.z = cvt_pk_bf16(act(g1[0], u1[0]), act(g1[1], u1[1])); w.w = cvt_pk_bf16(act(g1[2], u1[2]), act(g1[3], u1[3]));
                *(u32x4*)(rowp) = w; }
    }
};
}

struct Args {
    const float *x_prompt, *x_sample, *state_conv, *cache_k, *cache_v, *conv_w_in, *conv_kernel, *conv_w_out, *attn_w_qkv, *attn_w_o, *attn_rel_bias,
        *norm_mix_pre, *norm_mix_post, *norm_ffn_pre, *norm_ffn_post, *ffn_w_gate_up, *ffn_w_down;
    float* out; unsigned char* ws;
};

template <int MODE> __device__ __forceinline__ int dest_row(int n) {
    if (MODE == 1) { const int hh = n / DFF, rem = n - hh * DFF; return ((rem >> 7) << 8) + (hh << 7) + (rem & 127); }
    if (MODE == 2) { if (n < 1024) return n; const int np = n - 1024, hh = np >> 10, rem = np & 1023; return 1024 + ((rem >> 7) << 8) + (hh << 7) + (rem & 127); }
    return n;
}
template <int MODE> __device__ __forceinline__ void transpose_item(const float* W, int K, int N, bf16_t* WT, LAS float* scr, int item, int lane) {
    const int nblk = N / 32, kb = item / nblk, nb = item % nblk, k0 = 64 * kb, n0 = 32 * nb;
#pragma unroll 8
    for (int i = 0; i < 32; ++i) { const int kk = 2 * i + (lane >> 5); scr[kk * 33 + (lane & 31)] = W[(size_t)(k0 + kk) * N + n0 + (lane & 31)]; }
    asm volatile("s_waitcnt lgkmcnt(0)" ::: "memory");
    const int c = lane & 7; const int drow = dest_row<MODE>(n0);
#pragma unroll
    for (int j = 0; j < 4; ++j) { const int n = (lane >> 3) + 8 * j; const LAS float* s = scr + (8 * c) * 33 + n;
        u32x4 o; o.x = pk2(s[0 * 33], s[1 * 33]); o.y = pk2(s[2 * 33], s[3 * 33]); o.z = pk2(s[4 * 33], s[5 * 33]); o.w = pk2(s[6 * 33], s[7 * 33]);
        *(u32x4*)(WT + (size_t)(drow + n) * K + k0 + 8 * c) = o; }
    asm volatile("s_waitcnt lgkmcnt(0)" ::: "memory");
}

__device__ __forceinline__ void norm_row(const float* xrow, const float* g, bf16_t* orow, int lane) {
    const f32x4* xr = (const f32x4*)xrow + lane; const f32x4* gr = (const f32x4*)g + lane;
    f32x4 v[4]; float s = 0.f;
#pragma unroll
    for (int j = 0; j < 4; ++j) { v[j] = xr[64 * j]; s += (v[j].x * v[j].x + v[j].y * v[j].y) + (v[j].z * v[j].z + v[j].w * v[j].w); }
    const float inv = 1.0f / sqrtf(wave_sum(s) * (1.f / D) + EPS);
    u32x2* o8 = (u32x2*)orow + lane;
#pragma unroll
    for (int j = 0; j < 4; ++j) { const f32x4 gg = gr[64 * j]; u32x2 w; w.x = pk2(v[j].x * inv * gg.x, v[j].y * inv * gg.y); w.y = pk2(v[j].z * inv * gg.z, v[j].w * inv * gg.w); o8[64 * j] = w; }
}
template <int XIN, int XOUT> __device__ __forceinline__ void res_pass(const Args& a, const bf16_t* MO, bf16_t* XR, bf16_t* XN, float* Y, const float* gp, const float* gn, int gw, int NGW, int lane) {
    const f32x4* gr = (const f32x4*)gp + lane;
    for (int m0 = gw; m0 < M; m0 += 2 * NGW) {
        int mm[2]; mm[0] = m0; mm[1] = (m0 + NGW < M) ? m0 + NGW : m0;
        f32x4 mv[2][4], xv[2][4]; float s[2] = {0.f, 0.f};
#pragma unroll
        for (int k = 0; k < 2; ++k) {
            const int m = mm[k];
            const u32x2* mr = (const u32x2*)(MO + (size_t)m * D) + lane;
#pragma unroll
            for (int j = 0; j < 4; ++j) { const u32x2 w = mr[64 * j]; mv[k][j] = (f32x4){bflo(w.x), bfhi(w.x), bflo(w.y), bfhi(w.y)}; }
            if (XIN == 0) { const float* xr = m < MP ? a.x_prompt + (size_t)m * D : a.x_sample + (size_t)(m - MP) * D;
#pragma unroll
                for (int j = 0; j < 4; ++j) xv[k][j] = ((const f32x4*)xr + lane)[64 * j];
            } else { const u32x2* xr = (const u32x2*)(XR + (size_t)m * D) + lane;
#pragma unroll
                for (int j = 0; j < 4; ++j) { const u32x2 w = xr[64 * j]; xv[k][j] = (f32x4){bflo(w.x), bfhi(w.x), bflo(w.y), bfhi(w.y)}; } }
        }
#pragma unroll
        for (int k = 0; k < 2; ++k)
#pragma unroll
            for (int j = 0; j < 4; ++j) s[k] += (mv[k][j].x * mv[k][j].x + mv[k][j].y * mv[k][j].y) + (mv[k][j].z * mv[k][j].z + mv[k][j].w * mv[k][j].w);
        float inv[2], s2[2] = {0.f, 0.f};
#pragma unroll
        for (int k = 0; k < 2; ++k) inv[k] = 1.0f / sqrtf(wave_sum(s[k]) * (1.f / D) + EPS);
#pragma unroll
        for (int k = 0; k < 2; ++k)
#pragma unroll
            for (int j = 0; j < 4; ++j) { const f32x4 gg = gr[64 * j]; xv[k][j] = xv[k][j] + mv[k][j] * inv[k] * gg;
                s2[k] += (xv[k][j].x * xv[k][j].x + xv[k][j].y * xv[k][j].y) + (xv[k][j].z * xv[k][j].z + xv[k][j].w * xv[k][j].w); }
        if (XOUT == 1) {
#pragma unroll
            for (int k = 0; k < 2; ++k) { f32x4* xo = (f32x4*)(Y + (size_t)mm[k] * D) + lane;
#pragma unroll
                for (int j = 0; j < 4; ++j) xo[64 * j] = xv[k][j]; }
        } else {
            const f32x4* g2 = (const f32x4*)gn + lane;
#pragma unroll
            for (int k = 0; k < 2; ++k) {
                const float inv2 = 1.0f / sqrtf(wave_sum(s2[k]) * (1.f / D) + EPS);
                u32x2* xo = (u32x2*)(XR + (size_t)mm[k] * D) + lane; u32x2* o8 = (u32x2*)(XN + (size_t)mm[k] * D) + lane;
#pragma unroll
                for (int j = 0; j < 4; ++j) { const f32x4 gg = g2[64 * j]; const f32x4 x = xv[k][j];
                    u32x2 wx; wx.x = pk2(x.x, x.y); wx.y = pk2(x.z, x.w); xo[64 * j] = wx;
                    u32x2 w; w.x = pk2(x.x * inv2 * gg.x, x.y * inv2 * gg.y); w.y = pk2(x.z * inv2 * gg.z, x.w * inv2 * gg.w); o8[64 * j] = w; }
            }
        }
    }
}

namespace att {
__device__ __forceinline__ int crow(int i, int h) { return (i & 3) + 8 * (i >> 2) + 4 * h; }
typedef short v4i16_t __attribute__((ext_vector_type(4)));
__device__ __forceinline__ s16x4 vtr(const LAS unsigned char* p) { return __builtin_bit_cast(s16x4, __builtin_amdgcn_ds_read_tr16_b64_v4i16((LAS v4i16_t*)p)); }
struct Item { const bf16_t* q; const bf16_t* kc; const bf16_t* vc; const bf16_t* kn; const bf16_t* vn; bf16_t* o; float* kso; float* vso; int nc, kt0, kt1, qpos0, head; };

__device__ __forceinline__ void load_tile(const Item& it, int kt, int lane, bf16x8 (&kf)[4], u32x4 (&vr)[4]) {
    const int r = lane & 31, h = lane >> 5;
    const bf16_t* kp = kt < it.nc ? it.kc + (size_t)kt * 32 * 1024 : it.kn + (size_t)(kt - it.nc) * 32 * 1024;
    const bf16_t* vp = kt < it.nc ? it.vc + (size_t)kt * 32 * 1024 : it.vn + (size_t)(kt - it.nc) * 32 * 1024;
#pragma unroll
    for (int s = 0; s < 4; ++s) kf[s] = *(const bf16x8*)(kp + (size_t)r * 1024 + 16 * s + 8 * h);
#pragma unroll
    for (int i = 0; i < 4; ++i) vr[i] = *(const u32x4*)(vp + (size_t)((lane >> 3) + 8 * i) * 1024 + (lane & 7) * 8);
}

__device__ __forceinline__ void attn_item(const Item& it, LAS unsigned char* vlds, LAS float* tab, const float* table, int lane) {
    const int r = lane & 31, h = lane >> 5;
    asm volatile("s_waitcnt lgkmcnt(0)" ::: "memory");
    for (int i = lane; i < 257; i += 64) tab[i] = table[it.head * 257 + i] * LOG2E;
    bf16x8 qf[4];
#pragma unroll
    for (int s = 0; s < 4; ++s) qf[s] = *(const bf16x8*)(it.q + (size_t)r * 1024 + 16 * s + 8 * h);
    f32x16 o0, o1;
#pragma unroll
    for (int i = 0; i < 16; ++i) { o0[i] = 0.f; o1[i] = 0.f; }
    float mrun = -1e30f, lrun = 0.f;
    asm volatile("s_waitcnt lgkmcnt(0)" ::: "memory");
    const float cfar = tab[256];
    const int qpos = it.qpos0 + r;
    const int i16 = lane & 15, q4 = i16 >> 2, p4 = i16 & 3, g = (lane >> 4) & 1;
    const LAS unsigned char* trbase = vlds + (4 * h + q4) * 128 + (16 * g + 4 * p4) * 2;
    bf16x8 kf[4]; u32x4 vr[4];
    load_tile(it, it.kt0, lane, kf, vr);
    for (int kt = it.kt0; kt < it.kt1; ++kt) {
        bf16x8 kn_[4]; u32x4 vn_[4];
        if (kt + 1 < it.kt1) load_tile(it, kt + 1, lane, kn_, vn_);
        else {
#pragma unroll
            for (int s = 0; s < 4; ++s) { kn_[s] = kf[s]; vn_[s] = vr[s]; }
        }
        asm volatile("s_waitcnt lgkmcnt(0)" ::: "memory");
#pragma unroll
        for (int i = 0; i < 4; ++i) *(LAS u32x4*)(vlds + ((lane >> 3) + 8 * i) * 128 + (lane & 7) * 16) = vr[i];
        f32x16 p;
#pragma unroll
        for (int i = 0; i < 16; ++i) p[i] = 0.f;
#pragma unroll
        for (int s = 0; s < 4; ++s) p = __builtin_amdgcn_mfma_f32_32x32x16_bf16(kf[s], qf[s], p, 0, 0, 0);
        const int kb = 32 * kt;
        if (it.qpos0 - (kb + 31) >= 128) {
#pragma unroll
            for (int i = 0; i < 16; ++i) p[i] += cfar;
        } else {
#pragma unroll
            for (int i = 0; i < 16; ++i) { int dd = qpos - (kb + crow(i, h)); dd = dd < -128 ? -128 : (dd > 128 ? 128 : dd); p[i] += tab[dd + 128]; }
        }
        float tm = p[0];
#pragma unroll
        for (int i = 1; i < 16; ++i) tm = fmaxf(tm, p[i]);
        tm = fmaxf(tm, __shfl_xor(tm, 32));
        const float mnew = fmaxf(mrun, tm);
        const float sc = __builtin_amdgcn_exp2f(mrun - mnew);
        mrun = mnew;
        float ps = 0.f;
#pragma unroll
        for (int i = 0; i < 16; ++i) { p[i] = __builtin_amdgcn_exp2f(p[i] - mnew); ps += p[i]; }
        lrun = lrun * sc + ps;
#pragma unroll
        for (int i = 0; i < 16; ++i) { o0[i] *= sc; o1[i] *= sc; }
        u32x4 w0, w1;
        w0.x = pk2(p[0], p[1]); w0.y = pk2(p[2], p[3]); w0.z = pk2(p[4], p[5]); w0.w = pk2(p[6], p[7]);
        w1.x = pk2(p[8], p[9]); w1.y = pk2(p[10], p[11]); w1.z = pk2(p[12], p[13]); w1.w = pk2(p[14], p[15]);
        const bf16x8 pf0 = __builtin_bit_cast(bf16x8, w0), pf1 = __builtin_bit_cast(bf16x8, w1);
        asm volatile("s_waitcnt lgkmcnt(0)" ::: "memory");
#pragma unroll
        for (int s = 0; s < 2; ++s) {
            const s16x4 a_lo = vtr(trbase + (16 * s) * 128), a_hi = vtr(trbase + (16 * s + 8) * 128);
            const s16x4 b_lo = vtr(trbase + (16 * s) * 128 + 64), b_hi = vtr(trbase + (16 * s + 8) * 128 + 64);
            const bf16x8 va = __builtin_shufflevector(a_lo, a_hi, 0, 1, 2, 3, 4, 5, 6, 7), vb = __builtin_shufflevector(b_lo, b_hi, 0, 1, 2, 3, 4, 5, 6, 7);
            o0 = __builtin_amdgcn_mfma_f32_32x32x16_bf16(va, s == 0 ? pf0 : pf1, o0, 0, 0, 0);
            o1 = __builtin_amdgcn_mfma_f32_32x32x16_bf16(vb, s == 0 ? pf0 : pf1, o1, 0, 0, 0);
        }
#pragma unroll
        for (int s = 0; s < 4; ++s) { kf[s] = kn_[s]; vr[s] = vn_[s]; }
    }
    if (it.kso) {
        load_tile(it, it.nc, lane, kf, vr);
#pragma unroll
        for (int s = 0; s < 4; ++s) { const u32x4 w = __builtin_bit_cast(u32x4, kf[s]); float* d = it.kso + (size_t)r * 1024 + 16 * s + 8 * h;
            *(f32x4*)d = (f32x4){bflo(w.x), bfhi(w.x), bflo(w.y), bfhi(w.y)}; *(f32x4*)(d + 4) = (f32x4){bflo(w.z), bfhi(w.z), bflo(w.w), bfhi(w.w)}; }
#pragma unroll
        for (int i = 0; i < 4; ++i) { const u32x4 w = vr[i]; float* d = it.vso + (size_t)((lane >> 3) + 8 * i) * 1024 + (lane & 7) * 8;
            *(f32x4*)d = (f32x4){bflo(w.x), bfhi(w.x), bflo(w.y), bfhi(w.y)}; *(f32x4*)(d + 4) = (f32x4){bflo(w.z), bfhi(w.z), bflo(w.w), bfhi(w.w)}; }
    }
    lrun += __shfl_xor(lrun, 32);
    const float inv = 1.0f / lrun;
    bf16_t* orow = it.o + (size_t)r * 1024 + 4 * h;
#pragma unroll
    for (int g4 = 0; g4 < 4; ++g4) {
        u32x2 a, b;
        a.x = pk2(o0[4 * g4] * inv, o0[4 * g4 + 1] * inv); a.y = pk2(o0[4 * g4 + 2] * inv, o0[4 * g4 + 3] * inv);
        b.x = pk2(o1[4 * g4] * inv, o1[4 * g4 + 1] * inv); b.y = pk2(o1[4 * g4 + 2] * inv, o1[4 * g4 + 3] * inv);
        *(u32x2*)(orow + 8 * g4) = a; *(u32x2*)(orow + 32 + 8 * g4) = b;
    }
}

constexpr int KROW = 144, KTILE = 64 * KROW, VTILE = 64 * 128, A_K = 0, A_V = 2 * KTILE, A_TAB = A_V + 2 * VTILE, A_SLOT = A_TAB + 1296;
__device__ __forceinline__ float max3f(float a, float b, float c) { float r; asm("v_max3_f32 %0, %1, %2, %3" : "=v"(r) : "v"(a), "v"(b), "v"(c)); return r; }
__device__ __forceinline__ void attn_unit(int b, int hh, int cq, const bf16_t* Qg, const bf16_t* Kg, const bf16_t* Vg, bf16_t* Og, float* kout, float* vout, const float* table, LAS unsigned char* lds, int tid, int lane, int wave) {
    constexpr float THR = 8.0f;
    const int r = lane & 31, h = lane >> 5;
    const int c = 4 * cq + (wave >> 1), half = wave & 1;
    const int j0 = (4 * cq - 8) > 0 ? (4 * cq - 8) : 0, j1 = 4 * cq + 3;
    const size_t rb = (size_t)b * SEQ;
    LAS float* tab = (LAS float*)(lds + A_TAB);
    if (tid < 324) tab[tid] = table[hh * 257 + (tid < 256 ? tid : 256)] * LOG2E;
    const int lrow = tid >> 3, lch = tid & 7;
    const bf16_t* kgp = Kg + (rb + lrow) * D + hh * HD + lch * 8; const bf16_t* vgp = Vg + (rb + lrow) * D + hh * HD + lch * 8;
    const int kwoff = A_K + lrow * KROW + lch * 16, vwoff = A_V + lrow * 128 + ((lch ^ (((lrow >> 1) & 1) << 2)) << 4);
    const long korow = (long)b * CROWS - (SEQ - CROWS) + lrow; float* kop = kout + korow * D + hh * HD + lch * 8; float* vop = vout + korow * D + hh * HD + lch * 8;
#define ATT_KVOUT(tile) do { if (cq >= 6 && (tile) >= 4 * cq) { float* kd = kop + (long)(tile) * 64 * D; float* vd = vop + (long)(tile) * 64 * D; \
        *(f32x4*)kd = (f32x4){bflo(kreg.x), bfhi(kreg.x), bflo(kreg.y), bfhi(kreg.y)}; *(f32x4*)(kd + 4) = (f32x4){bflo(kreg.z), bfhi(kreg.z), bflo(kreg.w), bfhi(kreg.w)}; \
        *(f32x4*)vd = (f32x4){bflo(vreg.x), bfhi(vreg.x), bflo(vreg.y), bfhi(vreg.y)}; *(f32x4*)(vd + 4) = (f32x4){bflo(vreg.z), bfhi(vreg.z), bflo(vreg.w), bfhi(vreg.w)}; } } while (0)
    u32x4 kreg = *(const u32x4*)(kgp + (size_t)j0 * 64 * D), vreg = *(const u32x4*)(vgp + (size_t)j0 * 64 * D);
    bf16x8 qf[4];
    const bf16_t* qp = Qg + (rb + 64 * c + 32 * half + r) * D + hh * HD + 8 * h;
#pragma unroll
    for (int s = 0; s < 4; ++s) qf[s] = *(const bf16x8*)(qp + 16 * s);
    *(LAS u32x4*)(lds + kwoff) = kreg; *(LAS u32x4*)(lds + vwoff) = vreg;
    ATT_KVOUT(j0);
    kreg = *(const u32x4*)(kgp + (size_t)(j0 + 1) * 64 * D); vreg = *(const u32x4*)(vgp + (size_t)(j0 + 1) * 64 * D);
    f32x16 o0, o1;
#pragma unroll
    for (int i = 0; i < 16; ++i) { o0[i] = 0.f; o1[i] = 0.f; }
    float mrun = 0.f, lrun = 0.f;
    const int i16 = lane & 15, q4 = i16 >> 2, p4 = i16 & 3, g = (lane >> 4) & 1;
    const int troff = A_V + (4 * h + q4) * 128 + ((32 * g) ^ (((q4 >> 1) & 1) << 6)) + 8 * p4;
    const int kroff = A_K + r * KROW + 16 * h;
    __syncthreads();
    const float cfar = tab[256];
    f32x16 negf;
#pragma unroll
    for (int i = 0; i < 16; ++i) negf[i] = cfar;
    asm volatile("" : "+v"(negf));
    const int qpos = 64 * c + 32 * half + r;
    bool first = true;
    for (int j = j0; j <= j1; ++j) {
        const int bufk = ((j - j0) & 1) * KTILE, bufv = ((j - j0) & 1) * VTILE;
        if (j < j1) { const int nbk = ((j + 1 - j0) & 1) * KTILE, nbv = ((j + 1 - j0) & 1) * VTILE; *(LAS u32x4*)(lds + nbk + kwoff) = kreg; *(LAS u32x4*)(lds + nbv + vwoff) = vreg; ATT_KVOUT(j + 1); }
        if (j + 2 <= j1) { kreg = *(const u32x4*)(kgp + (size_t)(j + 2) * 64 * D); vreg = *(const u32x4*)(vgp + (size_t)(j + 2) * 64 * D); }
        if (j >= c - 8 && j <= c) {
            f32x16 p0, p1;
            bf16x8 ka[4], kb[4];
#pragma unroll
            for (int s = 0; s < 4; ++s) { ka[s] = *(const LAS bf16x8*)(lds + bufk + kroff + 32 * s); kb[s] = *(const LAS bf16x8*)(lds + bufk + kroff + 32 * KROW + 32 * s); }
            if (j <= c - 3) {
                p0 = __builtin_amdgcn_mfma_f32_32x32x16_bf16(ka[0], qf[0], negf, 0, 0, 0);
                p1 = __builtin_amdgcn_mfma_f32_32x32x16_bf16(kb[0], qf[0], negf, 0, 0, 0);
            } else {
                const LAS float* tb = tab + (qpos - 64 * j - 4 * h + 128 - 59);
#pragma unroll
                for (int i = 0; i < 16; ++i) { p0[i] = tb[59 - ((i & 3) + 8 * (i >> 2))] - mrun; p1[i] = tb[59 - 32 - ((i & 3) + 8 * (i >> 2))] - mrun; }
                p0 = __builtin_amdgcn_mfma_f32_32x32x16_bf16(ka[0], qf[0], p0, 0, 0, 0);
                p1 = __builtin_amdgcn_mfma_f32_32x32x16_bf16(kb[0], qf[0], p1, 0, 0, 0);
            }
#pragma unroll
            for (int s = 1; s < 4; ++s) {
                p0 = __builtin_amdgcn_mfma_f32_32x32x16_bf16(ka[s], qf[s], p0, 0, 0, 0);
                p1 = __builtin_amdgcn_mfma_f32_32x32x16_bf16(kb[s], qf[s], p1, 0, 0, 0);
            }
            float ta = max3f(p0[0], p0[1], p1[0]), tb2 = max3f(p0[2], p0[3], p1[1]);
            ta = max3f(ta, p1[2], p1[3]);
#pragma unroll
            for (int i = 4; i < 16; i += 4) { ta = max3f(ta, p0[i], p0[i + 1]); tb2 = max3f(tb2, p0[i + 2], p0[i + 3]); ta = max3f(ta, p1[i], p1[i + 1]); tb2 = max3f(tb2, p1[i + 2], p1[i + 3]); }
            float tm = fmaxf(ta, tb2);
            { auto rr = __builtin_amdgcn_permlane32_swap(__float_as_uint(tm), __float_as_uint(tm), false, false); tm = fmaxf(__uint_as_float(rr[0]), __uint_as_float(rr[1])); }
            if (first || __any(tm > THR)) {
                const float dl = first ? tm : fmaxf(tm, 0.f); mrun += dl;
                const float sc = __builtin_amdgcn_exp2f(-dl); lrun *= sc;
#pragma unroll
                for (int i = 0; i < 16; ++i) { p0[i] -= dl; p1[i] -= dl; o0[i] *= sc; o1[i] *= sc; negf[i] = cfar - mrun; }
                asm volatile("" : "+v"(negf));
                first = false;
            }
            float ps0 = 0.f, ps1 = 0.f;
#pragma unroll
            for (int i = 0; i < 16; ++i) { p0[i] = __builtin_amdgcn_exp2f(p0[i]); p1[i] = __builtin_amdgcn_exp2f(p1[i]); ps0 += p0[i]; ps1 += p1[i]; }
            lrun += ps0 + ps1;
            u32x4 w0, w1, w2, w3;
            w0.x = pk2(p0[0], p0[1]); w0.y = pk2(p0[2], p0[3]); w0.z = pk2(p0[4], p0[5]); w0.w = pk2(p0[6], p0[7]);
            w1.x = pk2(p0[8], p0[9]); w1.y = pk2(p0[10], p0[11]); w1.z = pk2(p0[12], p0[13]); w1.w = pk2(p0[14], p0[15]);
            w2.x = pk2(p1[0], p1[1]); w2.y = pk2(p1[2], p1[3]); w2.z = pk2(p1[4], p1[5]); w2.w = pk2(p1[6], p1[7]);
            w3.x = pk2(p1[8], p1[9]); w3.y = pk2(p1[10], p1[11]); w3.z = pk2(p1[12], p1[13]); w3.w = pk2(p1[14], p1[15]);
            const bf16x8 pf[4] = {__builtin_bit_cast(bf16x8, w0), __builtin_bit_cast(bf16x8, w1), __builtin_bit_cast(bf16x8, w2), __builtin_bit_cast(bf16x8, w3)};
#pragma unroll
            for (int ks = 0; ks < 4; ++ks) {
                const LAS unsigned char* tb = lds + bufv + troff + ks * 16 * 128;
                const s16x4 a_lo = vtr(tb), a_hi = vtr(tb + 8 * 128);
                const LAS unsigned char* tb1 = lds + bufv + (troff ^ 64) + ks * 16 * 128;
                const s16x4 b_lo = vtr(tb1), b_hi = vtr(tb1 + 8 * 128);
                const bf16x8 va = __builtin_shufflevector(a_lo, a_hi, 0, 1, 2, 3, 4, 5, 6, 7), vb = __builtin_shufflevector(b_lo, b_hi, 0, 1, 2, 3, 4, 5, 6, 7);
                o0 = __builtin_amdgcn_mfma_f32_32x32x16_bf16(va, pf[ks], o0, 0, 0, 0);
                o1 = __builtin_amdgcn_mfma_f32_32x32x16_bf16(vb, pf[ks], o1, 0, 0, 0);
            }
        }
        asm volatile("s_waitcnt lgkmcnt(0)\n\ts_barrier" ::: "memory");
    }
    lrun += __shfl_xor(lrun, 32);
    const float inv = 1.0f / lrun;
    bf16_t* orow = Og + (rb + 64 * c + 32 * half + r) * D + hh * HD + 4 * h;
#pragma unroll
    for (int g4 = 0; g4 < 4; ++g4) {
        u32x2 x, y;
        x.x = pk2(o0[4 * g4] * inv, o0[4 * g4 + 1] * inv); x.y = pk2(o0[4 * g4 + 2] * inv, o0[4 * g4 + 3] * inv);
        y.x = pk2(o1[4 * g4] * inv, o1[4 * g4 + 1] * inv); y.y = pk2(o1[4 * g4 + 2] * inv, o1[4 * g4 + 3] * inv);
        *(u32x2*)(orow + 8 * g4) = x; *(u32x2*)(orow + 32 + 8 * g4) = y;
    }
#undef ATT_KVOUT
}
}

#define XB_TMO      128
#define XB_XCNT(j)  (256  + 64 * (j))
#define XB_XSUB(j)  (1280 + 64 * (j))
#define XB_XGEN(j)  (2304 + 64 * (j))
#define XB_TOP      3328
#define XB_TOPGEN   3392
#define XCD_BAR_WORDS 3456
#define XB_SPIN_CAP (1u << 18)

__device__ __forceinline__ unsigned xb_ld(unsigned* p)              { return __hip_atomic_load(p, __ATOMIC_RELAXED, __HIP_MEMORY_SCOPE_AGENT); }
__device__ __forceinline__ unsigned xb_add(unsigned* p, unsigned v) { return __hip_atomic_fetch_add(p, v, __ATOMIC_RELAXED, __HIP_MEMORY_SCOPE_AGENT); }
__device__ __forceinline__ unsigned xb_xcc_id() { return (unsigned)__builtin_amdgcn_s_getreg((3 << 11) | 20) & 0xFu; }
#define XB_SPIN(cond, bar) do { unsigned _sp = 0; while (cond) { __builtin_amdgcn_s_sleep(1); \
    if ((++_sp & 255u) == 0u) { if (xb_ld(&(bar)[XB_TMO])) break; if (_sp > XB_SPIN_CAP) { atomicAdd(&(bar)[XB_TMO], 1u); break; } } } } while (0)

struct XcdBarrier {
    unsigned* bar; unsigned x;
    volatile LAS unsigned* st;
};

__device__ __forceinline__ XcdBarrier xcd_barrier_post(unsigned* bar, volatile LAS unsigned* st) {
    XcdBarrier b; b.bar = bar; b.x = xb_xcc_id(); b.st = st;
    if (threadIdx.x == 0) (void)xb_add(&bar[XB_XCNT(b.x)], 1u);
    return b;
}
__device__ __forceinline__ void xcd_barrier_complete(unsigned* bar, unsigned x, unsigned& nloc, unsigned& nx) {
    const unsigned G = gridDim.x * gridDim.y * gridDim.z;
    unsigned sum, cnt, mine, sp = 0u;
    for (;;) {
        sum = 0u; cnt = 0u; mine = 0u;
#pragma unroll
        for (unsigned j = 0; j < 16; ++j) { const unsigned c = xb_ld(&bar[XB_XCNT(j)]); sum += c; cnt += (c > 0u) ? 1u : 0u; mine = (j == x) ? c : mine; }
        if (sum == G) break;
        __builtin_amdgcn_s_sleep(1);
        if ((++sp & 255u) == 0u) { if (xb_ld(&bar[XB_TMO])) break; if (sp > XB_SPIN_CAP) { atomicAdd(&bar[XB_TMO], 1u); break; } }
    }
    nloc = mine > 0u ? mine : 1u; nx = cnt > 0u ? cnt : 1u;
}

__device__ __forceinline__ void xcd_barrier(const XcdBarrier& b) {
    asm volatile("s_waitcnt vmcnt(0)" ::: "memory");
    __syncthreads();
    if (threadIdx.x == 0) {
        unsigned* bar = b.bar;
        __builtin_amdgcn_s_waitcnt(0);
        unsigned nloc = b.st[0], nx = b.st[1];
        if (nloc == 0u) { xcd_barrier_complete(bar, b.x, nloc, nx); b.st[0] = nloc; b.st[1] = nx; }
        const unsigned old = xb_add(&bar[XB_XSUB(b.x)], 1u);
        const unsigned gen = old / nloc;
        if (old + 1u == (gen + 1u) * nloc) {
            __builtin_amdgcn_fence(__ATOMIC_RELEASE, "agent");
            asm volatile("s_waitcnt vmcnt(0)" ::: "memory");
            const unsigned og = xb_add(&bar[XB_TOP], 1u);
            const unsigned tg = og / nx;
            if (og + 1u == (tg + 1u) * nx) xb_add(&bar[XB_TOPGEN], 1u);
            else XB_SPIN(xb_ld(&bar[XB_TOPGEN]) == tg, bar);
            __builtin_amdgcn_fence(__ATOMIC_ACQUIRE, "agent");
            xb_add(&bar[XB_XGEN(b.x)], 1u);
            asm volatile("s_waitcnt vmcnt(0)" ::: "memory");
        } else {
            XB_SPIN(xb_ld(&bar[XB_XGEN(b.x)]) == gen, bar);
            __builtin_amdgcn_fence(__ATOMIC_ACQUIRE, "agent");
            asm volatile("s_waitcnt vmcnt(0)" ::: "memory");
        }
    }
    __syncthreads();
}


__global__ void __launch_bounds__(NWAVES * 64, 2) fwd_kernel(Args a) {
    extern __shared__ __attribute__((aligned(16))) unsigned char lds_raw[];
    cg::grid_group grid = cg::this_grid();
    LAS unsigned char* lds = (LAS unsigned char*)lds_raw;
    const int tid = threadIdx.x, lane = tid & 63, wave = __builtin_amdgcn_readfirstlane(tid >> 6);
    const int G = gridDim.x, gw = blockIdx.x * NWAVES + wave, NGW = G * NWAVES;
    unsigned char* ws = a.ws;
    bf16_t* Win_t = (bf16_t*)(ws + WS_WIN); bf16_t* Wout_t = (bf16_t*)(ws + WS_WOUT);
    bf16_t* Wgu_t0 = (bf16_t*)(ws + WS_WGU0); bf16_t* Wgu_t1 = (bf16_t*)(ws + WS_WGU1);
    bf16_t* Wd_t0 = (bf16_t*)(ws + WS_WD0); bf16_t* Wd_t1 = (bf16_t*)(ws + WS_WD1);
    bf16_t* Wqkv_t = (bf16_t*)(ws + WS_WQKV); bf16_t* Wo_t = (bf16_t*)(ws + WS_WO);
    bf16_t* KC = (bf16_t*)(ws + WS_KC); bf16_t* VC = (bf16_t*)(ws + WS_VC);
    bf16_t* XN = (bf16_t*)(ws + WS_XN); bf16_t* BA = (bf16_t*)(ws + WS_A); bf16_t* BB = (bf16_t*)(ws + WS_B); bf16_t* BC = (bf16_t*)(ws + WS_C);
    bf16_t* MO = (bf16_t*)(ws + WS_MO); bf16_t* OB = (bf16_t*)(ws + WS_O); bf16_t* HB = BA; bf16_t* XR = (bf16_t*)(ws + WS_XR);
    float* Y = a.out + O_Y;
    unsigned* qctr = (unsigned*)(ws + WS_CTL);
    { volatile LAS unsigned* st0 = (volatile LAS unsigned*)(lds + MISC_OFF); if (tid < 16) st0[tid] = 0u; }
    __syncthreads();
    XcdBarrier bar = xcd_barrier_post((unsigned*)(ws + WS_CTL) + CW_BAR, (volatile LAS unsigned*)(lds + MISC_OFF) + 8);

    {
        LAS float* scr = (LAS float*)(lds + wave * 16384);
        constexpr int I_IN = 16 * 96, I_OUT = 16 * 32, I_GU = 16 * 176, I_D = 44 * 32;
        constexpr int NITEMS = 2 * I_IN + 2 * I_OUT + 2 * I_GU + 2 * I_D;
        for (int it = gw; it < NITEMS; it += NGW) {
            int r = it;
            if (r < I_IN) { transpose_item<2>(a.conv_w_in, D, 3 * D, Win_t, scr, r, lane); continue; } r -= I_IN;
            if (r < I_OUT) { transpose_item<0>(a.conv_w_out, D, D, Wout_t, scr, r, lane); continue; } r -= I_OUT;
            if (r < I_GU) { transpose_item<1>(a.ffn_w_gate_up, D, 2 * DFF, Wgu_t0, scr, r, lane); continue; } r -= I_GU;
            if (r < I_GU) { transpose_item<1>(a.ffn_w_gate_up + (size_t)D * 2 * DFF, D, 2 * DFF, Wgu_t1, scr, r, lane); continue; } r -= I_GU;
            if (r < I_D) { transpose_item<0>(a.ffn_w_down, DFF, D, Wd_t0, scr, r, lane); continue; } r -= I_D;
            if (r < I_D) { transpose_item<0>(a.ffn_w_down + (size_t)DFF * D, DFF, D, Wd_t1, scr, r, lane); continue; } r -= I_D;
            if (r < I_IN) { transpose_item<0>(a.attn_w_qkv, D, 3 * D, Wqkv_t, scr, r, lane); continue; } r -= I_IN;
            transpose_item<0>(a.attn_w_o, D, D, Wo_t, scr, r, lane);
        }
        {
            const size_t n8 = (size_t)DB * CROWS * D / 8; const size_t gt = (size_t)blockIdx.x * (NWAVES * 64) + tid, NT = (size_t)G * NWAVES * 64;
            for (size_t i = gt; i < 2 * n8; i += NT) {
                const float* src = i < n8 ? a.cache_k + i * 8 : a.cache_v + (i - n8) * 8; bf16_t* dst = i < n8 ? KC + i * 8 : VC + (i - n8) * 8;
                const f32x4 v0 = *(const f32x4*)src, v1 = *(const f32x4*)(src + 4);
                u32x4 w; w.x = pk2(v0.x, v0.y); w.y = pk2(v0.z, v0.w); w.z = pk2(v1.x, v1.y); w.w = pk2(v1.z, v1.w);
                *(u32x4*)dst = w;
            }
        }
        for (int m = gw; m < M; m += NGW) { const float* xr = m < MP ? a.x_prompt + (size_t)m * D : a.x_sample + (size_t)(m - MP) * D; norm_row(xr, a.norm_mix_pre, XN + (size_t)m * D, lane); }
    }
    grid.sync();
    { pg8::Gemm g{XN, Win_t, M, 3 * D, D}; pg8::StaticOrder S; S.init(M, 3 * D, G, (int)blockIdx.x); pg8::EpiConvIn E{BA, BB};
      pg8::gemm_phase<pg8::EpiConvIn, pg8::StaticOrder, true, true>(lds, g, S, E); }
    xcd_barrier(bar);
    {
        const f32x4* wp = (const f32x4*)a.conv_kernel + lane;
        f32x4 w0[4], w1[4], w2[4];
#pragma unroll
        for (int j = 0; j < 4; ++j) { w0[j] = wp[64 * j]; w1[j] = wp[256 + 64 * j]; w2[j] = wp[512 + 64 * j]; }
        for (int blk = gw; blk < M / 4; blk += NGW) {
            const int m0 = blk * 4; const bool samp = m0 >= MP; const int t0 = samp ? ((m0 - MP) & 31) : (m0 & 2047); const int b = samp ? ((m0 - MP) >> 5) : (m0 >> 11); const int T = samp ? DS : SEQ;
            const u32x2* up = (const u32x2*)(BB + (size_t)m0 * D) + lane; const u32x2* bp = (const u32x2*)(BA + (size_t)m0 * D) + lane;
            u32x2 ur[6][4], br[4][4];
#pragma unroll
            for (int k = 2; k < 6; ++k)
#pragma unroll
                for (int j = 0; j < 4; ++j) { ur[k][j] = up[(k - 2) * 256 + 64 * j]; br[k - 2][j] = bp[(k - 2) * 256 + 64 * j]; }
            f32x4 h0[4], h1[4];
            if (t0 > 0) {
#pragma unroll
                for (int j = 0; j < 4; ++j) { const u32x2 a0 = up[64 * j - 512], a1 = up[64 * j - 256];
                    h0[j] = (f32x4){bflo(a0.x), bfhi(a0.x), bflo(a0.y), bfhi(a0.y)}; h1[j] = (f32x4){bflo(a1.x), bfhi(a1.x), bflo(a1.y), bfhi(a1.y)}; }
            } else if (samp) {
                const f32x4* st = (const f32x4*)(a.state_conv + (size_t)b * 2 * D) + lane;
#pragma unroll
                for (int j = 0; j < 4; ++j) { h0[j] = st[64 * j]; h1[j] = st[256 + 64 * j]; }
            } else {
#pragma unroll
                for (int j = 0; j < 4; ++j) { h0[j] = (f32x4){0.f, 0.f, 0.f, 0.f}; h1[j] = h0[j]; }
            }
            u32x2* yo = (u32x2*)(BC + (size_t)m0 * D) + lane;
            float* so = (t0 == T - 4) ? a.out + (samp ? O_CONVS : O_CONVP) + (size_t)b * 2 * D : nullptr;
#pragma unroll
            for (int j = 0; j < 4; ++j) {
                f32x4 u2 = h0[j], u1 = h1[j];
#pragma unroll
                for (int k = 0; k < 4; ++k) {
                    const u32x2 uw = ur[k + 2][j]; const f32x4 u0 = (f32x4){bflo(uw.x), bfhi(uw.x), bflo(uw.y), bfhi(uw.y)};
                    const u32x2 bw = br[k][j]; const f32x4 bg = (f32x4){bflo(bw.x), bfhi(bw.x), bflo(bw.y), bfhi(bw.y)};
                    const f32x4 y = bg * (w0[j] * u2 + w1[j] * u1 + w2[j] * u0);
                    u32x2 o; o.x = pk2(y.x, y.y); o.y = pk2(y.z, y.w); yo[k * 256 + 64 * j] = o;
                    if (so && k >= 2) *((f32x4*)(so + (size_t)(k - 2) * D) + lane + 64 * j) = u0;
                    u2 = u1; u1 = u0;
                }
            }
        }
    }
    xcd_barrier(bar);
    { pg8::Gemm g{BC, Wout_t, M, D, D}; pg8::StaticOrder S; S.init(M, D, G, (int)blockIdx.x); pg8::EpiBf16<0> E{MO, D, nullptr, 0, 0, 1.f};
      pg8::gemm_phase<pg8::EpiBf16<0>, pg8::StaticOrder, true, true>(lds, g, S, E); }
    xcd_barrier(bar);
    res_pass<0, 0>(a, MO, XR, XN, Y, a.norm_mix_post, a.norm_ffn_pre, gw, NGW, lane);
    xcd_barrier(bar);
    { pg8::Gemm g{XN, Wgu_t0, M, 2 * DFF, D}; pg8::StaticOrder S; S.init(M, 2 * DFF, G, (int)blockIdx.x); pg8::EpiSwiGLU E{HB};
      pg8::gemm_phase<pg8::EpiSwiGLU, pg8::StaticOrder, true, true>(lds, g, S, E); }
    xcd_barrier(bar);
    { pg8::Gemm g{HB, Wd_t0, M, D, DFF}; pg8::StaticOrder S; S.init(M, D, G, (int)blockIdx.x); pg8::EpiBf16<0> E{MO, D, nullptr, 0, 0, 1.f};
      pg8::gemm_phase<pg8::EpiBf16<0>, pg8::StaticOrder, true, true>(lds, g, S, E); }
    xcd_barrier(bar);
    res_pass<1, 0>(a, MO, XR, XN, Y, a.norm_ffn_post, a.norm_mix_pre + D, gw, NGW, lane);
    xcd_barrier(bar);
    { pg8::Gemm g{XN, Wqkv_t, M, 3 * D, D}; pg8::StaticOrder S; S.init(M, 3 * D, G, (int)blockIdx.x);
      pg8::EpiBf16<0> E{BA, D, nullptr, D, (size_t)(WS_B - WS_A) / 2, QSCALE};
      pg8::gemm_phase<pg8::EpiBf16<0>, pg8::StaticOrder, true, true>(lds, g, S, E); }
    xcd_barrier(bar);
    {
        constexpr int NGS1 = (DB * NH) / 8, NPU1 = NB * NH * 8, NGS = NGS1 * REP_SAMPLE, NPU = NPU1 * REP_PROMPT;
        LAS unsigned char* vlds = lds + wave * 4096; LAS float* tabw = (LAS float*)(lds + 32768 + wave * 1088);
        volatile LAS int* slot = (volatile LAS int*)(lds + 65536);
        if (tid == 0) *slot = (int)atomicAdd(qctr, 1u);
        __syncthreads();
        int wi = *slot;
        __syncthreads();
        while (wi < NGS + NPU) {
            int nxt = 0;
            if (tid == 0) nxt = (int)atomicAdd(qctr, 1u);
            if (wi < NGS) {
                att::Item it;
                const int si = (wi % NGS1) * 8 + wave, b = si >> 4, hh = si & 15;
                const size_t rb = (size_t)MP + (size_t)b * DS;
                it.q = BA + rb * D + hh * HD; it.o = OB + rb * D + hh * HD;
                it.kc = KC + (size_t)b * CROWS * D + hh * HD; it.vc = VC + (size_t)b * CROWS * D + hh * HD; it.kn = BB + rb * D + hh * HD; it.vn = BC + rb * D + hh * HD; it.nc = CROWS / 32;
                it.kt0 = 0; it.kt1 = CROWS / 32 + 1; it.qpos0 = CROWS; it.head = hh;
                it.kso = (wi < NGS1) ? a.out + O_KS + (size_t)b * DS * D + hh * HD : nullptr; it.vso = a.out + O_VS + (size_t)b * DS * D + hh * HD;
                att::attn_item(it, vlds, tabw, a.attn_rel_bias, lane);
            } else {
                const int u = (wi - NGS) % NPU1, bh = u >> 3, cq = 7 - (u & 7);
                att::attn_unit(bh >> 4, bh & 15, cq, BA, BB, BC, OB, a.out + O_KP, a.out + O_VP, a.attn_rel_bias, lds, tid, lane, wave);
            }
            __syncthreads();
            if (tid == 0) *slot = nxt;
            __syncthreads();
            wi = *slot;
        }
    }
    xcd_barrier(bar);
    { pg8::Gemm g{OB, Wo_t, M, D, D}; pg8::StaticOrder S; S.init(M, D, G, (int)blockIdx.x); pg8::EpiBf16<0> E{MO, D, nullptr, 0, 0, 1.f};
      pg8::gemm_phase<pg8::EpiBf16<0>, pg8::StaticOrder, true, true>(lds, g, S, E); }
    xcd_barrier(bar);
    res_pass<1, 0>(a, MO, XR, XN, Y, a.norm_mix_post + D, a.norm_ffn_pre + D, gw, NGW, lane);
    xcd_barrier(bar);
    { pg8::Gemm g{XN, Wgu_t1, M, 2 * DFF, D}; pg8::StaticOrder S; S.init(M, 2 * DFF, G, (int)blockIdx.x); pg8::EpiSwiGLU E{HB};
      pg8::gemm_phase<pg8::EpiSwiGLU, pg8::StaticOrder, true, true>(lds, g, S, E); }
    xcd_barrier(bar);
    { pg8::Gemm g{HB, Wd_t1, M, D, DFF}; pg8::StaticOrder S; S.init(M, D, G, (int)blockIdx.x); pg8::EpiBf16<0> E{MO, D, nullptr, 0, 0, 1.f};
      pg8::gemm_phase<pg8::EpiBf16<0>, pg8::StaticOrder, true, true>(lds, g, S, E); }
    xcd_barrier(bar);
    res_pass<1, 1>(a, MO, XR, XN, Y, a.norm_ffn_post + D, nullptr, gw, NGW, lane);
}

extern "C" void kernel_launch(void* const* d_in, const int* in_sizes, int n_in, void* d_out, int out_size, void* d_ws, size_t ws_size, hipStream_t stream) {
    static int grid = 0;
    if (grid == 0) {
        if (n_in != 17 || (size_t)out_size != O_END || ws_size < WS_END) { fprintf(stderr, "kernel_launch: unexpected shapes n_in %d out %d ws %zu\n", n_in, out_size, ws_size); grid = -1; return; }
        int dev = 0, cus = 0, per_cu = 0;
        hipGetDevice(&dev); hipDeviceGetAttribute(&cus, hipDeviceAttributeMultiprocessorCount, dev);
        if (hipFuncSetAttribute((const void*)fwd_kernel, hipFuncAttributeMaxDynamicSharedMemorySize, LDS_BYTES) != hipSuccess) { fprintf(stderr, "kernel_launch: hipFuncSetAttribute failed\n"); grid = -1; return; }
        if (hipOccupancyMaxActiveBlocksPerMultiprocessor(&per_cu, (const void*)fwd_kernel, NWAVES * 64, LDS_BYTES) != hipSuccess || per_cu < 1) { fprintf(stderr, "kernel_launch: occupancy query says %d\n", per_cu); per_cu = 1; }
        (void)hipGetLastError();
        grid = cus;
    }
    if (grid < 0) return;
    if (hipMemsetAsync((char*)d_ws + WS_CTL, 0, CTL_BYTES, stream) != hipSuccess) { fprintf(stderr, "kernel_launch: memset failed\n"); return; }
    Args a{};
    const float** p = (const float**)&a;
    for (int i = 0; i < 17; ++i) p[i] = (const float*)d_in[i];
    a.out = (float*)d_out; a.ws = (unsigned char*)d_ws;
    void* args[] = {&a};
    hipError_t e = hipLaunchCooperativeKernel((const void*)fwd_kernel, dim3(grid), dim3(NWAVES * 64), args, LDS_BYTES, stream);
    if (e != hipSuccess) fprintf(stderr, "cooperative launch failed: %s (grid %d)\n", hipGetErrorString(e), grid);
}
```

```cpp
#include <hip/hip_runtime.h>
#include <hip/hip_cooperative_groups.h>
#include <cstdio>
#include <cstdint>
namespace cg = cooperative_groups;
namespace pg8 {
#define PG8_LAS __attribute__((address_space(3)))
typedef unsigned short bf16_t;
typedef short bf16x8 __attribute__((ext_vector_type(8)));
typedef float f32x4 __attribute__((ext_vector_type(4)));
typedef unsigned u32x4 __attribute__((ext_vector_type(4)));
constexpr int BM = 256, BK = 64, HALF = 128, HTB = HALF * BK * 2  , STAGE_BYTES = 8 * HTB, NXCD = 8, WGM = 8;

__host__ __device__ __forceinline__ int lds_byte(int r, int c) { const int st = (r >> 4) * 2 + (c >> 5), rr = r & 15, cc = c & 31, ob = rr * 64 + cc * 2; return st * 1024 + (ob ^ (((ob >> 9) & 1) << 5)); }
__host__ __device__ __forceinline__ void stage_rc(int b, int& R, int& C) { const int st = b / 1024, sb = b % 1024, swz = sb ^ (((sb >> 9) & 1) << 5); R = (st >> 1) * 16 + swz / 64; C = (st & 1) * 32 + (swz % 64) / 2; }
__host__ __device__ __forceinline__ int perm32(int rho) { const int n = rho >> 4, i = rho & 15; return 8 * (i >> 2) + 4 * n + (i & 3); }

struct Unit { int pm, pn; int kb; };
struct Gemm { const bf16_t* A; const bf16_t* Bt; int M, N, K; int ld; };

struct StaticOrder {
    int nM, nN, nwg, G, c;
    __host__ __device__ void init(int M, int N, int G_, int c_) { nM = M / BM; nN = N / BM; nwg = nM * nN; G = G_; c = c_; }
    __host__ __device__ bool next(int i, Unit& u) const {
        const long L = (long)i * G + c; if (L >= nwg) return false;
        int wgid = (int)L; { const int q = nwg / NXCD, r = nwg % NXCD, xcd = wgid % NXCD, off = wgid / NXCD; wgid = (xcd < r ? xcd * (q + 1) : r * (q + 1) + (xcd - r) * q) + off; }
        const int nig = WGM * nN, gid = wgid / nig, fm = gid * WGM, gsz = (nM - fm) < WGM ? (nM - fm) : WGM;
        u.pm = fm + ((wgid % nig) % gsz); u.pn = (wgid % nig) / gsz; u.kb = 0; return true;
    }
    __device__ __forceinline__ void a_ready(const Unit&) const {}
    __device__ __forceinline__ void done(const Unit&) const {}
};

__device__ __forceinline__ unsigned cvt_pk_bf16(float lo, float hi) { unsigned r; asm volatile("v_cvt_pk_bf16_f32 %0, %1, %2" : "=v"(r) : "v"(lo), "v"(hi)); return r; }
typedef float f32x2 __attribute__((ext_vector_type(2)));
__device__ __forceinline__ f32x2 gelu_pk(f32x2 v) {
    const f32x2 av = __builtin_elementwise_abs(v), d = av * 0.2316418882f + 1.0f;
    f32x2 t; t.x = __builtin_amdgcn_rcpf(d.x); t.y = __builtin_amdgcn_rcpf(d.y);
    f32x2 q = t * 0.5307027145f + (-0.7265760135f); q = q * t + 0.7107068705f; q = q * t + (-0.142248368f); q = q * t + 0.127414796f; q = q * t;
    const f32x2 s = (v * v) * (-0.72134752044f);
    f32x2 e; e.x = __builtin_amdgcn_exp2f(s.x); e.y = __builtin_amdgcn_exp2f(s.y);
    const f32x2 m = v * (q * e), r = v - m;
    f32x2 o; o.x = v.x < 0.f ? m.x : r.x; o.y = v.y < 0.f ? m.y : r.y; return o;
}

template <int ACT  > struct EpiBf16 {
    static constexpr bool PERM = true, AFTER_DRAIN = false; static_assert(ACT == 0 || ACT == 1, "EpiBf16: ACT is 0 (none) or 1 (gelu_pk)");
    bf16_t* O; int ldc; const float* bias; int split_cols; size_t split_stride; float scale0;
    __device__ __forceinline__ void operator()(const f32x4 (&acc)[2][2][4][2], const Unit& u, int wr, int wc, int fr, int fq) const {
        const int row0 = u.pm * BM + wr * 64 + fr; int colt = u.pn * BM; bf16_t* base = O;
        float sc = 1.f; if (split_cols) { const int t = colt / split_cols; base += (size_t)t * split_stride; colt -= t * split_cols; if (t == 0) sc = scale0; }
        const int col0 = colt + wc * 32 + 8 * fq, bcol0 = u.pn * BM + wc * 32 + 8 * fq;
        f32x4 bv[2][2];
#pragma unroll
        for (int bj = 0; bj < 2; ++bj)
#pragma unroll
            for (int n = 0; n < 2; ++n) bv[bj][n] = bias ? *(const f32x4*)(bias + bcol0 + bj * HALF + 4 * n) : (f32x4){0.f, 0.f, 0.f, 0.f};
#pragma unroll
        for (int ai = 0; ai < 2; ++ai)
#pragma unroll
            for (int m = 0; m < 4; ++m) { bf16_t* rowp = base + (size_t)(row0 + ai * HALF + m * 16) * ldc + col0;
#pragma unroll
                for (int bj = 0; bj < 2; ++bj) { f32x4 v0 = acc[ai][bj][m][0] + bv[bj][0], v1 = acc[ai][bj][m][1] + bv[bj][1];
                    if (ACT == 1) { f32x2 a = gelu_pk((f32x2){v0[0], v0[1]}), b = gelu_pk((f32x2){v0[2], v0[3]}), c = gelu_pk((f32x2){v1[0], v1[1]}), d = gelu_pk((f32x2){v1[2], v1[3]});
                        v0 = (f32x4){a.x, a.y, b.x, b.y}; v1 = (f32x4){c.x, c.y, d.x, d.y}; }
                    v0 = v0 * sc; v1 = v1 * sc; u32x4 w; w.x = cvt_pk_bf16(v0[0], v0[1]); w.y = cvt_pk_bf16(v0[2], v0[3]); w.z = cvt_pk_bf16(v1[0], v1[1]); w.w = cvt_pk_bf16(v1[2], v1[3]);
                    *(u32x4*)(rowp + bj * HALF) = w; } }
    }
};
template <class Epi, class Sched, bool ALIGN_EPI = false, bool SP2 = false>
__device__ __forceinline__ void gemm_phase(PG8_LAS unsigned char* lds, const Gemm g, const Sched& S, const Epi& E) {
    int tid_ = threadIdx.x; asm volatile("" : "+v"(tid_)); const int tid = tid_, wid = __builtin_amdgcn_readfirstlane(tid >> 6), lane = tid & 63, wr = wid >> 2, wc = wid & 3, fr = lane & 15, fq = lane >> 4;
    const int K = g.ld, nt = g.K / BK;
    unsigned voffA[2], voffB[2];
#pragma unroll
    for (int i = 0; i < 2; ++i) { int R, C; stage_rc(tid * 16 + i * 8192, R, C); const int Rb = Epi::PERM ? ((R & ~31) + perm32(R & 31)) : R;
        voffA[i] = (unsigned)(R * K + C) * 2u; voffB[i] = (unsigned)(Rb * K + C) * 2u; }
    const size_t kstep = (size_t)(BK * 2);
    const size_t hstep = (size_t)HALF * K * 2;
    const size_t tstep = 2 * hstep;
    const unsigned ldsw = (unsigned)wid * 1024u;
    const int aoff = lds_byte(wr * 64 + fr, fq * 8), boff = lds_byte(wc * 32 + fr, fq * 8);
#define PG8_SA(b, h) (((b) * 2 + (h)) * HTB)
#define PG8_SB(b, h) ((4 + (b) * 2 + (h)) * HTB)
#define PG8_STAGE(bufoff, gbase, voff) do { _Pragma("unroll") for (int _i = 0; _i < 2; ++_i) \
        __builtin_amdgcn_global_load_lds((const unsigned*)((const char*)(gbase) + (voff)[_i]), (PG8_LAS unsigned*)(lds + (bufoff) + ldsw + _i * 8192), 16, 0, 0); } while (0)
#define PG8_LDA(dst, b, h) do { _Pragma("unroll") for (int m = 0; m < 4; ++m) _Pragma("unroll") for (int k = 0; k < 2; ++k) dst[m][k] = *(const PG8_LAS bf16x8*)(lds + PG8_SA(b, h) + aoff + m * 2048 + k * 1024); } while (0)
#define PG8_LDB(dst, b, h) do { _Pragma("unroll") for (int n = 0; n < 2; ++n) _Pragma("unroll") for (int k = 0; k < 2; ++k) dst[n][k] = *(const PG8_LAS bf16x8*)(lds + PG8_SB(b, h) + boff + n * 2048 + k * 1024); } while (0)
#define PG8_MMA(ai, bj, At, Bt) do { __builtin_amdgcn_s_setprio(1); _Pragma("unroll") for (int m = 0; m < 4; ++m) _Pragma("unroll") for (int n = 0; n < 2; ++n) _Pragma("unroll") for (int k = 0; k < 2; ++k) \
        acc[ai][bj][m][n] = __builtin_amdgcn_mfma_f32_16x16x32_bf16(Bt[n][k], At[m][k], acc[ai][bj][m][n], 0, 0, 0); __builtin_amdgcn_s_setprio(0); } while (0)
#define PG8_WAIT_V(n) asm volatile("s_waitcnt vmcnt(" #n ")" ::: "memory")
#define PG8_WAIT_L(n) asm volatile("s_waitcnt lgkmcnt(" #n ")" ::: "memory")
#define PG8_BAR __builtin_amdgcn_s_barrier()
#define PG8_SCHED __builtin_amdgcn_sched_barrier(0)
    Unit cur, nxt; int ui = 0;
    if (!S.next(0, cur)) return;
    f32x4 acc[2][2][4][2];
#pragma unroll
    for (int a = 0; a < 2; ++a)
#pragma unroll
        for (int b = 0; b < 2; ++b)
#pragma unroll
            for (int m = 0; m < 4; ++m)
#pragma unroll
                for (int n = 0; n < 2; ++n) acc[a][b][m][n] = (f32x4){0.f, 0.f, 0.f, 0.f};
    bf16x8 At[4][2], B0[2][2], B1[2][2];
    const char* cA = (const char*)g.A + (size_t)cur.pm * tstep + cur.kb; const char* cB = (const char*)g.Bt + (size_t)cur.pn * tstep + cur.kb;
    S.a_ready(cur);
    if constexpr (SP2) {
        PG8_STAGE(PG8_SB(0, 0), cB, voffB); PG8_STAGE(PG8_SB(0, 1), cB + hstep, voffB); PG8_STAGE(PG8_SA(0, 0), cA, voffA); PG8_STAGE(PG8_SA(0, 1), cA + hstep, voffA);
        if (wr == 1) PG8_BAR;
        PG8_WAIT_V(2); PG8_BAR;
        PG8_STAGE(PG8_SB(1, 0), cB + kstep, voffB); PG8_STAGE(PG8_SA(1, 0), cA + kstep, voffA); PG8_STAGE(PG8_SB(1, 1), cB + hstep + kstep, voffB);
        PG8_WAIT_V(6); PG8_BAR;
    } else {
        PG8_STAGE(PG8_SB(0, 0), cB, voffB); PG8_STAGE(PG8_SA(0, 0), cA, voffA); PG8_STAGE(PG8_SB(0, 1), cB + hstep, voffB); PG8_STAGE(PG8_SA(0, 1), cA + hstep, voffA);
        if (wr == 1) PG8_BAR;
        PG8_WAIT_V(4); PG8_BAR;
        PG8_STAGE(PG8_SB(1, 0), cB + kstep, voffB); PG8_STAGE(PG8_SA(1, 0), cA + kstep, voffA); PG8_STAGE(PG8_SB(1, 1), cB + hstep + kstep, voffB);
        PG8_WAIT_V(6); PG8_BAR;
    }
    for (;;) {
        const bool has_next = S.next(ui + 1, nxt);
        const char* nA = has_next ? (const char*)g.A + (size_t)nxt.pm * tstep + nxt.kb : cA; const char* nB = has_next ? (const char*)g.Bt + (size_t)nxt.pn * tstep + nxt.kb : cB;
        for (int t = 0; t < nt; t += 2) {
            const bool last = (t == nt - 2);
            const char* a1 = cA + (size_t)(t + 1) * kstep;
            const char* a2 = last ? nA : cA + (size_t)(t + 2) * kstep; const char* b2 = last ? nB : cB + (size_t)(t + 2) * kstep;
            const char* a3 = a2 + kstep; const char* b3 = b2 + kstep;
            if (last && has_next) S.a_ready(nxt);
            if constexpr (SP2) {
            PG8_LDB(B0, 0, 0); PG8_LDB(B1, 0, 1); PG8_SCHED; PG8_LDA(At, 0, 0); PG8_STAGE(PG8_SA(1, 1), a1 + hstep, voffA);
            PG8_WAIT_V(8); PG8_WAIT_L(0); PG8_BAR; PG8_MMA(0, 0, At, B0); PG8_MMA(0, 1, At, B1); PG8_BAR; PG8_SCHED;
            PG8_LDA(At, 0, 1); PG8_STAGE(PG8_SB(0, 0), b2, voffB); PG8_STAGE(PG8_SB(0, 1), b2 + hstep, voffB); PG8_STAGE(PG8_SA(0, 0), a2, voffA);
            PG8_WAIT_V(8); PG8_WAIT_L(0); PG8_BAR; PG8_MMA(1, 0, At, B0); PG8_MMA(1, 1, At, B1); PG8_BAR; PG8_SCHED;
            PG8_LDB(B0, 1, 0); PG8_LDB(B1, 1, 1); PG8_SCHED; PG8_LDA(At, 1, 0); PG8_STAGE(PG8_SA(0, 1), a2 + hstep, voffA);
            PG8_WAIT_V(8); PG8_WAIT_L(0); PG8_BAR; PG8_MMA(0, 0, At, B0); PG8_MMA(0, 1, At, B1); PG8_BAR; PG8_SCHED;
            PG8_LDA(At, 1, 1); PG8_STAGE(PG8_SB(1, 0), b3, voffB); PG8_STAGE(PG8_SB(1, 1), b3 + hstep, voffB); PG8_STAGE(PG8_SA(1, 0), a3, voffA);
            PG8_WAIT_V(8); PG8_WAIT_L(0); PG8_BAR; PG8_MMA(1, 0, At, B0); PG8_MMA(1, 1, At, B1); PG8_BAR; PG8_SCHED;
            } else {
            PG8_LDB(B0, 0, 0); PG8_SCHED; PG8_LDA(At, 0, 0); PG8_STAGE(PG8_SA(1, 1), a1 + hstep, voffA);
            PG8_WAIT_L(8); PG8_BAR; PG8_WAIT_L(0); PG8_MMA(0, 0, At, B0); PG8_BAR; PG8_SCHED;
            PG8_LDB(B1, 0, 1); PG8_STAGE(PG8_SB(0, 0), b2, voffB);
            PG8_BAR; PG8_WAIT_L(0); PG8_MMA(0, 1, At, B1); PG8_BAR;
            PG8_LDA(At, 0, 1); PG8_STAGE(PG8_SA(0, 0), a2, voffA);
            PG8_BAR; PG8_WAIT_L(0); PG8_MMA(1, 0, At, B0); PG8_BAR; PG8_SCHED;
            PG8_STAGE(PG8_SB(0, 1), b2 + hstep, voffB);
            PG8_WAIT_V(6); PG8_BAR; PG8_MMA(1, 1, At, B1); PG8_BAR;
            PG8_LDB(B0, 1, 0); PG8_SCHED; PG8_LDA(At, 1, 0); PG8_STAGE(PG8_SA(0, 1), a2 + hstep, voffA);
            PG8_WAIT_L(8); PG8_BAR; PG8_WAIT_L(0); PG8_MMA(0, 0, At, B0); PG8_BAR; PG8_SCHED;
            PG8_LDB(B1, 1, 1); PG8_STAGE(PG8_SB(1, 0), b3, voffB);
            PG8_BAR; PG8_WAIT_L(0); PG8_MMA(0, 1, At, B1); PG8_BAR;
            PG8_LDA(At, 1, 1); PG8_STAGE(PG8_SA(1, 0), a3, voffA);
            PG8_BAR; PG8_WAIT_L(0); PG8_MMA(1, 0, At, B0); PG8_BAR; PG8_SCHED;
            PG8_STAGE(PG8_SB(1, 1), b3 + hstep, voffB);
            PG8_WAIT_V(6); PG8_BAR; PG8_MMA(1, 1, At, B1); PG8_BAR;
            }
        }
        if constexpr (ALIGN_EPI) { if (wr == 0) PG8_BAR; }
        if constexpr (!Epi::AFTER_DRAIN) { E(acc, cur, wr, wc, fr, fq); S.done(cur); }
        if (!has_next) break;
#pragma unroll
        for (int a = 0; a < 2; ++a)
#pragma unroll
            for (int b = 0; b < 2; ++b)
#pragma unroll
                for (int m = 0; m < 4; ++m)
#pragma unroll
                    for (int n = 0; n < 2; ++n) acc[a][b][m][n] = (f32x4){0.f, 0.f, 0.f, 0.f};
        cur = nxt; cA = nA; cB = nB; ++ui;
        if constexpr (ALIGN_EPI) { if (wr == 1) PG8_BAR; }
    }
    PG8_WAIT_V(0);
    if constexpr (!ALIGN_EPI) { if (wr == 0) PG8_BAR; }
    PG8_BAR;
    if constexpr (Epi::AFTER_DRAIN) { E.fused(acc, cur, wr, wc, fr, fq, lds, wid, lane); S.done(cur); }
#undef PG8_SA
#undef PG8_SB
#undef PG8_STAGE
#undef PG8_LDA
#undef PG8_LDB
#undef PG8_MMA
#undef PG8_WAIT_V
#undef PG8_WAIT_L
#undef PG8_BAR
#undef PG8_SCHED
}
}

#define LAS __attribute__((address_space(3)))
typedef unsigned short bf16_t;
typedef unsigned u32x4 __attribute__((ext_vector_type(4)));
typedef unsigned u32x2 __attribute__((ext_vector_type(2)));
typedef float f32x4 __attribute__((ext_vector_type(4)));
typedef float f32x16 __attribute__((ext_vector_type(16)));
typedef short bf16x8 __attribute__((ext_vector_type(8)));
typedef short s16x4 __attribute__((ext_vector_type(4)));

constexpr int D = 1024, NB = 32, SEQ = 2048, DB = 32, DS = 32, NH = 16, HD = 64, DFF = 2816;
constexpr int MP = NB * SEQ;
constexpr int MS = DB * DS;
constexpr int M = MP + MS;
constexpr int CROWS = 512;
constexpr float EPS = 1e-6f;
constexpr float LOG2E = 1.4426950408889634f;
constexpr float QSCALE = 0.125f * LOG2E;
constexpr int NWAVES = 8;
#ifndef REP_KVOUT
#define REP_KVOUT 1
#endif
#ifndef REP_SAMPLE
#define REP_SAMPLE 1
#endif
#ifndef REP_PROMPT
#define REP_PROMPT 1
#endif

constexpr size_t O_Y = 0;
constexpr size_t O_CONVP = (size_t)M * D;
constexpr size_t O_CONVS = O_CONVP + 65536;
constexpr size_t O_KP = O_CONVS + 65536;
constexpr size_t O_VP = O_KP + (size_t)NB * CROWS * D;
constexpr size_t O_KS = O_VP + (size_t)NB * CROWS * D;
constexpr size_t O_VS = O_KS + (size_t)MS * D;
constexpr size_t O_END = O_VS + (size_t)MS * D;

constexpr size_t MiB = 1u << 20;
constexpr size_t WS_WIN = 0, WS_WOUT = 6 * MiB, WS_WGU0 = 8 * MiB, WS_WGU1 = 19 * MiB, WS_WD0 = 30 * MiB, WS_WD1 = 30 * MiB + 5632 * 1024,
                 WS_WQKV = 41 * MiB, WS_WO = 47 * MiB, WS_PART = 50 * MiB  , WS_CTL = 120 * MiB;
constexpr size_t WS_XN = 128 * MiB, WS_A = 258 * MiB, WS_B = 388 * MiB, WS_C = 518 * MiB, WS_MO = 648 * MiB, WS_O = 128 * MiB  , WS_XR = 778 * MiB, WS_END = 908 * MiB;

constexpr int LDS_BYTES = 131072 + 8192, MISC_OFF = 131072 + 4096, CW_BAR = 4096  , CTL_BYTES = 65536;

__device__ __forceinline__ float bf2f(unsigned short b) { return __uint_as_float(((unsigned)b) << 16); }
__device__ __forceinline__ float bflo(unsigned w) { return __uint_as_float(w << 16); }
__device__ __forceinline__ float bfhi(unsigned w) { return __uint_as_float(w & 0xffff0000u); }
__device__ __forceinline__ unsigned pk2(float lo, float hi) { return pg8::cvt_pk_bf16(lo, hi); }
__device__ __forceinline__ float wave_sum(float v) {
#pragma unroll
    for (int o = 1; o < 64; o <<= 1) v += __shfl_xor(v, o);
    return v;
}

namespace pg8 {
struct EpiConvIn {
    static constexpr bool PERM = true, AFTER_DRAIN = false;
    bf16_t* Bg; bf16_t* U;
    __device__ __forceinline__ void operator()(const f32x4 (&acc)[2][2][4][2], const Unit& u, int wr, int wc, int fr, int fq) const {
        const int row0 = u.pm * BM + wr * 64 + fr;
        if (u.pn < 4) {
            const int col0 = u.pn * BM + wc * 32 + 8 * fq;
#pragma unroll
            for (int ai = 0; ai < 2; ++ai)
#pragma unroll
                for (int m = 0; m < 4; ++m) { bf16_t* rowp = Bg + (size_t)(row0 + ai * HALF + m * 16) * 1024 + col0;
#pragma unroll
                    for (int bj = 0; bj < 2; ++bj) { const f32x4 v0 = acc[ai][bj][m][0], v1 = acc[ai][bj][m][1];
                        u32x4 w; w.x = cvt_pk_bf16(v0[0], v0[1]); w.y = cvt_pk_bf16(v0[2], v0[3]); w.z = cvt_pk_bf16(v1[0], v1[1]); w.w = cvt_pk_bf16(v1[2], v1[3]);
                        *(u32x4*)(rowp + bj * HALF) = w; } }
        } else {
            const int col0 = (u.pn - 4) * HALF + wc * 32 + 8 * fq;
#pragma unroll
            for (int ai = 0; ai < 2; ++ai)
#pragma unroll
                for (int m = 0; m < 4; ++m) { bf16_t* rowp = U + (size_t)(row0 + ai * HALF + m * 16) * 1024 + col0;
                    const f32x4 v0 = acc[ai][0][m][0] * acc[ai][1][m][0], v1 = acc[ai][0][m][1] * acc[ai][1][m][1];
                    u32x4 w; w.x = cvt_pk_bf16(v0[0], v0[1]); w.y = cvt_pk_bf16(v0[2], v0[3]); w.z = cvt_pk_bf16(v1[0], v1[1]); w.w = cvt_pk_bf16(v1[2], v1[3]);
                    *(u32x4*)(rowp) = w; }
        }
    }
};
struct EpiSwiGLU {
    static constexpr bool PERM = true, AFTER_DRAIN = false;
    bf16_t* H;
    __device__ __forceinline__ float act(float g, float uu) const { return g * uu * __builtin_amdgcn_rcpf(1.0f + __builtin_amdgcn_exp2f(-1.4426950408889634f * g)); }
    __device__ __forceinline__ void operator()(const f32x4 (&acc)[2][2][4][2], const Unit& u, int wr, int wc, int fr, int fq) const {
        const int row0 = u.pm * BM + wr * 64 + fr;
        const int col0 = u.pn * HALF + wc * 32 + 8 * fq;
#pragma unroll
        for (int ai = 0; ai < 2; ++ai)
#pragma unroll
            for (int m = 0; m < 4; ++m) { bf16_t* rowp = H + (size_t)(row0 + ai * HALF + m * 16) * 2816 + col0;
                const f32x4 g0 = acc[ai][0][m][0], g1 = acc[ai][0][m][1], u0 = acc[ai][1][m][0], u1 = acc[ai][1][m][1];
                u32x4 w; w.x = cvt_pk_bf16(act(g0[0], u0[0]), act(g0[1], u0[1])); w.y = cvt_pk_bf16(act(g0[2], u0[2]), act(g0[3], u0[3]));
                w.z = cvt_pk_bf16(act(g1[0], u1[0]), act(g1[1], u1[1])); w.w = cvt_pk_bf16(act(g1[2], u1[2]), act(g1[3], u1[3]));
                *(u32x4*)(rowp) = w; }
    }
};
struct TailOrder {
    int nsplit, ksub_bytes, G, c;
    __device__ __forceinline__ bool next(int i, Unit& u) const { const int L = i * G + c; if (L >= 16 * nsplit) return false; const int ks = L >> 4, t = L & 15; u.pm = 256 + (t & 3); u.pn = t >> 2; u.kb = ks * ksub_bytes; return true; }
    __device__ __forceinline__ void a_ready(const Unit&) const {}
    __device__ __forceinline__ void done(const Unit&) const {}
};
struct EpiPartF32 {
    static constexpr bool PERM = false, AFTER_DRAIN = false;
    float* P; int ksub_bytes;
    __device__ __forceinline__ void operator()(const f32x4 (&acc)[2][2][4][2], const Unit& u, int wr, int wc, int fr, int fq) const {
        const int ks = u.kb / ksub_bytes; const int row0 = (u.pm - 256) * BM + wr * 64 + fr, col0 = u.pn * BM + wc * 32 + 4 * fq;
        float* base = P + (size_t)ks * 1024 * 1024;
#pragma unroll
        for (int ai = 0; ai < 2; ++ai)
#pragma unroll
            for (int m = 0; m < 4; ++m) { float* rowp = base + (size_t)(row0 + ai * HALF + m * 16) * 1024 + col0;
#pragma unroll
                for (int bj = 0; bj < 2; ++bj)
#pragma unroll
                    for (int n = 0; n < 2; ++n) *(f32x4*)(rowp + bj * HALF + n * 16) = acc[ai][bj][m][n]; }
    }
};
}

struct Args {
    const float *x_prompt, *x_sample, *state_conv, *cache_k, *cache_v, *conv_w_in, *conv_kernel, *conv_w_out, *attn_w_qkv, *attn_w_o, *attn_rel_bias,
        *norm_mix_pre, *norm_mix_post, *norm_ffn_pre, *norm_ffn_post, *ffn_w_gate_up, *ffn_w_down;
    float* out; unsigned char* ws;
};

template <int MODE> __device__ __forceinline__ int dest_row(int n) {
    if (MODE == 1) { const int hh = n / DFF, rem = n - hh * DFF; return ((rem >> 7) << 8) + (hh << 7) + (rem & 127); }
    if (MODE == 2) { if (n < 1024) return n; const int np = n - 1024, hh = np >> 10, rem = np & 1023; return 1024 + ((rem >> 7) << 8) + (hh << 7) + (rem & 127); }
    return n;
}
template <int MODE> __device__ __forceinline__ void transpose_item(const float* W, int K, int N, bf16_t* WT, LAS float* scr, int item, int lane) {
    const int nblk = N / 32, kb = item / nblk, nb = item % nblk, k0 = 64 * kb, n0 = 32 * nb;
#pragma unroll 8
    for (int i = 0; i < 32; ++i) { const int kk = 2 * i + (lane >> 5); scr[kk * 33 + (lane & 31)] = W[(size_t)(k0 + kk) * N + n0 + (lane & 31)]; }
    asm volatile("s_waitcnt lgkmcnt(0)" ::: "memory");
    const int c = lane & 7; const int drow = dest_row<MODE>(n0);
#pragma unroll
    for (int j = 0; j < 4; ++j) { const int n = (lane >> 3) + 8 * j; const LAS float* s = scr + (8 * c) * 33 + n;
        u32x4 o; o.x = pk2(s[0 * 33], s[1 * 33]); o.y = pk2(s[2 * 33], s[3 * 33]); o.z = pk2(s[4 * 33], s[5 * 33]); o.w = pk2(s[6 * 33], s[7 * 33]);
        *(u32x4*)(WT + (size_t)(drow + n) * K + k0 + 8 * c) = o; }
    asm volatile("s_waitcnt lgkmcnt(0)" ::: "memory");
}

__device__ __forceinline__ void norm_row(const float* xrow, const float* g, bf16_t* orow, int lane) {
    const f32x4* xr = (const f32x4*)xrow + lane; const f32x4* gr = (const f32x4*)g + lane;
    f32x4 v[4]; float s = 0.f;
#pragma unroll
    for (int j = 0; j < 4; ++j) { v[j] = xr[64 * j]; s += (v[j].x * v[j].x + v[j].y * v[j].y) + (v[j].z * v[j].z + v[j].w * v[j].w); }
    const float inv = 1.0f / sqrtf(wave_sum(s) * (1.f / D) + EPS);
    u32x2* o8 = (u32x2*)orow + lane;
#pragma unroll
    for (int j = 0; j < 4; ++j) { const f32x4 gg = gr[64 * j]; u32x2 w; w.x = pk2(v[j].x * inv * gg.x, v[j].y * inv * gg.y); w.y = pk2(v[j].z * inv * gg.z, v[j].w * inv * gg.w); o8[64 * j] = w; }
}
template <int XIN> struct ResRaw { u32x2 m[2][4]; f32x4 xf[2][4]; u32x2 xb[2][4]; };
template <int XIN> __device__ __forceinline__ void res_load(ResRaw<XIN>& R, const Args& a, const bf16_t* MO, const bf16_t* XR, const float* part, int nsplit, int m0, int NGW, int lane) {
#pragma unroll
    for (int k = 0; k < 2; ++k) {
        const int m = (k == 0) ? m0 : ((m0 + NGW < M) ? m0 + NGW : m0);
        if (m >= MP) {
            const f32x4* pp = (const f32x4*)(part + (size_t)(m - MP) * D) + lane;
#pragma unroll
            for (int j = 0; j < 4; ++j) { f32x4 sacc = pp[64 * j];
                for (int ks = 1; ks < nsplit; ++ks) sacc = sacc + pp[(size_t)ks * 262144 + 64 * j];
                u32x2 w; w.x = pk2(sacc.x, sacc.y); w.y = pk2(sacc.z, sacc.w); R.m[k][j] = w; }
        } else {
            const u32x2* mr = (const u32x2*)(MO + (size_t)m * D) + lane;
#pragma unroll
            for (int j = 0; j < 4; ++j) R.m[k][j] = mr[64 * j];
        }
        if (XIN == 0) { const float* xr = m < MP ? a.x_prompt + (size_t)m * D : a.x_sample + (size_t)(m - MP) * D;
#pragma unroll
            for (int j = 0; j < 4; ++j) R.xf[k][j] = ((const f32x4*)xr + lane)[64 * j];
        } else { const u32x2* xr = (const u32x2*)(XR + (size_t)m * D) + lane;
#pragma unroll
            for (int j = 0; j < 4; ++j) R.xb[k][j] = xr[64 * j]; }
    }
}
template <int XIN, int XOUT> __device__ __forceinline__ void res_pass(const Args& a, const bf16_t* MO, bf16_t* XR, bf16_t* XN, float* Y, const float* gp, const float* gn, const float* part, int nsplit, int gw, int NGW, int lane) {
    const f32x4* gr = (const f32x4*)gp + lane;
    ResRaw<XIN> nx;
    if (gw < M) res_load<XIN>(nx, a, MO, XR, part, nsplit, gw, NGW, lane);
    for (int m0 = gw; m0 < M; m0 += 2 * NGW) {
        int mm[2]; mm[0] = m0; mm[1] = (m0 + NGW < M) ? m0 + NGW : m0;
        const ResRaw<XIN> cur = nx;
        if (m0 + 2 * NGW < M) res_load<XIN>(nx, a, MO, XR, part, nsplit, m0 + 2 * NGW, NGW, lane);
        f32x4 mv[2][4], xv[2][4]; float s[2] = {0.f, 0.f};
#pragma unroll
        for (int k = 0; k < 2; ++k)
#pragma unroll
            for (int j = 0; j < 4; ++j) { const u32x2 w = cur.m[k][j]; mv[k][j] = (f32x4){bflo(w.x), bfhi(w.x), bflo(w.y), bfhi(w.y)};
                if (XIN == 0) xv[k][j] = cur.xf[k][j]; else { const u32x2 x = cur.xb[k][j]; xv[k][j] = (f32x4){bflo(x.x), bfhi(x.x), bflo(x.y), bfhi(x.y)}; }
                s[k] += (mv[k][j].x * mv[k][j].x + mv[k][j].y * mv[k][j].y) + (mv[k][j].z * mv[k][j].z + mv[k][j].w * mv[k][j].w); }
        float inv[2], s2[2] = {0.f, 0.f};
#pragma unroll
        for (int k = 0; k < 2; ++k) inv[k] = 1.0f / sqrtf(wave_sum(s[k]) * (1.f / D) + EPS);
#pragma unroll
        for (int k = 0; k < 2; ++k)
#pragma unroll
            for (int j = 0; j < 4; ++j) { const f32x4 gg = gr[64 * j]; xv[k][j] = xv[k][j] + mv[k][j] * inv[k] * gg;
                s2[k] += (xv[k][j].x * xv[k][j].x + xv[k][j].y * xv[k][j].y) + (xv[k][j].z * xv[k][j].z + xv[k][j].w * xv[k][j].w); }
        if (XOUT == 1) {
#pragma unroll
            for (int k = 0; k < 2; ++k) { f32x4* xo = (f32x4*)(Y + (size_t)mm[k] * D) + lane;
#pragma unroll
                for (int j = 0; j < 4; ++j) xo[64 * j] = xv[k][j]; }
        } else {
            const f32x4* g2 = (const f32x4*)gn + lane;
#pragma unroll
            for (int k = 0; k < 2; ++k) {
                const float inv2 = 1.0f / sqrtf(wave_sum(s2[k]) * (1.f / D) + EPS);
                u32x2* xo = (u32x2*)(XR + (size_t)mm[k] * D) + lane; u32x2* o8 = (u32x2*)(XN + (size_t)mm[k] * D) + lane;
#pragma unroll
                for (int j = 0; j < 4; ++j) { const f32x4 gg = g2[64 * j]; const f32x4 x = xv[k][j];
                    u32x2 wx; wx.x = pk2(x.x, x.y); wx.y = pk2(x.z, x.w); xo[64 * j] = wx;
                    u32x2 w; w.x = pk2(x.x * inv2 * gg.x, x.y * inv2 * gg.y); w.y = pk2(x.z * inv2 * gg.z, x.w * inv2 * gg.w); o8[64 * j] = w; }
            }
        }
    }
}

namespace att {
__device__ __forceinline__ int crow(int i, int h) { return (i & 3) + 8 * (i >> 2) + 4 * h; }
typedef short v4i16_t __attribute__((ext_vector_type(4)));
__device__ __forceinline__ s16x4 vtr(const LAS unsigned char* p) { return __builtin_bit_cast(s16x4, __builtin_amdgcn_ds_read_tr16_b64_v4i16((LAS v4i16_t*)p)); }
struct Item { const bf16_t* q; const bf16_t* kc; const bf16_t* vc; const bf16_t* kn; const bf16_t* vn; bf16_t* o; float* kso; float* vso; const float* kcf; const float* vcf; int nc, kt0, kt1, qpos0, head; };

__device__ __forceinline__ void load_tile(const Item& it, int kt, int lane, bf16x8 (&kf)[4], u32x4 (&vr)[4]) {
    const int r = lane & 31, h = lane >> 5;
    if (it.kcf && kt < it.nc) {
        const float* kp = it.kcf + (size_t)kt * 32 * 1024 + (size_t)r * 1024 + 8 * h; const float* vp = it.vcf + (size_t)kt * 32 * 1024 + (size_t)(lane >> 3) * 1024 + (lane & 7) * 8;
#pragma unroll
        for (int s = 0; s < 4; ++s) { const f32x4 a = *(const f32x4*)(kp + 16 * s), b = *(const f32x4*)(kp + 16 * s + 4);
            u32x4 w; w.x = pk2(a.x, a.y); w.y = pk2(a.z, a.w); w.z = pk2(b.x, b.y); w.w = pk2(b.z, b.w); kf[s] = __builtin_bit_cast(bf16x8, w); }
#pragma unroll
        for (int i = 0; i < 4; ++i) { const f32x4 a = *(const f32x4*)(vp + (size_t)8 * i * 1024), b = *(const f32x4*)(vp + (size_t)8 * i * 1024 + 4);
            u32x4 w; w.x = pk2(a.x, a.y); w.y = pk2(a.z, a.w); w.z = pk2(b.x, b.y); w.w = pk2(b.z, b.w); vr[i] = w; }
        return;
    }
    const bf16_t* kp = kt < it.nc ? it.kc + (size_t)kt * 32 * 1024 : it.kn + (size_t)(kt - it.nc) * 32 * 1024;
    const bf16_t* vp = kt < it.nc ? it.vc + (size_t)kt * 32 * 1024 : it.vn + (size_t)(kt - it.nc) * 32 * 1024;
#pragma unroll
    for (int s = 0; s < 4; ++s) kf[s] = *(const bf16x8*)(kp + (size_t)r * 1024 + 16 * s + 8 * h);
#pragma unroll
    for (int i = 0; i < 4; ++i) vr[i] = *(const u32x4*)(vp + (size_t)((lane >> 3) + 8 * i) * 1024 + (lane & 7) * 8);
}

__device__ __forceinline__ void attn_item(const Item& it, LAS unsigned char* vlds, LAS float* tab, const float* table, int lane) {
    const int r = lane & 31, h = lane >> 5;
    asm volatile("s_waitcnt lgkmcnt(0)" ::: "memory");
    for (int i = lane; i < 257; i += 64) tab[i] = table[it.head * 257 + i] * LOG2E;
    bf16x8 qf[4];
#pragma unroll
    for (int s = 0; s < 4; ++s) qf[s] = *(const bf16x8*)(it.q + (size_t)r * 1024 + 16 * s + 8 * h);
    f32x16 o0, o1;
#pragma unroll
    for (int i = 0; i < 16; ++i) { o0[i] = 0.f; o1[i] = 0.f; }
    float mrun = -1e30f, lrun = 0.f;
    asm volatile("s_waitcnt lgkmcnt(0)" ::: "memory");
    const float cfar = tab[256];
    const int qpos = it.qpos0 + r;
    const int i16 = lane & 15, q4 = i16 >> 2, p4 = i16 & 3, g = (lane >> 4) & 1;
    const LAS unsigned char* trbase = vlds + (4 * h + q4) * 128 + (16 * g + 4 * p4) * 2;
    bf16x8 kf[4]; u32x4 vr[4];
    load_tile(it, it.kt0, lane, kf, vr);
    for (int kt = it.kt0; kt < it.kt1; ++kt) {
        bf16x8 kn_[4]; u32x4 vn_[4];
        if (kt + 1 < it.kt1) load_tile(it, kt + 1, lane, kn_, vn_);
        else {
#pragma unroll
            for (int s = 0; s < 4; ++s) { kn_[s] = kf[s]; vn_[s] = vr[s]; }
        }
        asm volatile("s_waitcnt lgkmcnt(0)" ::: "memory");
#pragma unroll
        for (int i = 0; i < 4; ++i) *(LAS u32x4*)(vlds + ((lane >> 3) + 8 * i) * 128 + (lane & 7) * 16) = vr[i];
        f32x16 p;
#pragma unroll
        for (int i = 0; i < 16; ++i) p[i] = 0.f;
#pragma unroll
        for (int s = 0; s < 4; ++s) p = __builtin_amdgcn_mfma_f32_32x32x16_bf16(kf[s], qf[s], p, 0, 0, 0);
        const int kb = 32 * kt;
        if (it.qpos0 - (kb + 31) >= 128) {
#pragma unroll
            for (int i = 0; i < 16; ++i) p[i] += cfar;
        } else {
#pragma unroll
            for (int i = 0; i < 16; ++i) { int dd = qpos - (kb + crow(i, h)); dd = dd < -128 ? -128 : (dd > 128 ? 128 : dd); p[i] += tab[dd + 128]; }
        }
        float tm = p[0];
#pragma unroll
        for (int i = 1; i < 16; ++i) tm = fmaxf(tm, p[i]);
        tm = fmaxf(tm, __shfl_xor(tm, 32));
        const float mnew = fmaxf(mrun, tm);
        const float sc = __builtin_amdgcn_exp2f(mrun - mnew);
        mrun = mnew;
        float ps = 0.f;
#pragma unroll
        for (int i = 0; i < 16; ++i) { p[i] = __builtin_amdgcn_exp2f(p[i] - mnew); ps += p[i]; }
        lrun = lrun * sc + ps;
#pragma unroll
        for (int i = 0; i < 16; ++i) { o0[i] *= sc; o1[i] *= sc; }
        u32x4 w0, w1;
        w0.x = pk2(p[0], p[1]); w0.y = pk2(p[2], p[3]); w0.z = pk2(p[4], p[5]); w0.w = pk2(p[6], p[7]);
        w1.x = pk2(p[8], p[9]); w1.y = pk2(p[10], p[11]); w1.z = pk2(p[12], p[13]); w1.w = pk2(p[14], p[15]);
        const bf16x8 pf0 = __builtin_bit_cast(bf16x8, w0), pf1 = __builtin_bit_cast(bf16x8, w1);
        asm volatile("s_waitcnt lgkmcnt(0)" ::: "memory");
#pragma unroll
        for (int s = 0; s < 2; ++s) {
            const s16x4 a_lo = vtr(trbase + (16 * s) * 128), a_hi = vtr(trbase + (16 * s + 8) * 128);
            const s16x4 b_lo = vtr(trbase + (16 * s) * 128 + 64), b_hi = vtr(trbase + (16 * s + 8) * 128 + 64);
            const bf16x8 va = __builtin_shufflevector(a_lo, a_hi, 0, 1, 2, 3, 4, 5, 6, 7), vb = __builtin_shufflevector(b_lo, b_hi, 0, 1, 2, 3, 4, 5, 6, 7);
            o0 = __builtin_amdgcn_mfma_f32_32x32x16_bf16(va, s == 0 ? pf0 : pf1, o0, 0, 0, 0);
            o1 = __builtin_amdgcn_mfma_f32_32x32x16_bf16(vb, s == 0 ? pf0 : pf1, o1, 0, 0, 0);
        }
#pragma unroll
        for (int s = 0; s < 4; ++s) { kf[s] = kn_[s]; vr[s] = vn_[s]; }
    }
    if (it.kso) {
        load_tile(it, it.nc, lane, kf, vr);
#pragma unroll
        for (int s = 0; s < 4; ++s) { const u32x4 w = __builtin_bit_cast(u32x4, kf[s]); float* d = it.kso + (size_t)r * 1024 + 16 * s + 8 * h;
            *(f32x4*)d = (f32x4){bflo(w.x), bfhi(w.x), bflo(w.y), bfhi(w.y)}; *(f32x4*)(d + 4) = (f32x4){bflo(w.z), bfhi(w.z), bflo(w.w), bfhi(w.w)}; }
#pragma unroll
        for (int i = 0; i < 4; ++i) { const u32x4 w = vr[i]; float* d = it.vso + (size_t)((lane >> 3) + 8 * i) * 1024 + (lane & 7) * 8;
            *(f32x4*)d = (f32x4){bflo(w.x), bfhi(w.x), bflo(w.y), bfhi(w.y)}; *(f32x4*)(d + 4) = (f32x4){bflo(w.z), bfhi(w.z), bflo(w.w), bfhi(w.w)}; }
    }
    lrun += __shfl_xor(lrun, 32);
    const float inv = 1.0f / lrun;
    bf16_t* orow = it.o + (size_t)r * 1024 + 4 * h;
#pragma unroll
    for (int g4 = 0; g4 < 4; ++g4) {
        u32x2 a, b;
        a.x = pk2(o0[4 * g4] * inv, o0[4 * g4 + 1] * inv); a.y = pk2(o0[4 * g4 + 2] * inv, o0[4 * g4 + 3] * inv);
        b.x = pk2(o1[4 * g4] * inv, o1[4 * g4 + 1] * inv); b.y = pk2(o1[4 * g4 + 2] * inv, o1[4 * g4 + 3] * inv);
        *(u32x2*)(orow + 8 * g4) = a; *(u32x2*)(orow + 32 + 8 * g4) = b;
    }
}

constexpr int KROW = 144, KTILE = 64 * KROW, VTILE = 64 * 128, A_K = 0, A_V = 2 * KTILE, A_TAB = A_V + 2 * VTILE, A_SLOT = A_TAB + 1296;
__device__ __forceinline__ float max3f(float a, float b, float c) { float r; asm("v_max3_f32 %0, %1, %2, %3" : "=v"(r) : "v"(a), "v"(b), "v"(c)); return r; }
__device__ __forceinline__ void attn_unit(int b, int hh, int cq, const bf16_t* Qg, const bf16_t* Kg, const bf16_t* Vg, bf16_t* Og, float* kout, float* vout, const float* table, LAS unsigned char* lds, int tid, int lane, int wave) {
    constexpr float THR = 8.0f;
    const int r = lane & 31, h = lane >> 5;
    const int c = 4 * cq + (wave >> 1), half = wave & 1;
    const int j0 = (4 * cq - 8) > 0 ? (4 * cq - 8) : 0, j1 = 4 * cq + 3;
    const size_t rb = (size_t)b * SEQ;
    LAS float* tab = (LAS float*)(lds + A_TAB);
    if (tid < 324) tab[tid] = table[hh * 257 + (tid < 256 ? tid : 256)] * LOG2E;
    const int lrow = tid >> 3, lch = tid & 7;
    const bf16_t* kgp = Kg + (rb + lrow) * D + hh * HD + lch * 8; const bf16_t* vgp = Vg + (rb + lrow) * D + hh * HD + lch * 8;
    const int kwoff = A_K + lrow * KROW + lch * 16, vwoff = A_V + lrow * 128 + ((lch ^ (((lrow >> 1) & 1) << 2)) << 4);
    const long korow = (long)b * CROWS - (SEQ - CROWS) + lrow; float* kop = kout + korow * D + hh * HD + lch * 8; float* vop = vout + korow * D + hh * HD + lch * 8;
#define ATT_KVOUT(tile) do { if (cq >= 6 && (tile) >= 4 * cq) { float* kd = kop + (long)(tile) * 64 * D; float* vd = vop + (long)(tile) * 64 * D; \
        *(f32x4*)kd = (f32x4){bflo(kreg.x), bfhi(kreg.x), bflo(kreg.y), bfhi(kreg.y)}; *(f32x4*)(kd + 4) = (f32x4){bflo(kreg.z), bfhi(kreg.z), bflo(kreg.w), bfhi(kreg.w)}; \
        *(f32x4*)vd = (f32x4){bflo(vreg.x), bfhi(vreg.x), bflo(vreg.y), bfhi(vreg.y)}; *(f32x4*)(vd + 4) = (f32x4){bflo(vreg.z), bfhi(vreg.z), bflo(vreg.w), bfhi(vreg.w)}; } } while (0)
    u32x4 kreg = *(const u32x4*)(kgp + (size_t)j0 * 64 * D), vreg = *(const u32x4*)(vgp + (size_t)j0 * 64 * D);
    bf16x8 qf[4];
    const bf16_t* qp = Qg + (rb + 64 * c + 32 * half + r) * D + hh * HD + 8 * h;
#pragma unroll
    for (int s = 0; s < 4; ++s) qf[s] = *(const bf16x8*)(qp + 16 * s);
    *(LAS u32x4*)(lds + kwoff) = kreg; *(LAS u32x4*)(lds + vwoff) = vreg;
    ATT_KVOUT(j0);
    kreg = *(const u32x4*)(kgp + (size_t)(j0 + 1) * 64 * D); vreg = *(const u32x4*)(vgp + (size_t)(j0 + 1) * 64 * D);
    f32x16 o0, o1;
#pragma unroll
    for (int i = 0; i < 16; ++i) { o0[i] = 0.f; o1[i] = 0.f; }
    float mrun = 0.f, lrun = 0.f;
    const int i16 = lane & 15, q4 = i16 >> 2, p4 = i16 & 3, g = (lane >> 4) & 1;
    const int troff = A_V + (4 * h + q4) * 128 + ((32 * g) ^ (((q4 >> 1) & 1) << 6)) + 8 * p4;
    const int kroff = A_K + r * KROW + 16 * h;
    __syncthreads();
    const float cfar = tab[256];
    f32x16 negf;
#pragma unroll
    for (int i = 0; i < 16; ++i) negf[i] = cfar;
    asm volatile("" : "+v"(negf));
    const int qpos = 64 * c + 32 * half + r;
    bool first = true;
    for (int j = j0; j <= j1; ++j) {
        const int bufk = ((j - j0) & 1) * KTILE, bufv = ((j - j0) & 1) * VTILE;
        if (j < j1) { const int nbk = ((j + 1 - j0) & 1) * KTILE, nbv = ((j + 1 - j0) & 1) * VTILE; *(LAS u32x4*)(lds + nbk + kwoff) = kreg; *(LAS u32x4*)(lds + nbv + vwoff) = vreg; ATT_KVOUT(j + 1); }
        if (j + 2 <= j1) { kreg = *(const u32x4*)(kgp + (size_t)(j + 2) * 64 * D); vreg = *(const u32x4*)(vgp + (size_t)(j + 2) * 64 * D); }
        if (j >= c - 8 && j <= c) {
            f32x16 p0, p1;
            bf16x8 ka[4], kb[4];
#pragma unroll
            for (int s = 0; s < 4; ++s) { ka[s] = *(const LAS bf16x8*)(lds + bufk + kroff + 32 * s); kb[s] = *(const LAS bf16x8*)(lds + bufk + kroff + 32 * KROW + 32 * s); }
            if (j <= c - 3) {
                p0 = __builtin_amdgcn_mfma_f32_32x32x16_bf16(ka[0], qf[0], negf, 0, 0, 0);
                p1 = __builtin_amdgcn_mfma_f32_32x32x16_bf16(kb[0], qf[0], negf, 0, 0, 0);
            } else {
                const LAS float* tb = tab + (qpos - 64 * j - 4 * h + 128 - 59);
#pragma unroll
                for (int i = 0; i < 16; ++i) { p0[i] = tb[59 - ((i & 3) + 8 * (i >> 2))] - mrun; p1[i] = tb[59 - 32 - ((i & 3) + 8 * (i >> 2))] - mrun; }
                p0 = __builtin_amdgcn_mfma_f32_32x32x16_bf16(ka[0], qf[0], p0, 0, 0, 0);
                p1 = __builtin_amdgcn_mfma_f32_32x32x16_bf16(kb[0], qf[0], p1, 0, 0, 0);
            }
#pragma unroll
            for (int s = 1; s < 4; ++s) {
                p0 = __builtin_amdgcn_mfma_f32_32x32x16_bf16(ka[s], qf[s], p0, 0, 0, 0);
                p1 = __builtin_amdgcn_mfma_f32_32x32x16_bf16(kb[s], qf[s], p1, 0, 0, 0);
            }
            float ta = max3f(p0[0], p0[1], p1[0]), tb2 = max3f(p0[2], p0[3], p1[1]);
            ta = max3f(ta, p1[2], p1[3]);
#pragma unroll
            for (int i = 4; i < 16; i += 4) { ta = max3f(ta, p0[i], p0[i + 1]); tb2 = max3f(tb2, p0[i + 2], p0[i + 3]); ta = max3f(ta, p1[i], p1[i + 1]); tb2 = max3f(tb2, p1[i + 2], p1[i + 3]); }
            float tm = fmaxf(ta, tb2);
            { auto rr = __builtin_amdgcn_permlane32_swap(__float_as_uint(tm), __float_as_uint(tm), false, false); tm = fmaxf(__uint_as_float(rr[0]), __uint_as_float(rr[1])); }
            if (first || __any(tm > THR)) {
                const float dl = first ? tm : fmaxf(tm, 0.f); mrun += dl;
                const float sc = __builtin_amdgcn_exp2f(-dl); lrun *= sc;
#pragma unroll
                for (int i = 0; i < 16; ++i) { p0[i] -= dl; p1[i] -= dl; o0[i] *= sc; o1[i] *= sc; negf[i] = cfar - mrun; }
                asm volatile("" : "+v"(negf));
                first = false;
            }
            float ps0 = 0.f, ps1 = 0.f;
#pragma unroll
            for (int i = 0; i < 16; ++i) { p0[i] = __builtin_amdgcn_exp2f(p0[i]); p1[i] = __builtin_amdgcn_exp2f(p1[i]); ps0 += p0[i]; ps1 += p1[i]; }
            lrun += ps0 + ps1;
            u32x4 w0, w1, w2, w3;
            w0.x = pk2(p0[0], p0[1]); w0.y = pk2(p0[2], p0[3]); w0.z = pk2(p0[4], p0[5]); w0.w = pk2(p0[6], p0[7]);
            w1.x = pk2(p0[8], p0[9]); w1.y = pk2(p0[10], p0[11]); w1.z = pk2(p0[12], p0[13]); w1.w = pk2(p0[14], p0[15]);
            w2.x = pk2(p1[0], p1[1]); w2.y = pk2(p1[2], p1[3]); w2.z = pk2(p1[4], p1[5]); w2.w = pk2(p1[6], p1[7]);
            w3.x = pk2(p1[8], p1[9]); w3.y = pk2(p1[10], p1[11]); w3.z = pk2(p1[12], p1[13]); w3.w = pk2(p1[14], p1[15]);
            const bf16x8 pf[4] = {__builtin_bit_cast(bf16x8, w0), __builtin_bit_cast(bf16x8, w1), __builtin_bit_cast(bf16x8, w2), __builtin_bit_cast(bf16x8, w3)};
#pragma unroll
            for (int ks = 0; ks < 4; ++ks) {
                const LAS unsigned char* tb = lds + bufv + troff + ks * 16 * 128;
                const s16x4 a_lo = vtr(tb), a_hi = vtr(tb + 8 * 128);
                const LAS unsigned char* tb1 = lds + bufv + (troff ^ 64) + ks * 16 * 128;
                const s16x4 b_lo = vtr(tb1), b_hi = vtr(tb1 + 8 * 128);
                const bf16x8 va = __builtin_shufflevector(a_lo, a_hi, 0, 1, 2, 3, 4, 5, 6, 7), vb = __builtin_shufflevector(b_lo, b_hi, 0, 1, 2, 3, 4, 5, 6, 7);
                o0 = __builtin_amdgcn_mfma_f32_32x32x16_bf16(va, pf[ks], o0, 0, 0, 0);
                o1 = __builtin_amdgcn_mfma_f32_32x32x16_bf16(vb, pf[ks], o1, 0, 0, 0);
            }
        }
        asm volatile("s_waitcnt lgkmcnt(0)\n\ts_barrier" ::: "memory");
    }
    lrun += __shfl_xor(lrun, 32);
    const float inv = 1.0f / lrun;
    bf16_t* orow = Og + (rb + 64 * c + 32 * half + r) * D + hh * HD + 4 * h;
#pragma unroll
    for (int g4 = 0; g4 < 4; ++g4) {
        u32x2 x, y;
        x.x = pk2(o0[4 * g4] * inv, o0[4 * g4 + 1] * inv); x.y = pk2(o0[4 * g4 + 2] * inv, o0[4 * g4 + 3] * inv);
        y.x = pk2(o1[4 * g4] * inv, o1[4 * g4 + 1] * inv); y.y = pk2(o1[4 * g4 + 2] * inv, o1[4 * g4 + 3] * inv);
        *(u32x2*)(orow + 8 * g4) = x; *(u32x2*)(orow + 32 + 8 * g4) = y;
    }
#undef ATT_KVOUT
}
}

#define XB_TMO      128
#define XB_XCNT(j)  (256  + 64 * (j))
#define XB_XSUB(j)  (1280 + 64 * (j))
#define XB_XGEN(j)  (2304 + 64 * (j))
#define XB_TOP      3328
#define XB_TOPGEN   3392
#define XCD_BAR_WORDS 3456
#define XB_SPIN_CAP (1u << 18)

__device__ __forceinline__ unsigned xb_ld(unsigned* p)              { return __hip_atomic_load(p, __ATOMIC_RELAXED, __HIP_MEMORY_SCOPE_AGENT); }
__device__ __forceinline__ unsigned xb_add(unsigned* p, unsigned v) { return __hip_atomic_fetch_add(p, v, __ATOMIC_RELAXED, __HIP_MEMORY_SCOPE_AGENT); }
__device__ __forceinline__ unsigned xb_xcc_id() { return (unsigned)__builtin_amdgcn_s_getreg((3 << 11) | 20) & 0xFu; }
#define XB_SPIN(cond, bar) do { unsigned _sp = 0; while (cond) { __builtin_amdgcn_s_sleep(1); \
    if ((++_sp & 255u) == 0u) { if (xb_ld(&(bar)[XB_TMO])) break; if (_sp > XB_SPIN_CAP) { atomicAdd(&(bar)[XB_TMO], 1u); break; } } } } while (0)

struct XcdBarrier {
    unsigned* bar; unsigned x;
    volatile LAS unsigned* st;
};

__device__ __forceinline__ XcdBarrier xcd_barrier_post(unsigned* bar, volatile LAS unsigned* st) {
    XcdBarrier b; b.bar = bar; b.x = xb_xcc_id(); b.st = st;
    if (threadIdx.x == 0) (void)xb_add(&bar[XB_XCNT(b.x)], 1u);
    return b;
}
__device__ __forceinline__ void xcd_barrier_complete(unsigned* bar, unsigned x, unsigned& nloc, unsigned& nx) {
    const unsigned G = gridDim.x * gridDim.y * gridDim.z;
    unsigned sum, cnt, mine, sp = 0u;
    for (;;) {
        sum = 0u; cnt = 0u; mine = 0u;
#pragma unroll
        for (unsigned j = 0; j < 16; ++j) { const unsigned c = xb_ld(&bar[XB_XCNT(j)]); sum += c; cnt += (c > 0u) ? 1u : 0u; mine = (j == x) ? c : mine; }
        if (sum == G) break;
        __builtin_amdgcn_s_sleep(1);
        if ((++sp & 255u) == 0u) { if (xb_ld(&bar[XB_TMO])) break; if (sp > XB_SPIN_CAP) { atomicAdd(&bar[XB_TMO], 1u); break; } }
    }
    nloc = mine > 0u ? mine : 1u; nx = cnt > 0u ? cnt : 1u;
}

__device__ __forceinline__ void xcd_barrier(const XcdBarrier& b) {
    asm volatile("s_waitcnt vmcnt(0)" ::: "memory");
    __syncthreads();
    if (threadIdx.x == 0) {
        unsigned* bar = b.bar;
        __builtin_amdgcn_s_waitcnt(0);
        unsigned nloc = b.st[0], nx = b.st[1];
        if (nloc == 0u) { xcd_barrier_complete(bar, b.x, nloc, nx); b.st[0] = nloc; b.st[1] = nx; }
        const unsigned old = xb_add(&bar[XB_XSUB(b.x)], 1u);
        const unsigned gen = old / nloc;
        if (old + 1u == (gen + 1u) * nloc) {
            __builtin_amdgcn_fence(__ATOMIC_RELEASE, "agent");
            asm volatile("s_waitcnt vmcnt(0)" ::: "memory");
            const unsigned og = xb_add(&bar[XB_TOP], 1u);
            const unsigned tg = og / nx;
            if (og + 1u == (tg + 1u) * nx) xb_add(&bar[XB_TOPGEN], 1u);
            else XB_SPIN(xb_ld(&bar[XB_TOPGEN]) == tg, bar);
            __builtin_amdgcn_fence(__ATOMIC_ACQUIRE, "agent");
            xb_add(&bar[XB_XGEN(b.x)], 1u);
            asm volatile("s_waitcnt vmcnt(0)" ::: "memory");
        } else {
            XB_SPIN(xb_ld(&bar[XB_XGEN(b.x)]) == gen, bar);
            __builtin_amdgcn_fence(__ATOMIC_ACQUIRE, "agent");
            asm volatile("s_waitcnt vmcnt(0)" ::: "memory");
        }
    }
    __syncthreads();
}


__global__ void __launch_bounds__(NWAVES * 64, 2) fwd_kernel(Args a) {
    extern __shared__ __attribute__((aligned(16))) unsigned char lds_raw[];
    cg::grid_group grid = cg::this_grid();
    LAS unsigned char* lds = (LAS unsigned char*)lds_raw;
    int tid = threadIdx.x, lane = tid & 63; const int wave = __builtin_amdgcn_readfirstlane(tid >> 6);
    const int G = gridDim.x, gw = blockIdx.x * NWAVES + wave, NGW = G * NWAVES;
    unsigned char* ws = a.ws;
    bf16_t *Win_t, *Wout_t, *Wgu_t0, *Wgu_t1, *Wd_t0, *Wd_t1, *Wqkv_t, *Wo_t, *XN, *BA, *BB, *BC, *MO, *OB, *HB, *XR; float *Y, *PART; unsigned* qctr;
#define DERIVE() do { unsigned char* w_ = a.ws; asm volatile("" : "+s"(w_)); \
        Win_t = (bf16_t*)(w_ + WS_WIN); Wout_t = (bf16_t*)(w_ + WS_WOUT); Wgu_t0 = (bf16_t*)(w_ + WS_WGU0); Wgu_t1 = (bf16_t*)(w_ + WS_WGU1); \
        Wd_t0 = (bf16_t*)(w_ + WS_WD0); Wd_t1 = (bf16_t*)(w_ + WS_WD1); Wqkv_t = (bf16_t*)(w_ + WS_WQKV); Wo_t = (bf16_t*)(w_ + WS_WO); \
        XN = (bf16_t*)(w_ + WS_XN); BA = (bf16_t*)(w_ + WS_A); BB = (bf16_t*)(w_ + WS_B); BC = (bf16_t*)(w_ + WS_C); MO = (bf16_t*)(w_ + WS_MO); OB = (bf16_t*)(w_ + WS_O); HB = BA; \
        XR = (bf16_t*)(w_ + WS_XR); Y = a.out + O_Y; PART = (float*)(w_ + WS_PART); qctr = (unsigned*)(w_ + WS_CTL); } while (0)
    DERIVE(); tid = threadIdx.x; asm volatile("" : "+v"(tid)); lane = tid & 63;
    { volatile LAS unsigned* st0 = (volatile LAS unsigned*)(lds + MISC_OFF); if (tid < 16) st0[tid] = 0u; }
    __syncthreads();
    XcdBarrier bar = xcd_barrier_post((unsigned*)(ws + WS_CTL) + CW_BAR, (volatile LAS unsigned*)(lds + MISC_OFF) + 8);

    DERIVE(); tid = threadIdx.x; asm volatile("" : "+v"(tid)); lane = tid & 63;
    {
        LAS float* scr = (LAS float*)(lds + wave * 16384);
        constexpr int I_IN = 16 * 96, I_OUT = 16 * 32, I_GU = 16 * 176, I_D = 44 * 32;
        constexpr int NITEMS = 2 * I_IN + 2 * I_OUT + 2 * I_GU + 2 * I_D;
        for (int it = gw; it < NITEMS; it += NGW) {
            int r = it;
            if (r < I_IN) { transpose_item<2>(a.conv_w_in, D, 3 * D, Win_t, scr, r, lane); continue; } r -= I_IN;
            if (r < I_OUT) { transpose_item<0>(a.conv_w_out, D, D, Wout_t, scr, r, lane); continue; } r -= I_OUT;
            if (r < I_GU) { transpose_item<1>(a.ffn_w_gate_up, D, 2 * DFF, Wgu_t0, scr, r, lane); continue; } r -= I_GU;
            if (r < I_GU) { transpose_item<1>(a.ffn_w_gate_up + (size_t)D * 2 * DFF, D, 2 * DFF, Wgu_t1, scr, r, lane); continue; } r -= I_GU;
            if (r < I_D) { transpose_item<0>(a.ffn_w_down, DFF, D, Wd_t0, scr, r, lane); continue; } r -= I_D;
            if (r < I_D) { transpose_item<0>(a.ffn_w_down + (size_t)DFF * D, DFF, D, Wd_t1, scr, r, lane); continue; } r -= I_D;
            if (r < I_IN) { transpose_item<0>(a.attn_w_qkv, D, 3 * D, Wqkv_t, scr, r, lane); continue; } r -= I_IN;
            transpose_item<0>(a.attn_w_o, D, D, Wo_t, scr, r, lane);
        }
        for (int m = gw; m < M; m += NGW) { const float* xr = m < MP ? a.x_prompt + (size_t)m * D : a.x_sample + (size_t)(m - MP) * D; norm_row(xr, a.norm_mix_pre, XN + (size_t)m * D, lane); }
    }
    grid.sync();
    DERIVE(); tid = threadIdx.x; asm volatile("" : "+v"(tid)); lane = tid & 63;
    { pg8::Gemm g{XN, Win_t, M, 3 * D, D, D}; pg8::StaticOrder S; S.init(M, 3 * D, G, (int)blockIdx.x); pg8::EpiConvIn E{BA, BB};
      pg8::gemm_phase<pg8::EpiConvIn, pg8::StaticOrder, true, true>(lds, g, S, E); }
    xcd_barrier(bar);
    DERIVE(); tid = threadIdx.x; asm volatile("" : "+v"(tid)); lane = tid & 63;
    {
        const f32x4* wp = (const f32x4*)a.conv_kernel + lane;
        f32x4 w0[4], w1[4], w2[4];
#pragma unroll
        for (int j = 0; j < 4; ++j) { w0[j] = wp[64 * j]; w1[j] = wp[256 + 64 * j]; w2[j] = wp[512 + 64 * j]; }
        for (int blk = gw; blk < M / 4; blk += NGW) {
            const int m0 = blk * 4; const bool samp = m0 >= MP; const int t0 = samp ? ((m0 - MP) & 31) : (m0 & 2047); const int b = samp ? ((m0 - MP) >> 5) : (m0 >> 11); const int T = samp ? DS : SEQ;
            const u32x2* up = (const u32x2*)(BB + (size_t)m0 * D) + lane; const u32x2* bp = (const u32x2*)(BA + (size_t)m0 * D) + lane;
            u32x2 ur[6][4], br[4][4];
#pragma unroll
            for (int k = 2; k < 6; ++k)
#pragma unroll
                for (int j = 0; j < 4; ++j) { ur[k][j] = up[(k - 2) * 256 + 64 * j]; br[k - 2][j] = bp[(k - 2) * 256 + 64 * j]; }
            f32x4 h0[4], h1[4];
            if (t0 > 0) {
#pragma unroll
                for (int j = 0; j < 4; ++j) { const u32x2 a0 = up[64 * j - 512], a1 = up[64 * j - 256];
                    h0[j] = (f32x4){bflo(a0.x), bfhi(a0.x), bflo(a0.y), bfhi(a0.y)}; h1[j] = (f32x4){bflo(a1.x), bfhi(a1.x), bflo(a1.y), bfhi(a1.y)}; }
            } else if (samp) {
                const f32x4* st = (const f32x4*)(a.state_conv + (size_t)b * 2 * D) + lane;
#pragma unroll
                for (int j = 0; j < 4; ++j) { h0[j] = st[64 * j]; h1[j] = st[256 + 64 * j]; }
            } else {
#pragma unroll
                for (int j = 0; j < 4; ++j) { h0[j] = (f32x4){0.f, 0.f, 0.f, 0.f}; h1[j] = h0[j]; }
            }
            u32x2* yo = (u32x2*)(BC + (size_t)m0 * D) + lane;
            float* so = (t0 == T - 4) ? a.out + (samp ? O_CONVS : O_CONVP) + (size_t)b * 2 * D : nullptr;
#pragma unroll
            for (int j = 0; j < 4; ++j) {
                f32x4 u2 = h0[j], u1 = h1[j];
#pragma unroll
                for (int k = 0; k < 4; ++k) {
                    const u32x2 uw = ur[k + 2][j]; const f32x4 u0 = (f32x4){bflo(uw.x), bfhi(uw.x), bflo(uw.y), bfhi(uw.y)};
                    const u32x2 bw = br[k][j]; const f32x4 bg = (f32x4){bflo(bw.x), bfhi(bw.x), bflo(bw.y), bfhi(bw.y)};
                    const f32x4 y = bg * (w0[j] * u2 + w1[j] * u1 + w2[j] * u0);
                    u32x2 o; o.x = pk2(y.x, y.y); o.y = pk2(y.z, y.w); yo[k * 256 + 64 * j] = o;
                    if (so && k >= 2) *((f32x4*)(so + (size_t)(k - 2) * D) + lane + 64 * j) = u0;
                    u2 = u1; u1 = u0;
                }
            }
        }
    }
    xcd_barrier(bar);
    DERIVE(); tid = threadIdx.x; asm volatile("" : "+v"(tid)); lane = tid & 63;
    { pg8::Gemm g{BC, Wout_t, MP, D, D, D}; pg8::StaticOrder S; S.init(MP, D, G, (int)blockIdx.x); pg8::EpiBf16<0> E{MO, D, nullptr, 0, 0, 1.f};
      pg8::gemm_phase<pg8::EpiBf16<0>, pg8::StaticOrder, true, true>(lds, g, S, E); }
    { constexpr int KS = D / 4; pg8::Gemm g{BC, Wout_t, M, D, KS, D}; pg8::TailOrder S{4, KS * 2, G, (int)blockIdx.x}; pg8::EpiPartF32 E{PART, KS * 2};
      pg8::gemm_phase<pg8::EpiPartF32, pg8::TailOrder, true, true>(lds, g, S, E); }
    xcd_barrier(bar);
    DERIVE(); tid = threadIdx.x; asm volatile("" : "+v"(tid)); lane = tid & 63;
    res_pass<0, 0>(a, MO, XR, XN, Y, a.norm_mix_post, a.norm_ffn_pre, PART, 4, gw, NGW, lane);
    xcd_barrier(bar);
    DERIVE(); tid = threadIdx.x; asm volatile("" : "+v"(tid)); lane = tid & 63;
    { pg8::Gemm g{XN, Wgu_t0, M, 2 * DFF, D, D}; pg8::StaticOrder S; S.init(M, 2 * DFF, G, (int)blockIdx.x); pg8::EpiSwiGLU E{HB};
      pg8::gemm_phase<pg8::EpiSwiGLU, pg8::StaticOrder, true, true>(lds, g, S, E); }
    xcd_barrier(bar);
    DERIVE(); tid = threadIdx.x; asm volatile("" : "+v"(tid)); lane = tid & 63;
    { pg8::Gemm g{HB, Wd_t0, MP, D, DFF, DFF}; pg8::StaticOrder S; S.init(MP, D, G, (int)blockIdx.x); pg8::EpiBf16<0> E{MO, D, nullptr, 0, 0, 1.f};
      pg8::gemm_phase<pg8::EpiBf16<0>, pg8::StaticOrder, true, true>(lds, g, S, E); }
    { constexpr int KS = DFF / 11; pg8::Gemm g{HB, Wd_t0, M, D, KS, DFF}; pg8::TailOrder S{11, KS * 2, G, (int)blockIdx.x}; pg8::EpiPartF32 E{PART, KS * 2};
      pg8::gemm_phase<pg8::EpiPartF32, pg8::TailOrder, true, true>(lds, g, S, E); }
    xcd_barrier(bar);
    DERIVE(); tid = threadIdx.x; asm volatile("" : "+v"(tid)); lane = tid & 63;
    res_pass<1, 0>(a, MO, XR, XN, Y, a.norm_ffn_post, a.norm_mix_pre + D, PART, 11, gw, NGW, lane);
    xcd_barrier(bar);
    DERIVE(); tid = threadIdx.x; asm volatile("" : "+v"(tid)); lane = tid & 63;
    { pg8::Gemm g{XN, Wqkv_t, M, 3 * D, D, D}; pg8::StaticOrder S; S.init(M, 3 * D, G, (int)blockIdx.x);
      pg8::EpiBf16<0> E{BA, D, nullptr, D, (size_t)(WS_B - WS_A) / 2, QSCALE};
      pg8::gemm_phase<pg8::EpiBf16<0>, pg8::StaticOrder, true, true>(lds, g, S, E); }
    xcd_barrier(bar);
    DERIVE(); tid = threadIdx.x; asm volatile("" : "+v"(tid)); lane = tid & 63;
    {
        constexpr int NGS1 = (DB * NH) / 8, NPU1 = NB * NH * 8, NGS = NGS1 * REP_SAMPLE, NPU = NPU1 * REP_PROMPT;
        LAS unsigned char* vlds = lds + wave * 4096; LAS float* tabw = (LAS float*)(lds + 32768 + wave * 1088);
        volatile LAS int* slot = (volatile LAS int*)(lds + 65536);
        if (tid == 0) *slot = (int)atomicAdd(qctr, 1u);
        __syncthreads();
        int wi = *slot;
        __syncthreads();
        while (wi < NGS + NPU) {
            int nxt = 0;
            if (tid == 0) nxt = (int)atomicAdd(qctr, 1u);
            if (wi < NGS) {
                att::Item it;
                const int si = (wi % NGS1) * 8 + wave, b = si >> 4, hh = si & 15;
                const size_t rb = (size_t)MP + (size_t)b * DS;
                it.q = BA + rb * D + hh * HD; it.o = OB + rb * D + hh * HD;
                it.kc = nullptr; it.vc = nullptr; it.kcf = a.cache_k + (size_t)b * CROWS * D + hh * HD; it.vcf = a.cache_v + (size_t)b * CROWS * D + hh * HD; it.kn = BB + rb * D + hh * HD; it.vn = BC + rb * D + hh * HD; it.nc = CROWS / 32;
                it.kt0 = 0; it.kt1 = CROWS / 32 + 1; it.qpos0 = CROWS; it.head = hh;
                it.kso = (wi < NGS1) ? a.out + O_KS + (size_t)b * DS * D + hh * HD : nullptr; it.vso = a.out + O_VS + (size_t)b * DS * D + hh * HD;
                att::attn_item(it, vlds, tabw, a.attn_rel_bias, lane);
            } else {
                const int u = (wi - NGS) % NPU1, bh = u >> 3, cq = 7 - (u & 7);
                att::attn_unit(bh >> 4, bh & 15, cq, BA, BB, BC, OB, a.out + O_KP, a.out + O_VP, a.attn_rel_bias, lds, tid, lane, wave);
            }
            __syncthreads();
            if (tid == 0) *slot = nxt;
            __syncthreads();
            wi = *slot;
        }
    }
    xcd_barrier(bar);
    DERIVE(); tid = threadIdx.x; asm volatile("" : "+v"(tid)); lane = tid & 63;
    { pg8::Gemm g{OB, Wo_t, MP, D, D, D}; pg8::StaticOrder S; S.init(MP, D, G, (int)blockIdx.x); pg8::EpiBf16<0> E{MO, D, nullptr, 0, 0, 1.f};
      pg8::gemm_phase<pg8::EpiBf16<0>, pg8::StaticOrder, true, true>(lds, g, S, E); }
    { constexpr int KS = D / 4; pg8::Gemm g{OB, Wo_t, M, D, KS, D}; pg8::TailOrder S{4, KS * 2, G, (int)blockIdx.x}; pg8::EpiPartF32 E{PART, KS * 2};
      pg8::gemm_phase<pg8::EpiPartF32, pg8::TailOrder, true, true>(lds, g, S, E); }
    xcd_barrier(bar);
    DERIVE(); tid = threadIdx.x; asm volatile("" : "+v"(tid)); lane = tid & 63;
    res_pass<1, 0>(a, MO, XR, XN, Y, a.norm_mix_post + D, a.norm_ffn_pre + D, PART, 4, gw, NGW, lane);
    xcd_barrier(bar);
    DERIVE(); tid = threadIdx.x; asm volatile("" : "+v"(tid)); lane = tid & 63;
    { pg8::Gemm g{XN, Wgu_t1, M, 2 * DFF, D, D}; pg8::StaticOrder S; S.init(M, 2 * DFF, G, (int)blockIdx.x); pg8::EpiSwiGLU E{HB};
      pg8::gemm_phase<pg8::EpiSwiGLU, pg8::StaticOrder, true, true>(lds, g, S, E); }
    xcd_barrier(bar);
    DERIVE(); tid = threadIdx.x; asm volatile("" : "+v"(tid)); lane = tid & 63;
    { pg8::Gemm g{HB, Wd_t1, MP, D, DFF, DFF}; pg8::StaticOrder S; S.init(MP, D, G, (int)blockIdx.x); pg8::EpiBf16<0> E{MO, D, nullptr, 0, 0, 1.f};
      pg8::gemm_phase<pg8::EpiBf16<0>, pg8::StaticOrder, true, true>(lds, g, S, E); }
    { constexpr int KS = DFF / 11; pg8::Gemm g{HB, Wd_t1, M, D, KS, DFF}; pg8::TailOrder S{11, KS * 2, G, (int)blockIdx.x}; pg8::EpiPartF32 E{PART, KS * 2};
      pg8::gemm_phase<pg8::EpiPartF32, pg8::TailOrder, true, true>(lds, g, S, E); }
    xcd_barrier(bar);
    DERIVE(); tid = threadIdx.x; asm volatile("" : "+v"(tid)); lane = tid & 63;
    res_pass<1, 1>(a, MO, XR, XN, Y, a.norm_ffn_post + D, nullptr, PART, 11, gw, NGW, lane);
}

extern "C" void kernel_launch(void* const* d_in, const int* in_sizes, int n_in, void* d_out, int out_size, void* d_ws, size_t ws_size, hipStream_t stream) {
    static int grid = 0;
    if (grid == 0) {
        if (n_in != 17 || (size_t)out_size != O_END || ws_size < WS_END) { fprintf(stderr, "kernel_launch: unexpected shapes n_in %d out %d ws %zu\n", n_in, out_size, ws_size); grid = -1; return; }
        int dev = 0, cus = 0, per_cu = 0;
        hipGetDevice(&dev); hipDeviceGetAttribute(&cus, hipDeviceAttributeMultiprocessorCount, dev);
        if (hipFuncSetAttribute((const void*)fwd_kernel, hipFuncAttributeMaxDynamicSharedMemorySize, LDS_BYTES) != hipSuccess) { fprintf(stderr, "kernel_launch: hipFuncSetAttribute failed\n"); grid = -1; return; }
        if (hipOccupancyMaxActiveBlocksPerMultiprocessor(&per_cu, (const void*)fwd_kernel, NWAVES * 64, LDS_BYTES) != hipSuccess || per_cu < 1) { fprintf(stderr, "kernel_launch: occupancy query says %d\n", per_cu); per_cu = 1; }
        (void)hipGetLastError();
        grid = cus;
    }
    if (grid < 0) return;
    if (hipMemsetAsync((char*)d_ws + WS_CTL, 0, CTL_BYTES, stream) != hipSuccess) { fprintf(stderr, "kernel_launch: memset failed\n"); return; }
    Args a{};
    const float** p = (const float**)&a;
    for (int i = 0; i < 17; ++i) p[i] = (const float*)d_in[i];
    a.out = (float*)d_out; a.ws = (unsigned char*)d_ws;
    void* args[] = {&a};
    hipError_t e = hipLaunchCooperativeKernel((const void*)fwd_kernel, dim3(grid), dim3(NWAVES * 64), args, LDS_BYTES, stream);
    if (e != hipSuccess) fprintf(stderr, "cooperative launch failed: %s (grid %d)\n", hipGetErrorString(e), grid);
}
```

```cpp
#include <hip/hip_runtime.h>
#include <hip/hip_cooperative_groups.h>
#include <cstdio>
#include <cstdint>
namespace cg = cooperative_groups;
namespace pg8 {
#define PG8_LAS __attribute__((address_space(3)))
typedef unsigned short bf16_t;
typedef short bf16x8 __attribute__((ext_vector_type(8)));
typedef float f32x4 __attribute__((ext_vector_type(4)));
typedef unsigned u32x4 __attribute__((ext_vector_type(4)));
constexpr int BM = 256, BK = 64, HALF = 128, HTB = HALF * BK * 2  , STAGE_BYTES = 8 * HTB, NXCD = 8, WGM = 8;

__host__ __device__ __forceinline__ int lds_byte(int r, int c) { const int st = (r >> 4) * 2 + (c >> 5), rr = r & 15, cc = c & 31, ob = rr * 64 + cc * 2; return st * 1024 + (ob ^ (((ob >> 9) & 1) << 5)); }
__host__ __device__ __forceinline__ void stage_rc(int b, int& R, int& C) { const int st = b / 1024, sb = b % 1024, swz = sb ^ (((sb >> 9) & 1) << 5); R = (st >> 1) * 16 + swz / 64; C = (st & 1) * 32 + (swz % 64) / 2; }
__host__ __device__ __forceinline__ int perm32(int rho) { const int n = rho >> 4, i = rho & 15; return 8 * (i >> 2) + 4 * n + (i & 3); }

struct Unit { int pm, pn; int kb; };
struct Gemm { const bf16_t* A; const bf16_t* Bt; int M, N, K; int ld; };

struct StaticOrder {
    int nM, nN, nwg, G, c;
    __host__ __device__ void init(int M, int N, int G_, int c_) { nM = M / BM; nN = N / BM; nwg = nM * nN; G = G_; c = c_; }
    __host__ __device__ bool next(int i, Unit& u) const {
        const long L = (long)i * G + c; if (L >= nwg) return false;
        int wgid = (int)L; { const int q = nwg / NXCD, r = nwg % NXCD, xcd = wgid % NXCD, off = wgid / NXCD; wgid = (xcd < r ? xcd * (q + 1) : r * (q + 1) + (xcd - r) * q) + off; }
        const int nig = WGM * nN, gid = wgid / nig, fm = gid * WGM, gsz = (nM - fm) < WGM ? (nM - fm) : WGM;
        u.pm = fm + ((wgid % nig) % gsz); u.pn = (wgid % nig) / gsz; u.kb = 0; return true;
    }
    __device__ __forceinline__ void a_ready(const Unit&) const {}
    __device__ __forceinline__ void done(const Unit&) const {}
};

__device__ __forceinline__ unsigned cvt_pk_bf16(float lo, float hi) { unsigned r; asm volatile("v_cvt_pk_bf16_f32 %0, %1, %2" : "=v"(r) : "v"(lo), "v"(hi)); return r; }
typedef float f32x2 __attribute__((ext_vector_type(2)));
__device__ __forceinline__ f32x2 gelu_pk(f32x2 v) {
    const f32x2 av = __builtin_elementwise_abs(v), d = av * 0.2316418882f + 1.0f;
    f32x2 t; t.x = __builtin_amdgcn_rcpf(d.x); t.y = __builtin_amdgcn_rcpf(d.y);
    f32x2 q = t * 0.5307027145f + (-0.7265760135f); q = q * t + 0.7107068705f; q = q * t + (-0.142248368f); q = q * t + 0.127414796f; q = q * t;
    const f32x2 s = (v * v) * (-0.72134752044f);
    f32x2 e; e.x = __builtin_amdgcn_exp2f(s.x); e.y = __builtin_amdgcn_exp2f(s.y);
    const f32x2 m = v * (q * e), r = v - m;
    f32x2 o; o.x = v.x < 0.f ? m.x : r.x; o.y = v.y < 0.f ? m.y : r.y; return o;
}

template <int ACT  > struct EpiBf16 {
    static constexpr bool PERM = true, AFTER_DRAIN = false; static_assert(ACT == 0 || ACT == 1, "EpiBf16: ACT is 0 (none) or 1 (gelu_pk)");
    bf16_t* O; int ldc; const float* bias; int split_cols; size_t split_stride; float scale0;
    __device__ __forceinline__ void operator()(const f32x4 (&acc)[2][2][4][2], const Unit& u, int wr, int wc, int fr, int fq) const {
        const int row0 = u.pm * BM + wr * 64 + fr; int colt = u.pn * BM; bf16_t* base = O;
        float sc = 1.f; if (split_cols) { const int t = colt / split_cols; base += (size_t)t * split_stride; colt -= t * split_cols; if (t == 0) sc = scale0; }
        const int col0 = colt + wc * 32 + 8 * fq, bcol0 = u.pn * BM + wc * 32 + 8 * fq;
        f32x4 bv[2][2];
#pragma unroll
        for (int bj = 0; bj < 2; ++bj)
#pragma unroll
            for (int n = 0; n < 2; ++n) bv[bj][n] = bias ? *(const f32x4*)(bias + bcol0 + bj * HALF + 4 * n) : (f32x4){0.f, 0.f, 0.f, 0.f};
#pragma unroll
        for (int ai = 0; ai < 2; ++ai)
#pragma unroll
            for (int m = 0; m < 4; ++m) { bf16_t* rowp = base + (size_t)(row0 + ai * HALF + m * 16) * ldc + col0;
#pragma unroll
                for (int bj = 0; bj < 2; ++bj) { f32x4 v0 = acc[ai][bj][m][0] + bv[bj][0], v1 = acc[ai][bj][m][1] + bv[bj][1];
                    if (ACT == 1) { f32x2 a = gelu_pk((f32x2){v0[0], v0[1]}), b = gelu_pk((f32x2){v0[2], v0[3]}), c = gelu_pk((f32x2){v1[0], v1[1]}), d = gelu_pk((f32x2){v1[2], v1[3]});
                        v0 = (f32x4){a.x, a.y, b.x, b.y}; v1 = (f32x4){c.x, c.y, d.x, d.y}; }
                    v0 = v0 * sc; v1 = v1 * sc; u32x4 w; w.x = cvt_pk_bf16(v0[0], v0[1]); w.y = cvt_pk_bf16(v0[2], v0[3]); w.z = cvt_pk_bf16(v1[0], v1[1]); w.w = cvt_pk_bf16(v1[2], v1[3]);
                    *(u32x4*)(rowp + bj * HALF) = w; } }
    }
};
template <class Epi, class Sched, bool ALIGN_EPI = false, bool SP2 = false>
__device__ __forceinline__ void gemm_phase(PG8_LAS unsigned char* lds, const Gemm g, const Sched& S, const Epi& E) {
    int tid_ = threadIdx.x; asm volatile("" : "+v"(tid_)); const int tid = tid_, wid = __builtin_amdgcn_readfirstlane(tid >> 6), lane = tid & 63, wr = wid >> 2, wc = wid & 3, fr = lane & 15, fq = lane >> 4;
    const int K = g.ld, nt = g.K / BK;
    unsigned voffA[2], voffB[2];
#pragma unroll
    for (int i = 0; i < 2; ++i) { int R, C; stage_rc(tid * 16 + i * 8192, R, C); const int Rb = Epi::PERM ? ((R & ~31) + perm32(R & 31)) : R;
        voffA[i] = (unsigned)(R * K + C) * 2u; voffB[i] = (unsigned)(Rb * K + C) * 2u; }
    const size_t kstep = (size_t)(BK * 2);
    const size_t hstep = (size_t)HALF * K * 2;
    const size_t tstep = 2 * hstep;
    const unsigned ldsw = (unsigned)wid * 1024u;
    const int aoff = lds_byte(wr * 64 + fr, fq * 8), boff = lds_byte(wc * 32 + fr, fq * 8);
#define PG8_SA(b, h) (((b) * 2 + (h)) * HTB)
#define PG8_SB(b, h) ((4 + (b) * 2 + (h)) * HTB)
#define PG8_STAGE(bufoff, gbase, voff) do { _Pragma("unroll") for (int _i = 0; _i < 2; ++_i) \
        __builtin_amdgcn_global_load_lds((const unsigned*)((const char*)(gbase) + (voff)[_i]), (PG8_LAS unsigned*)(lds + (bufoff) + ldsw + _i * 8192), 16, 0, 0); } while (0)
#define PG8_LDA(dst, b, h) do { _Pragma("unroll") for (int m = 0; m < 4; ++m) _Pragma("unroll") for (int k = 0; k < 2; ++k) dst[m][k] = *(const PG8_LAS bf16x8*)(lds + PG8_SA(b, h) + aoff + m * 2048 + k * 1024); } while (0)
#define PG8_LDB(dst, b, h) do { _Pragma("unroll") for (int n = 0; n < 2; ++n) _Pragma("unroll") for (int k = 0; k < 2; ++k) dst[n][k] = *(const PG8_LAS bf16x8*)(lds + PG8_SB(b, h) + boff + n * 2048 + k * 1024); } while (0)
#define PG8_MMA(ai, bj, At, Bt) do { __builtin_amdgcn_s_setprio(1); _Pragma("unroll") for (int m = 0; m < 4; ++m) _Pragma("unroll") for (int n = 0; n < 2; ++n) _Pragma("unroll") for (int k = 0; k < 2; ++k) \
        acc[ai][bj][m][n] = __builtin_amdgcn_mfma_f32_16x16x32_bf16(Bt[n][k], At[m][k], acc[ai][bj][m][n], 0, 0, 0); __builtin_amdgcn_s_setprio(0); } while (0)
#define PG8_WAIT_V(n) asm volatile("s_waitcnt vmcnt(" #n ")" ::: "memory")
#define PG8_WAIT_L(n) asm volatile("s_waitcnt lgkmcnt(" #n ")" ::: "memory")
#define PG8_BAR __builtin_amdgcn_s_barrier()
#define PG8_SCHED __builtin_amdgcn_sched_barrier(0)
    Unit cur, nxt; int ui = 0;
    if (!S.next(0, cur)) return;
    f32x4 acc[2][2][4][2];
#pragma unroll
    for (int a = 0; a < 2; ++a)
#pragma unroll
        for (int b = 0; b < 2; ++b)
#pragma unroll
            for (int m = 0; m < 4; ++m)
#pragma unroll
                for (int n = 0; n < 2; ++n) acc[a][b][m][n] = (f32x4){0.f, 0.f, 0.f, 0.f};
    bf16x8 At[4][2], B0[2][2], B1[2][2];
    const char* cA = (const char*)g.A + (size_t)cur.pm * tstep + cur.kb; const char* cB = (const char*)g.Bt + (size_t)cur.pn * tstep + cur.kb;
    S.a_ready(cur);
    if constexpr (SP2) {
        PG8_STAGE(PG8_SB(0, 0), cB, voffB); PG8_STAGE(PG8_SB(0, 1), cB + hstep, voffB); PG8_STAGE(PG8_SA(0, 0), cA, voffA); PG8_STAGE(PG8_SA(0, 1), cA + hstep, voffA);
        if (wr == 1) PG8_BAR;
        PG8_WAIT_V(2); PG8_BAR;
        PG8_STAGE(PG8_SB(1, 0), cB + kstep, voffB); PG8_STAGE(PG8_SA(1, 0), cA + kstep, voffA); PG8_STAGE(PG8_SB(1, 1), cB + hstep + kstep, voffB);
        PG8_WAIT_V(6); PG8_BAR;
    } else {
        PG8_STAGE(PG8_SB(0, 0), cB, voffB); PG8_STAGE(PG8_SA(0, 0), cA, voffA); PG8_STAGE(PG8_SB(0, 1), cB + hstep, voffB); PG8_STAGE(PG8_SA(0, 1), cA + hstep, voffA);
        if (wr == 1) PG8_BAR;
        PG8_WAIT_V(4); PG8_BAR;
        PG8_STAGE(PG8_SB(1, 0), cB + kstep, voffB); PG8_STAGE(PG8_SA(1, 0), cA + kstep, voffA); PG8_STAGE(PG8_SB(1, 1), cB + hstep + kstep, voffB);
        PG8_WAIT_V(6); PG8_BAR;
    }
    for (;;) {
        const bool has_next = S.next(ui + 1, nxt);
        const char* nA = has_next ? (const char*)g.A + (size_t)nxt.pm * tstep + nxt.kb : cA; const char* nB = has_next ? (const char*)g.Bt + (size_t)nxt.pn * tstep + nxt.kb : cB;
        for (int t = 0; t < nt; t += 2) {
            const bool last = (t == nt - 2);
            const char* a1 = cA + (size_t)(t + 1) * kstep;
            const char* a2 = last ? nA : cA + (size_t)(t + 2) * kstep; const char* b2 = last ? nB : cB + (size_t)(t + 2) * kstep;
            const char* a3 = a2 + kstep; const char* b3 = b2 + kstep;
            if (last && has_next) S.a_ready(nxt);
            if constexpr (SP2) {
            PG8_LDB(B0, 0, 0); PG8_LDB(B1, 0, 1); PG8_SCHED; PG8_LDA(At, 0, 0); PG8_STAGE(PG8_SA(1, 1), a1 + hstep, voffA);
            PG8_WAIT_V(8); PG8_WAIT_L(0); PG8_BAR; PG8_MMA(0, 0, At, B0); PG8_MMA(0, 1, At, B1); PG8_BAR; PG8_SCHED;
            PG8_LDA(At, 0, 1); PG8_STAGE(PG8_SB(0, 0), b2, voffB); PG8_STAGE(PG8_SB(0, 1), b2 + hstep, voffB); PG8_STAGE(PG8_SA(0, 0), a2, voffA);
            PG8_WAIT_V(8); PG8_WAIT_L(0); PG8_BAR; PG8_MMA(1, 0, At, B0); PG8_MMA(1, 1, At, B1); PG8_BAR; PG8_SCHED;
            PG8_LDB(B0, 1, 0); PG8_LDB(B1, 1, 1); PG8_SCHED; PG8_LDA(At, 1, 0); PG8_STAGE(PG8_SA(0, 1), a2 + hstep, voffA);
            PG8_WAIT_V(8); PG8_WAIT_L(0); PG8_BAR; PG8_MMA(0, 0, At, B0); PG8_MMA(0, 1, At, B1); PG8_BAR; PG8_SCHED;
            PG8_LDA(At, 1, 1); PG8_STAGE(PG8_SB(1, 0), b3, voffB); PG8_STAGE(PG8_SB(1, 1), b3 + hstep, voffB); PG8_STAGE(PG8_SA(1, 0), a3, voffA);
            PG8_WAIT_V(8); PG8_WAIT_L(0); PG8_BAR; PG8_MMA(1, 0, At, B0); PG8_MMA(1, 1, At, B1); PG8_BAR; PG8_SCHED;
            } else {
            PG8_LDB(B0, 0, 0); PG8_SCHED; PG8_LDA(At, 0, 0); PG8_STAGE(PG8_SA(1, 1), a1 + hstep, voffA);
            PG8_WAIT_L(8); PG8_BAR; PG8_WAIT_L(0); PG8_MMA(0, 0, At, B0); PG8_BAR; PG8_SCHED;
            PG8_LDB(B1, 0, 1); PG8_STAGE(PG8_SB(0, 0), b2, voffB);
            PG8_BAR; PG8_WAIT_L(0); PG8_MMA(0, 1, At, B1); PG8_BAR;
            PG8_LDA(At, 0, 1); PG8_STAGE(PG8_SA(0, 0), a2, voffA);
            PG8_BAR; PG8_WAIT_L(0); PG8_MMA(1, 0, At, B0); PG8_BAR; PG8_SCHED;
            PG8_STAGE(PG8_SB(0, 1), b2 + hstep, voffB);
            PG8_WAIT_V(6); PG8_BAR; PG8_MMA(1, 1, At, B1); PG8_BAR;
            PG8_LDB(B0, 1, 0); PG8_SCHED; PG8_LDA(At, 1, 0); PG8_STAGE(PG8_SA(0, 1), a2 + hstep, voffA);
            PG8_WAIT_L(8); PG8_BAR; PG8_WAIT_L(0); PG8_MMA(0, 0, At, B0); PG8_BAR; PG8_SCHED;
            PG8_LDB(B1, 1, 1); PG8_STAGE(PG8_SB(1, 0), b3, voffB);
            PG8_BAR; PG8_WAIT_L(0); PG8_MMA(0, 1, At, B1); PG8_BAR;
            PG8_LDA(At, 1, 1); PG8_STAGE(PG8_SA(1, 0), a3, voffA);
            PG8_BAR; PG8_WAIT_L(0); PG8_MMA(1, 0, At, B0); PG8_BAR; PG8_SCHED;
            PG8_STAGE(PG8_SB(1, 1), b3 + hstep, voffB);
            PG8_WAIT_V(6); PG8_BAR; PG8_MMA(1, 1, At, B1); PG8_BAR;
            }
        }
        if constexpr (ALIGN_EPI) { if (wr == 0) PG8_BAR; }
        if constexpr (!Epi::AFTER_DRAIN) { E(acc, cur, wr, wc, fr, fq); S.done(cur); }
        if (!has_next) break;
#pragma unroll
        for (int a = 0; a < 2; ++a)
#pragma unroll
            for (int b = 0; b < 2; ++b)
#pragma unroll
                for (int m = 0; m < 4; ++m)
#pragma unroll
                    for (int n = 0; n < 2; ++n) acc[a][b][m][n] = (f32x4){0.f, 0.f, 0.f, 0.f};
        cur = nxt; cA = nA; cB = nB; ++ui;
        if constexpr (ALIGN_EPI) { if (wr == 1) PG8_BAR; }
    }
    PG8_WAIT_V(0);
    if constexpr (!ALIGN_EPI) { if (wr == 0) PG8_BAR; }
    PG8_BAR;
    if constexpr (Epi::AFTER_DRAIN) { E.fused(acc, cur, wr, wc, fr, fq, lds, wid, lane); S.done(cur); }
#undef PG8_SA
#undef PG8_SB
#undef PG8_STAGE
#undef PG8_LDA
#undef PG8_LDB
#undef PG8_MMA
#undef PG8_WAIT_V
#undef PG8_WAIT_L
#undef PG8_BAR
#undef PG8_SCHED
}
}

#define LAS __attribute__((address_space(3)))
typedef unsigned short bf16_t;
typedef unsigned u32x4 __attribute__((ext_vector_type(4)));
typedef unsigned u32x2 __attribute__((ext_vector_type(2)));
typedef float f32x4 __attribute__((ext_vector_type(4)));
typedef float f32x16 __attribute__((ext_vector_type(16)));
typedef short bf16x8 __attribute__((ext_vector_type(8)));
typedef short s16x4 __attribute__((ext_vector_type(4)));

constexpr int D = 1024, NB = 32, SEQ = 2048, DB = 32, DS = 32, NH = 16, HD = 64, DFF = 2816;
constexpr int MP = NB * SEQ;
constexpr int MS = DB * DS;
constexpr int M = MP + MS;
constexpr int CROWS = 512;
constexpr float EPS = 1e-6f;
constexpr float LOG2E = 1.4426950408889634f;
constexpr float QSCALE = 0.125f * LOG2E;
constexpr int NWAVES = 8;
#ifndef REP_KVOUT
#define REP_KVOUT 1
#endif
#ifndef REP_SAMPLE
#define REP_SAMPLE 1
#endif
#ifndef REP_PROMPT
#define REP_PROMPT 1
#endif

constexpr size_t O_Y = 0;
constexpr size_t O_CONVP = (size_t)M * D;
constexpr size_t O_CONVS = O_CONVP + 65536;
constexpr size_t O_KP = O_CONVS + 65536;
constexpr size_t O_VP = O_KP + (size_t)NB * CROWS * D;
constexpr size_t O_KS = O_VP + (size_t)NB * CROWS * D;
constexpr size_t O_VS = O_KS + (size_t)MS * D;
constexpr size_t O_END = O_VS + (size_t)MS * D;

constexpr size_t MiB = 1u << 20;
constexpr size_t WS_WIN = 0, WS_WOUT = 6 * MiB, WS_WGU0 = 8 * MiB, WS_WGU1 = 19 * MiB, WS_WD0 = 30 * MiB, WS_WD1 = 30 * MiB + 5632 * 1024,
                 WS_WQKV = 41 * MiB, WS_WO = 47 * MiB, WS_PART = 50 * MiB  , WS_CTL = 120 * MiB;
constexpr size_t WS_XN = 128 * MiB, WS_A = 258 * MiB, WS_B = 388 * MiB, WS_C = 518 * MiB, WS_MO = 648 * MiB, WS_O = 128 * MiB  , WS_XR = 778 * MiB, WS_END = 908 * MiB;

constexpr int LDS_BYTES = 131072 + 8192, MISC_OFF = 131072 + 4096, CW_BAR = 4096  , CTL_BYTES = 65536;

__device__ __forceinline__ float bf2f(unsigned short b) { return __uint_as_float(((unsigned)b) << 16); }
__device__ __forceinline__ float bflo(unsigned w) { return __uint_as_float(w << 16); }
__device__ __forceinline__ float bfhi(unsigned w) { return __uint_as_float(w & 0xffff0000u); }
__device__ __forceinline__ unsigned pk2(float lo, float hi) { return pg8::cvt_pk_bf16(lo, hi); }
__device__ __forceinline__ float wave_sum(float v) {
#pragma unroll
    for (int o = 1; o < 64; o <<= 1) v += __shfl_xor(v, o);
    return v;
}

namespace pg8 {
struct EpiConvIn {
    static constexpr bool PERM = true, AFTER_DRAIN = false;
    bf16_t* Bg; bf16_t* U;
    __device__ __forceinline__ void operator()(const f32x4 (&acc)[2][2][4][2], const Unit& u, int wr, int wc, int fr, int fq) const {
        const int row0 = u.pm * BM + wr * 64 + fr;
        if (u.pn < 4) {
            const int col0 = u.pn * BM + wc * 32 + 8 * fq;
#pragma unroll
            for (int ai = 0; ai < 2; ++ai)
#pragma unroll
                for (int m = 0; m < 4; ++m) { bf16_t* rowp = Bg + (size_t)(row0 + ai * HALF + m * 16) * 1024 + col0;
#pragma unroll
                    for (int bj = 0; bj < 2; ++bj) { const f32x4 v0 = acc[ai][bj][m][0], v1 = acc[ai][bj][m][1];
                        u32x4 w; w.x = cvt_pk_bf16(v0[0], v0[1]); w.y = cvt_pk_bf16(v0[2], v0[3]); w.z = cvt_pk_bf16(v1[0], v1[1]); w.w = cvt_pk_bf16(v1[2], v1[3]);
                        *(u32x4*)(rowp + bj * HALF) = w; } }
        } else {
            const int col0 = (u.pn - 4) * HALF + wc * 32 + 8 * fq;
#pragma unroll
            for (int ai = 0; ai < 2; ++ai)
#pragma unroll
                for (int m = 0; m < 4; ++m) { bf16_t* rowp = U + (size_t)(row0 + ai * HALF + m * 16) * 1024 + col0;
                    const f32x4 v0 = acc[ai][0][m][0] * acc[ai][1][m][0], v1 = acc[ai][0][m][1] * acc[ai][1][m][1];
                    u32x4 w; w.x = cvt_pk_bf16(v0[0], v0[1]); w.y = cvt_pk_bf16(v0[2], v0[3]); w.z = cvt_pk_bf16(v1[0], v1[1]); w.w = cvt_pk_bf16(v1[2], v1[3]);
                    *(u32x4*)(rowp) = w; }
        }
    }
};
struct EpiSwiGLU {
    static constexpr bool PERM = true, AFTER_DRAIN = false;
    bf16_t* H;
    __device__ __forceinline__ float act(float g, float uu) const { return g * uu * __builtin_amdgcn_rcpf(1.0f + __builtin_amdgcn_exp2f(-1.4426950408889634f * g)); }
    __device__ __forceinline__ void operator()(const f32x4 (&acc)[2][2][4][2], const Unit& u, int wr, int wc, int fr, int fq) const {
        const int row0 = u.pm * BM + wr * 64 + fr;
        const int col0 = u.pn * HALF + wc * 32 + 8 * fq;
#pragma unroll
        for (int ai = 0; ai < 2; ++ai)
#pragma unroll
            for (int m = 0; m < 4; ++m) { bf16_t* rowp = H + (size_t)(row0 + ai * HALF + m * 16) * 2816 + col0;
                const f32x4 g0 = acc[ai][0][m][0], g1 = acc[ai][0][m][1], u0 = acc[ai][1][m][0], u1 = acc[ai][1][m][1];
                u32x4 w; w.x = cvt_pk_bf16(act(g0[0], u0[0]), act(g0[1], u0[1])); w.y = cvt_pk_bf16(act(g0[2], u0[2]), act(g0[3], u0[3]));
                w.z = cvt_pk_bf16(act(g1[0], u1[0]), act(g1[1], u1[1])); w.w = cvt_pk_bf16(act(g1[2], u1[2]), act(g1[3], u1[3]));
                *(u32x4*)(rowp) = w; }
    }
};
struct TailOrder {
    int nsplit, ksub_bytes, G, c;
    __device__ __forceinline__ bool next(int i, Unit& u) const { const int L = i * G + c; if (L >= 16 * nsplit) return false; const int ks = L >> 4, t = L & 15; u.pm = 256 + (t & 3); u.pn = t >> 2; u.kb = ks * ksub_bytes; return true; }
    __device__ __forceinline__ void a_ready(const Unit&) const {}
    __device__ __forceinline__ void done(const Unit&) const {}
};
struct EpiPartF32 {
    static constexpr bool PERM = false, AFTER_DRAIN = false;
    float* P; int ksub_bytes;
    __device__ __forceinline__ void operator()(const f32x4 (&acc)[2][2][4][2], const Unit& u, int wr, int wc, int fr, int fq) const {
        const int ks = u.kb / ksub_bytes; const int row0 = (u.pm - 256) * BM + wr * 64 + fr, col0 = u.pn * BM + wc * 32 + 4 * fq;
        float* base = P + (size_t)ks * 1024 * 1024;
#pragma unroll
        for (int ai = 0; ai < 2; ++ai)
#pragma unroll
            for (int m = 0; m < 4; ++m) { float* rowp = base + (size_t)(row0 + ai * HALF + m * 16) * 1024 + col0;
#pragma unroll
                for (int bj = 0; bj < 2; ++bj)
#pragma unroll
                    for (int n = 0; n < 2; ++n) *(f32x4*)(rowp + bj * HALF + n * 16) = acc[ai][bj][m][n]; }
    }
};
}

struct Args {
    const float *x_prompt, *x_sample, *state_conv, *cache_k, *cache_v, *conv_w_in, *conv_kernel, *conv_w_out, *attn_w_qkv, *attn_w_o, *attn_rel_bias,
        *norm_mix_pre, *norm_mix_post, *norm_ffn_pre, *norm_ffn_post, *ffn_w_gate_up, *ffn_w_down;
    float* out; unsigned char* ws;
};

template <int MODE> __device__ __forceinline__ int dest_row(int n) {
    if (MODE == 1) { const int hh = n / DFF, rem = n - hh * DFF; return ((rem >> 7) << 8) + (hh << 7) + (rem & 127); }
    if (MODE == 2) { if (n < 1024) return n; const int np = n - 1024, hh = np >> 10, rem = np & 1023; return 1024 + ((rem >> 7) << 8) + (hh << 7) + (rem & 127); }
    return n;
}
template <int MODE> __device__ __forceinline__ void transpose_item(const float* W, int K, int N, bf16_t* WT, LAS float* scr, int item, int lane) {
    const int nblk = N / 32, kb = item / nblk, nb = item % nblk, k0 = 64 * kb, n0 = 32 * nb;
#pragma unroll 8
    for (int i = 0; i < 32; ++i) { const int kk = 2 * i + (lane >> 5); scr[kk * 33 + (lane & 31)] = W[(size_t)(k0 + kk) * N + n0 + (lane & 31)]; }
    asm volatile("s_waitcnt lgkmcnt(0)" ::: "memory");
    const int c = lane & 7; const int drow = dest_row<MODE>(n0);
#pragma unroll
    for (int j = 0; j < 4; ++j) { const int n = (lane >> 3) + 8 * j; const LAS float* s = scr + (8 * c) * 33 + n;
        u32x4 o; o.x = pk2(s[0 * 33], s[1 * 33]); o.y = pk2(s[2 * 33], s[3 * 33]); o.z = pk2(s[4 * 33], s[5 * 33]); o.w = pk2(s[6 * 33], s[7 * 33]);
        *(u32x4*)(WT + (size_t)(drow + n) * K + k0 + 8 * c) = o; }
    asm volatile("s_waitcnt lgkmcnt(0)" ::: "memory");
}

__device__ __forceinline__ void norm_row(const float* xrow, const float* g, bf16_t* orow, int lane) {
    const f32x4* xr = (const f32x4*)xrow + lane; const f32x4* gr = (const f32x4*)g + lane;
    f32x4 v[4]; float s = 0.f;
#pragma unroll
    for (int j = 0; j < 4; ++j) { v[j] = xr[64 * j]; s += (v[j].x * v[j].x + v[j].y * v[j].y) + (v[j].z * v[j].z + v[j].w * v[j].w); }
    const float inv = 1.0f / sqrtf(wave_sum(s) * (1.f / D) + EPS);
    u32x2* o8 = (u32x2*)orow + lane;
#pragma unroll
    for (int j = 0; j < 4; ++j) { const f32x4 gg = gr[64 * j]; u32x2 w; w.x = pk2(v[j].x * inv * gg.x, v[j].y * inv * gg.y); w.y = pk2(v[j].z * inv * gg.z, v[j].w * inv * gg.w); o8[64 * j] = w; }
}
template <int XIN> struct ResRaw { u32x2 m[2][4]; f32x4 xf[2][4]; u32x2 xb[2][4]; };
template <int XIN> __device__ __forceinline__ void res_load(ResRaw<XIN>& R, const Args& a, const bf16_t* MO, const bf16_t* XR, const float* part, int nsplit, int m0, int NGW, int lane) {
#pragma unroll
    for (int k = 0; k < 2; ++k) {
        const int m = (k == 0) ? m0 : ((m0 + NGW < M) ? m0 + NGW : m0);
        if (m >= MP) {
            const f32x4* pp = (const f32x4*)(part + (size_t)(m - MP) * D) + lane;
#pragma unroll
            for (int j = 0; j < 4; ++j) { f32x4 sacc = pp[64 * j];
                for (int ks = 1; ks < nsplit; ++ks) sacc = sacc + pp[(size_t)ks * 262144 + 64 * j];
                u32x2 w; w.x = pk2(sacc.x, sacc.y); w.y = pk2(sacc.z, sacc.w); R.m[k][j] = w; }
        } else {
            const u32x2* mr = (const u32x2*)(MO + (size_t)m * D) + lane;
#pragma unroll
            for (int j = 0; j < 4; ++j) R.m[k][j] = mr[64 * j];
        }
        if (XIN == 0) { const float* xr = m < MP ? a.x_prompt + (size_t)m * D : a.x_sample + (size_t)(m - MP) * D;
#pragma unroll
            for (int j = 0; j < 4; ++j) R.xf[k][j] = ((const f32x4*)xr + lane)[64 * j];
        } else { const u32x2* xr = (const u32x2*)(XR + (size_t)m * D) + lane;
#pragma unroll
            for (int j = 0; j < 4; ++j) R.xb[k][j] = xr[64 * j]; }
    }
}
template <int XIN, int XOUT> __device__ __forceinline__ void res_pass(const Args& a, const bf16_t* MO, bf16_t* XR, bf16_t* XN, float* Y, const float* gp, const float* gn, const float* part, int nsplit, int gw, int NGW, int lane) {
    const f32x4* gr = (const f32x4*)gp + lane;
    ResRaw<XIN> nx;
    if (gw < M) res_load<XIN>(nx, a, MO, XR, part, nsplit, gw, NGW, lane);
    for (int m0 = gw; m0 < M; m0 += 2 * NGW) {
        int mm[2]; mm[0] = m0; mm[1] = (m0 + NGW < M) ? m0 + NGW : m0;
        const ResRaw<XIN> cur = nx;
        if (m0 + 2 * NGW < M) res_load<XIN>(nx, a, MO, XR, part, nsplit, m0 + 2 * NGW, NGW, lane);
        f32x4 mv[2][4], xv[2][4]; float s[2] = {0.f, 0.f};
#pragma unroll
        for (int k = 0; k < 2; ++k)
#pragma unroll
            for (int j = 0; j < 4; ++j) { const u32x2 w = cur.m[k][j]; mv[k][j] = (f32x4){bflo(w.x), bfhi(w.x), bflo(w.y), bfhi(w.y)};
                if (XIN == 0) xv[k][j] = cur.xf[k][j]; else { const u32x2 x = cur.xb[k][j]; xv[k][j] = (f32x4){bflo(x.x), bfhi(x.x), bflo(x.y), bfhi(x.y)}; }
                s[k] += (mv[k][j].x * mv[k][j].x + mv[k][j].y * mv[k][j].y) + (mv[k][j].z * mv[k][j].z + mv[k][j].w * mv[k][j].w); }
        float inv[2], s2[2] = {0.f, 0.f};
#pragma unroll
        for (int k = 0; k < 2; ++k) inv[k] = 1.0f / sqrtf(wave_sum(s[k]) * (1.f / D) + EPS);
#pragma unroll
        for (int k = 0; k < 2; ++k)
#pragma unroll
            for (int j = 0; j < 4; ++j) { const f32x4 gg = gr[64 * j]; xv[k][j] = xv[k][j] + mv[k][j] * inv[k] * gg;
                s2[k] += (xv[k][j].x * xv[k][j].x + xv[k][j].y * xv[k][j].y) + (xv[k][j].z * xv[k][j].z + xv[k][j].w * xv[k][j].w); }
        if (XOUT == 1) {
#pragma unroll
            for (int k = 0; k < 2; ++k) { f32x4* xo = (f32x4*)(Y + (size_t)mm[k] * D) + lane;
#pragma unroll
                for (int j = 0; j < 4; ++j) xo[64 * j] = xv[k][j]; }
        } else {
            const f32x4* g2 = (const f32x4*)gn + lane;
#pragma unroll
            for (int k = 0; k < 2; ++k) {
                const float inv2 = 1.0f / sqrtf(wave_sum(s2[k]) * (1.f / D) + EPS);
                u32x2* xo = (u32x2*)(XR + (size_t)mm[k] * D) + lane; u32x2* o8 = (u32x2*)(XN + (size_t)mm[k] * D) + lane;
#pragma unroll
                for (int j = 0; j < 4; ++j) { const f32x4 gg = g2[64 * j]; const f32x4 x = xv[k][j];
                    u32x2 wx; wx.x = pk2(x.x, x.y); wx.y = pk2(x.z, x.w); xo[64 * j] = wx;
                    u32x2 w; w.x = pk2(x.x * inv2 * gg.x, x.y * inv2 * gg.y); w.y = pk2(x.z * inv2 * gg.z, x.w * inv2 * gg.w); o8[64 * j] = w; }
            }
        }
    }
}

namespace att {
__device__ __forceinline__ int crow(int i, int h) { return (i & 3) + 8 * (i >> 2) + 4 * h; }
typedef short v4i16_t __attribute__((ext_vector_type(4)));
__device__ __forceinline__ s16x4 vtr(const LAS unsigned char* p) { return __builtin_bit_cast(s16x4, __builtin_amdgcn_ds_read_tr16_b64_v4i16((LAS v4i16_t*)p)); }
struct Item { const bf16_t* q; const bf16_t* kc; const bf16_t* vc; const bf16_t* kn; const bf16_t* vn; bf16_t* o; float* kso; float* vso; const float* kcf; const float* vcf; int nc, kt0, kt1, qpos0, head; };

__device__ __forceinline__ void load_tile(const Item& it, int kt, int lane, bf16x8 (&kf)[4], u32x4 (&vr)[4]) {
    const int r = lane & 31, h = lane >> 5;
    if (it.kcf && kt < it.nc) {
        const float* kp = it.kcf + (size_t)kt * 32 * 1024 + (size_t)r * 1024 + 8 * h; const float* vp = it.vcf + (size_t)kt * 32 * 1024 + (size_t)(lane >> 3) * 1024 + (lane & 7) * 8;
#pragma unroll
        for (int s = 0; s < 4; ++s) { const f32x4 a = *(const f32x4*)(kp + 16 * s), b = *(const f32x4*)(kp + 16 * s + 4);
            u32x4 w; w.x = pk2(a.x, a.y); w.y = pk2(a.z, a.w); w.z = pk2(b.x, b.y); w.w = pk2(b.z, b.w); kf[s] = __builtin_bit_cast(bf16x8, w); }
#pragma unroll
        for (int i = 0; i < 4; ++i) { const f32x4 a = *(const f32x4*)(vp + (size_t)8 * i * 1024), b = *(const f32x4*)(vp + (size_t)8 * i * 1024 + 4);
            u32x4 w; w.x = pk2(a.x, a.y); w.y = pk2(a.z, a.w); w.z = pk2(b.x, b.y); w.w = pk2(b.z, b.w); vr[i] = w; }
        return;
    }
    const bf16_t* kp = it.kn + (size_t)(kt - it.nc) * 32 * 1024;
    const bf16_t* vp = it.vn + (size_t)(kt - it.nc) * 32 * 1024;
#pragma unroll
    for (int s = 0; s < 4; ++s) kf[s] = *(const bf16x8*)(kp + (size_t)r * 1024 + 16 * s + 8 * h);
#pragma unroll
    for (int i = 0; i < 4; ++i) vr[i] = *(const u32x4*)(vp + (size_t)((lane >> 3) + 8 * i) * 1024 + (lane & 7) * 8);
}

__device__ __forceinline__ void attn_item(const Item& it, LAS unsigned char* vlds, LAS float* tab, const float* table, int lane) {
    const int r = lane & 31, h = lane >> 5;
    asm volatile("s_waitcnt lgkmcnt(0)" ::: "memory");
    for (int i = lane; i < 257; i += 64) tab[i] = table[it.head * 257 + i] * LOG2E;
    bf16x8 qf[4];
#pragma unroll
    for (int s = 0; s < 4; ++s) qf[s] = *(const bf16x8*)(it.q + (size_t)r * 1024 + 16 * s + 8 * h);
    f32x16 o0, o1;
#pragma unroll
    for (int i = 0; i < 16; ++i) { o0[i] = 0.f; o1[i] = 0.f; }
    float mrun = -1e30f, lrun = 0.f;
    asm volatile("s_waitcnt lgkmcnt(0)" ::: "memory");
    const float cfar = tab[256];
    const int qpos = it.qpos0 + r;
    const int i16 = lane & 15, q4 = i16 >> 2, p4 = i16 & 3, g = (lane >> 4) & 1;
    const LAS unsigned char* trbase = vlds + (4 * h + q4) * 128 + (16 * g + 4 * p4) * 2;
    bf16x8 kf[4]; u32x4 vr[4];
    load_tile(it, it.kt0, lane, kf, vr);
    for (int kt = it.kt0; kt < it.kt1; ++kt) {
        bf16x8 kn_[4]; u32x4 vn_[4];
        if (kt + 1 < it.kt1) load_tile(it, kt + 1, lane, kn_, vn_);
        else {
#pragma unroll
            for (int s = 0; s < 4; ++s) { kn_[s] = kf[s]; vn_[s] = vr[s]; }
        }
        asm volatile("s_waitcnt lgkmcnt(0)" ::: "memory");
#pragma unroll
        for (int i = 0; i < 4; ++i) *(LAS u32x4*)(vlds + ((lane >> 3) + 8 * i) * 128 + (lane & 7) * 16) = vr[i];
        f32x16 p;
#pragma unroll
        for (int i = 0; i < 16; ++i) p[i] = 0.f;
#pragma unroll
        for (int s = 0; s < 4; ++s) p = __builtin_amdgcn_mfma_f32_32x32x16_bf16(kf[s], qf[s], p, 0, 0, 0);
        const int kb = 32 * kt;
        if (it.qpos0 - (kb + 31) >= 128) {
#pragma unroll
            for (int i = 0; i < 16; ++i) p[i] += cfar;
        } else {
#pragma unroll
            for (int i = 0; i < 16; ++i) { int dd = qpos - (kb + crow(i, h)); dd = dd < -128 ? -128 : (dd > 128 ? 128 : dd); p[i] += tab[dd + 128]; }
        }
        float tm = p[0];
#pragma unroll
        for (int i = 1; i < 16; ++i) tm = fmaxf(tm, p[i]);
        tm = fmaxf(tm, __shfl_xor(tm, 32));
        const float mnew = fmaxf(mrun, tm);
        const float sc = __builtin_amdgcn_exp2f(mrun - mnew);
        mrun = mnew;
        float ps = 0.f;
#pragma unroll
        for (int i = 0; i < 16; ++i) { p[i] = __builtin_amdgcn_exp2f(p[i] - mnew); ps += p[i]; }
        lrun = lrun * sc + ps;
#pragma unroll
        for (int i = 0; i < 16; ++i) { o0[i] *= sc; o1[i] *= sc; }
        u32x4 w0, w1;
        w0.x = pk2(p[0], p[1]); w0.y = pk2(p[2], p[3]); w0.z = pk2(p[4], p[5]); w0.w = pk2(p[6], p[7]);
        w1.x = pk2(p[8], p[9]); w1.y = pk2(p[10], p[11]); w1.z = pk2(p[12], p[13]); w1.w = pk2(p[14], p[15]);
        const bf16x8 pf0 = __builtin_bit_cast(bf16x8, w0), pf1 = __builtin_bit_cast(bf16x8, w1);
        asm volatile("s_waitcnt lgkmcnt(0)" ::: "memory");
#pragma unroll
        for (int s = 0; s < 2; ++s) {
            const s16x4 a_lo = vtr(trbase + (16 * s) * 128), a_hi = vtr(trbase + (16 * s + 8) * 128);
            const s16x4 b_lo = vtr(trbase + (16 * s) * 128 + 64), b_hi = vtr(trbase + (16 * s + 8) * 128 + 64);
            const bf16x8 va = __builtin_shufflevector(a_lo, a_hi, 0, 1, 2, 3, 4, 5, 6, 7), vb = __builtin_shufflevector(b_lo, b_hi, 0, 1, 2, 3, 4, 5, 6, 7);
            o0 = __builtin_amdgcn_mfma_f32_32x32x16_bf16(va, s == 0 ? pf0 : pf1, o0, 0, 0, 0);
            o1 = __builtin_amdgcn_mfma_f32_32x32x16_bf16(vb, s == 0 ? pf0 : pf1, o1, 0, 0, 0);
        }
#pragma unroll
        for (int s = 0; s < 4; ++s) { kf[s] = kn_[s]; vr[s] = vn_[s]; }
    }
    if (it.kso) {
        load_tile(it, it.nc, lane, kf, vr);
#pragma unroll
        for (int s = 0; s < 4; ++s) { const u32x4 w = __builtin_bit_cast(u32x4, kf[s]); float* d = it.kso + (size_t)r * 1024 + 16 * s + 8 * h;
            *(f32x4*)d = (f32x4){bflo(w.x), bfhi(w.x), bflo(w.y), bfhi(w.y)}; *(f32x4*)(d + 4) = (f32x4){bflo(w.z), bfhi(w.z), bflo(w.w), bfhi(w.w)}; }
#pragma unroll
        for (int i = 0; i < 4; ++i) { const u32x4 w = vr[i]; float* d = it.vso + (size_t)((lane >> 3) + 8 * i) * 1024 + (lane & 7) * 8;
            *(f32x4*)d = (f32x4){bflo(w.x), bfhi(w.x), bflo(w.y), bfhi(w.y)}; *(f32x4*)(d + 4) = (f32x4){bflo(w.z), bfhi(w.z), bflo(w.w), bfhi(w.w)}; }
    }
    lrun += __shfl_xor(lrun, 32);
    const float inv = 1.0f / lrun;
    bf16_t* orow = it.o + (size_t)r * 1024 + 4 * h;
#pragma unroll
    for (int g4 = 0; g4 < 4; ++g4) {
        u32x2 a, b;
        a.x = pk2(o0[4 * g4] * inv, o0[4 * g4 + 1] * inv); a.y = pk2(o0[4 * g4 + 2] * inv, o0[4 * g4 + 3] * inv);
        b.x = pk2(o1[4 * g4] * inv, o1[4 * g4 + 1] * inv); b.y = pk2(o1[4 * g4 + 2] * inv, o1[4 * g4 + 3] * inv);
        *(u32x2*)(orow + 8 * g4) = a; *(u32x2*)(orow + 32 + 8 * g4) = b;
    }
}

constexpr int KROW = 144, KTILE = 64 * KROW, VTILE = 64 * 128, A_K = 0, A_V = 2 * KTILE, A_TAB = A_V + 2 * VTILE, A_SLOT = A_TAB + 1296;
__device__ __forceinline__ float max3f(float a, float b, float c) { float r; asm("v_max3_f32 %0, %1, %2, %3" : "=v"(r) : "v"(a), "v"(b), "v"(c)); return r; }
__device__ __forceinline__ void attn_unit(int b, int hh, int cq, const bf16_t* Qg, const bf16_t* Kg, const bf16_t* Vg, bf16_t* Og, float* kout, float* vout, const float* table, LAS unsigned char* lds, int tid, int lane, int wave) {
    constexpr float THR = 8.0f;
    const int r = lane & 31, h = lane >> 5;
    const int c = 4 * cq + (wave >> 1), half = wave & 1;
    const int j0 = (4 * cq - 8) > 0 ? (4 * cq - 8) : 0, j1 = 4 * cq + 3;
    const size_t rb = (size_t)b * SEQ;
    LAS float* tab = (LAS float*)(lds + A_TAB);
    if (tid < 324) tab[tid] = table[hh * 257 + (tid < 256 ? tid : 256)] * LOG2E;
    const int lrow = tid >> 3, lch = tid & 7;
    const bf16_t* kgp = Kg + (rb + lrow) * D + hh * HD + lch * 8; const bf16_t* vgp = Vg + (rb + lrow) * D + hh * HD + lch * 8;
    const int kwoff = A_K + lrow * KROW + lch * 16, vwoff = A_V + lrow * 128 + ((lch ^ (((lrow >> 1) & 1) << 2)) << 4);
    const long korow = (long)b * CROWS - (SEQ - CROWS) + lrow; float* kop = kout + korow * D + hh * HD + lch * 8; float* vop = vout + korow * D + hh * HD + lch * 8;
#define ATT_KVOUT(tile) do { if (cq >= 6 && (tile) >= 4 * cq) { float* kd = kop + (long)(tile) * 64 * D; float* vd = vop + (long)(tile) * 64 * D; \
        *(f32x4*)kd = (f32x4){bflo(kreg.x), bfhi(kreg.x), bflo(kreg.y), bfhi(kreg.y)}; *(f32x4*)(kd + 4) = (f32x4){bflo(kreg.z), bfhi(kreg.z), bflo(kreg.w), bfhi(kreg.w)}; \
        *(f32x4*)vd = (f32x4){bflo(vreg.x), bfhi(vreg.x), bflo(vreg.y), bfhi(vreg.y)}; *(f32x4*)(vd + 4) = (f32x4){bflo(vreg.z), bfhi(vreg.z), bflo(vreg.w), bfhi(vreg.w)}; } } while (0)
    u32x4 kreg = *(const u32x4*)(kgp + (size_t)j0 * 64 * D), vreg = *(const u32x4*)(vgp + (size_t)j0 * 64 * D);
    bf16x8 qf[4];
    const bf16_t* qp = Qg + (rb + 64 * c + 32 * half + r) * D + hh * HD + 8 * h;
#pragma unroll
    for (int s = 0; s < 4; ++s) qf[s] = *(const bf16x8*)(qp + 16 * s);
    *(LAS u32x4*)(lds + kwoff) = kreg; *(LAS u32x4*)(lds + vwoff) = vreg;
    ATT_KVOUT(j0);
    kreg = *(const u32x4*)(kgp + (size_t)(j0 + 1) * 64 * D); vreg = *(const u32x4*)(vgp + (size_t)(j0 + 1) * 64 * D);
    f32x16 o0, o1;
#pragma unroll
    for (int i = 0; i < 16; ++i) { o0[i] = 0.f; o1[i] = 0.f; }
    float mrun = 0.f, lrun = 0.f;
    const int i16 = lane & 15, q4 = i16 >> 2, p4 = i16 & 3, g = (lane >> 4) & 1;
    const int troff = A_V + (4 * h + q4) * 128 + ((32 * g) ^ (((q4 >> 1) & 1) << 6)) + 8 * p4;
    const int kroff = A_K + r * KROW + 16 * h;
    __syncthreads();
    const float cfar = tab[256];
    f32x16 negf;
#pragma unroll
    for (int i = 0; i < 16; ++i) negf[i] = cfar;
    asm volatile("" : "+v"(negf));
    const int qpos = 64 * c + 32 * half + r;
    bool first = true;
    for (int j = j0; j <= j1; ++j) {
        const int bufk = ((j - j0) & 1) * KTILE, bufv = ((j - j0) & 1) * VTILE;
        if (j < j1) { const int nbk = ((j + 1 - j0) & 1) * KTILE, nbv = ((j + 1 - j0) & 1) * VTILE; *(LAS u32x4*)(lds + nbk + kwoff) = kreg; *(LAS u32x4*)(lds + nbv + vwoff) = vreg; ATT_KVOUT(j + 1); }
        if (j + 2 <= j1) { kreg = *(const u32x4*)(kgp + (size_t)(j + 2) * 64 * D); vreg = *(const u32x4*)(vgp + (size_t)(j + 2) * 64 * D); }
        if (j >= c - 8 && j <= c) {
            f32x16 p0, p1;
            bf16x8 ka[4], kb[4];
#pragma unroll
            for (int s = 0; s < 4; ++s) { ka[s] = *(const LAS bf16x8*)(lds + bufk + kroff + 32 * s); kb[s] = *(const LAS bf16x8*)(lds + bufk + kroff + 32 * KROW + 32 * s); }
            if (j <= c - 3) {
                p0 = __builtin_amdgcn_mfma_f32_32x32x16_bf16(ka[0], qf[0], negf, 0, 0, 0);
                p1 = __builtin_amdgcn_mfma_f32_32x32x16_bf16(kb[0], qf[0], negf, 0, 0, 0);
            } else {
                const LAS float* tb = tab + (qpos - 64 * j - 4 * h + 128 - 59);
#pragma unroll
                for (int i = 0; i < 16; ++i) { p0[i] = tb[59 - ((i & 3) + 8 * (i >> 2))] - mrun; p1[i] = tb[59 - 32 - ((i & 3) + 8 * (i >> 2))] - mrun; }
                p0 = __builtin_amdgcn_mfma_f32_32x32x16_bf16(ka[0], qf[0], p0, 0, 0, 0);
                p1 = __builtin_amdgcn_mfma_f32_32x32x16_bf16(kb[0], qf[0], p1, 0, 0, 0);
            }
#pragma unroll
            for (int s = 1; s < 4; ++s) {
                p0 = __builtin_amdgcn_mfma_f32_32x32x16_bf16(ka[s], qf[s], p0, 0, 0, 0);
                p1 = __builtin_amdgcn_mfma_f32_32x32x16_bf16(kb[s], qf[s], p1, 0, 0, 0);
            }
            float ta = max3f(p0[0], p0[1], p1[0]), tb2 = max3f(p0[2], p0[3], p1[1]);
            ta = max3f(ta, p1[2], p1[3]);
#pragma unroll
            for (int i = 4; i < 16; i += 4) { ta = max3f(ta, p0[i], p0[i + 1]); tb2 = max3f(tb2, p0[i + 2], p0[i + 3]); ta = max3f(ta, p1[i], p1[i + 1]); tb2 = max3f(tb2, p1[i + 2], p1[i + 3]); }
            float tm = fmaxf(ta, tb2);
            { auto rr = __builtin_amdgcn_permlane32_swap(__float_as_uint(tm), __float_as_uint(tm), false, false); tm = fmaxf(__uint_as_float(rr[0]), __uint_as_float(rr[1])); }
            if (first || __any(tm > THR)) {
                const float dl = first ? tm : fmaxf(tm, 0.f); mrun += dl;
                const float sc = __builtin_amdgcn_exp2f(-dl); lrun *= sc;
#pragma unroll
                for (int i = 0; i < 16; ++i) { p0[i] -= dl; p1[i] -= dl; o0[i] *= sc; o1[i] *= sc; negf[i] = cfar - mrun; }
                asm volatile("" : "+v"(negf));
                first = false;
            }
            float ps0 = 0.f, ps1 = 0.f;
#pragma unroll
            for (int i = 0; i < 16; ++i) { p0[i] = __builtin_amdgcn_exp2f(p0[i]); p1[i] = __builtin_amdgcn_exp2f(p1[i]); ps0 += p0[i]; ps1 += p1[i]; }
            lrun += ps0 + ps1;
            u32x4 w0, w1, w2, w3;
            w0.x = pk2(p0[0], p0[1]); w0.y = pk2(p0[2], p0[3]); w0.z = pk2(p0[4], p0[5]); w0.w = pk2(p0[6], p0[7]);
            w1.x = pk2(p0[8], p0[9]); w1.y = pk2(p0[10], p0[11]); w1.z = pk2(p0[12], p0[13]); w1.w = pk2(p0[14], p0[15]);
            w2.x = pk2(p1[0], p1[1]); w2.y = pk2(p1[2], p1[3]); w2.z = pk2(p1[4], p1[5]); w2.w = pk2(p1[6], p1[7]);
            w3.x = pk2(p1[8], p1[9]); w3.y = pk2(p1[10], p1[11]); w3.z = pk2(p1[12], p1[13]); w3.w = pk2(p1[14], p1[15]);
            const bf16x8 pf[4] = {__builtin_bit_cast(bf16x8, w0), __builtin_bit_cast(bf16x8, w1), __builtin_bit_cast(bf16x8, w2), __builtin_bit_cast(bf16x8, w3)};
#pragma unroll
            for (int ks = 0; ks < 4; ++ks) {
                const LAS unsigned char* tb = lds + bufv + troff + ks * 16 * 128;
                const s16x4 a_lo = vtr(tb), a_hi = vtr(tb + 8 * 128);
                const LAS unsigned char* tb1 = lds + bufv + (troff ^ 64) + ks * 16 * 128;
                const s16x4 b_lo = vtr(tb1), b_hi = vtr(tb1 + 8 * 128);
                const bf16x8 va = __builtin_shufflevector(a_lo, a_hi, 0, 1, 2, 3, 4, 5, 6, 7), vb = __builtin_shufflevector(b_lo, b_hi, 0, 1, 2, 3, 4, 5, 6, 7);
                o0 = __builtin_amdgcn_mfma_f32_32x32x16_bf16(va, pf[ks], o0, 0, 0, 0);
                o1 = __builtin_amdgcn_mfma_f32_32x32x16_bf16(vb, pf[ks], o1, 0, 0, 0);
            }
        }
        asm volatile("s_waitcnt lgkmcnt(0)\n\ts_barrier" ::: "memory");
    }
    lrun += __shfl_xor(lrun, 32);
    const float inv = 1.0f / lrun;
    bf16_t* orow = Og + (rb + 64 * c + 32 * half + r) * D + hh * HD + 4 * h;
#pragma unroll
    for (int g4 = 0; g4 < 4; ++g4) {
        u32x2 x, y;
        x.x = pk2(o0[4 * g4] * inv, o0[4 * g4 + 1] * inv); x.y = pk2(o0[4 * g4 + 2] * inv, o0[4 * g4 + 3] * inv);
        y.x = pk2(o1[4 * g4] * inv, o1[4 * g4 + 1] * inv); y.y = pk2(o1[4 * g4 + 2] * inv, o1[4 * g4 + 3] * inv);
        *(u32x2*)(orow + 8 * g4) = x; *(u32x2*)(orow + 32 + 8 * g4) = y;
    }
#undef ATT_KVOUT
}
}

#define XB_TMO      128
#define XB_XCNT(j)  (256  + 64 * (j))
#define XB_XSUB(j)  (1280 + 64 * (j))
#define XB_XGEN(j)  (2304 + 64 * (j))
#define XB_TOP      3328
#define XB_TOPGEN   3392
#define XCD_BAR_WORDS 3456
#define XB_SPIN_CAP (1u << 18)

__device__ __forceinline__ unsigned xb_ld(unsigned* p)              { return __hip_atomic_load(p, __ATOMIC_RELAXED, __HIP_MEMORY_SCOPE_AGENT); }
__device__ __forceinline__ unsigned xb_add(unsigned* p, unsigned v) { return __hip_atomic_fetch_add(p, v, __ATOMIC_RELAXED, __HIP_MEMORY_SCOPE_AGENT); }
__device__ __forceinline__ unsigned xb_xcc_id() { return (unsigned)__builtin_amdgcn_s_getreg((3 << 11) | 20) & 0xFu; }
#define XB_SPIN(cond, bar) do { unsigned _sp = 0; while (cond) { __builtin_amdgcn_s_sleep(1); \
    if ((++_sp & 255u) == 0u) { if (xb_ld(&(bar)[XB_TMO])) break; if (_sp > XB_SPIN_CAP) { atomicAdd(&(bar)[XB_TMO], 1u); break; } } } } while (0)

struct XcdBarrier {
    unsigned* bar; unsigned x;
    volatile LAS unsigned* st;
};

__device__ __forceinline__ XcdBarrier xcd_barrier_post(unsigned* bar, volatile LAS unsigned* st) {
    XcdBarrier b; b.bar = bar; b.x = xb_xcc_id(); b.st = st;
    if (threadIdx.x == 0) (void)xb_add(&bar[XB_XCNT(b.x)], 1u);
    return b;
}
__device__ __forceinline__ void xcd_barrier_complete(unsigned* bar, unsigned x, unsigned& nloc, unsigned& nx) {
    const unsigned G = gridDim.x * gridDim.y * gridDim.z;
    unsigned sum, cnt, mine, sp = 0u;
    for (;;) {
        sum = 0u; cnt = 0u; mine = 0u;
#pragma unroll
        for (unsigned j = 0; j < 16; ++j) { const unsigned c = xb_ld(&bar[XB_XCNT(j)]); sum += c; cnt += (c > 0u) ? 1u : 0u; mine = (j == x) ? c : mine; }
        if (sum == G) break;
        __builtin_amdgcn_s_sleep(1);
        if ((++sp & 255u) == 0u) { if (xb_ld(&bar[XB_TMO])) break; if (sp > XB_SPIN_CAP) { atomicAdd(&bar[XB_TMO], 1u); break; } }
    }
    nloc = mine > 0u ? mine : 1u; nx = cnt > 0u ? cnt : 1u;
}

__device__ __forceinline__ void xcd_barrier(const XcdBarrier& b) {
    asm volatile("s_waitcnt vmcnt(0)" ::: "memory");
    __syncthreads();
    if (threadIdx.x == 0) {
        unsigned* bar = b.bar;
        __builtin_amdgcn_s_waitcnt(0);
        unsigned nloc = b.st[0], nx = b.st[1];
        if (nloc == 0u) { xcd_barrier_complete(bar, b.x, nloc, nx); b.st[0] = nloc; b.st[1] = nx; }
        const unsigned old = xb_add(&bar[XB_XSUB(b.x)], 1u);
        const unsigned gen = old / nloc;
        if (old + 1u == (gen + 1u) * nloc) {
            __builtin_amdgcn_fence(__ATOMIC_RELEASE, "agent");
            asm volatile("s_waitcnt vmcnt(0)" ::: "memory");
            const unsigned og = xb_add(&bar[XB_TOP], 1u);
            const unsigned tg = og / nx;
            if (og + 1u == (tg + 1u) * nx) xb_add(&bar[XB_TOPGEN], 1u);
            else XB_SPIN(xb_ld(&bar[XB_TOPGEN]) == tg, bar);
            __builtin_amdgcn_fence(__ATOMIC_ACQUIRE, "agent");
            xb_add(&bar[XB_XGEN(b.x)], 1u);
            asm volatile("s_waitcnt vmcnt(0)" ::: "memory");
        } else {
            XB_SPIN(xb_ld(&bar[XB_XGEN(b.x)]) == gen, bar);
            __builtin_amdgcn_fence(__ATOMIC_ACQUIRE, "agent");
            asm volatile("s_waitcnt vmcnt(0)" ::: "memory");
        }
    }
    __syncthreads();
}


__global__ void __launch_bounds__(NWAVES * 64, 2) fwd_kernel(Args a) {
    extern __shared__ __attribute__((aligned(16))) unsigned char lds_raw[];
    cg::grid_group grid = cg::this_grid();
    LAS unsigned char* lds = (LAS unsigned char*)lds_raw;
    int tid = threadIdx.x, lane = tid & 63; const int wave = __builtin_amdgcn_readfirstlane(tid >> 6);
    const int G = gridDim.x, gw = blockIdx.x * NWAVES + wave, NGW = G * NWAVES;
    unsigned char* ws = a.ws;
    bf16_t *Win_t, *Wout_t, *Wgu_t0, *Wgu_t1, *Wd_t0, *Wd_t1, *Wqkv_t, *Wo_t, *XN, *BA, *BB, *BC, *MO, *OB, *HB, *XR; float *Y, *PART; unsigned* qctr;
#define DERIVE() do { size_t z_ = 0; asm volatile("" : "+s"(z_)); unsigned char* w_ = a.ws + z_;     \
        Win_t = (bf16_t*)(w_ + WS_WIN); Wout_t = (bf16_t*)(w_ + WS_WOUT); Wgu_t0 = (bf16_t*)(w_ + WS_WGU0); Wgu_t1 = (bf16_t*)(w_ + WS_WGU1); \
        Wd_t0 = (bf16_t*)(w_ + WS_WD0); Wd_t1 = (bf16_t*)(w_ + WS_WD1); Wqkv_t = (bf16_t*)(w_ + WS_WQKV); Wo_t = (bf16_t*)(w_ + WS_WO); \
        XN = (bf16_t*)(w_ + WS_XN); BA = (bf16_t*)(w_ + WS_A); BB = (bf16_t*)(w_ + WS_B); BC = (bf16_t*)(w_ + WS_C); MO = (bf16_t*)(w_ + WS_MO); OB = (bf16_t*)(w_ + WS_O); HB = BA; \
        XR = (bf16_t*)(w_ + WS_XR); Y = a.out + O_Y; PART = (float*)(w_ + WS_PART); qctr = (unsigned*)(w_ + WS_CTL); } while (0)
    DERIVE(); tid = threadIdx.x; asm volatile("" : "+v"(tid)); lane = tid & 63;
    { volatile LAS unsigned* st0 = (volatile LAS unsigned*)(lds + MISC_OFF); if (tid < 16) st0[tid] = 0u; }
    __syncthreads();
    XcdBarrier bar = xcd_barrier_post((unsigned*)(ws + WS_CTL) + CW_BAR, (volatile LAS unsigned*)(lds + MISC_OFF) + 8);
    if (a.out == nullptr) grid.sync();

    DERIVE(); tid = threadIdx.x; asm volatile("" : "+v"(tid)); lane = tid & 63;
    {
        LAS float* scr = (LAS float*)(lds + wave * 16384);
        constexpr int I_IN = 16 * 96, I_OUT = 16 * 32, I_GU = 16 * 176, I_D = 44 * 32;
        constexpr int NITEMS = 2 * I_IN + 2 * I_OUT + 2 * I_GU + 2 * I_D;
        for (int it = gw; it < NITEMS; it += NGW) {
            int r = it;
            if (r < I_IN) { transpose_item<2>(a.conv_w_in, D, 3 * D, Win_t, scr, r, lane); continue; } r -= I_IN;
            if (r < I_OUT) { transpose_item<0>(a.conv_w_out, D, D, Wout_t, scr, r, lane); continue; } r -= I_OUT;
            if (r < I_GU) { transpose_item<1>(a.ffn_w_gate_up, D, 2 * DFF, Wgu_t0, scr, r, lane); continue; } r -= I_GU;
            if (r < I_GU) { transpose_item<1>(a.ffn_w_gate_up + (size_t)D * 2 * DFF, D, 2 * DFF, Wgu_t1, scr, r, lane); continue; } r -= I_GU;
            if (r < I_D) { transpose_item<0>(a.ffn_w_down, DFF, D, Wd_t0, scr, r, lane); continue; } r -= I_D;
            if (r < I_D) { transpose_item<0>(a.ffn_w_down + (size_t)DFF * D, DFF, D, Wd_t1, scr, r, lane); continue; } r -= I_D;
            if (r < I_IN) { transpose_item<0>(a.attn_w_qkv, D, 3 * D, Wqkv_t, scr, r, lane); continue; } r -= I_IN;
            transpose_item<0>(a.attn_w_o, D, D, Wo_t, scr, r, lane);
        }
        for (int m = gw; m < M; m += NGW) { const float* xr = m < MP ? a.x_prompt + (size_t)m * D : a.x_sample + (size_t)(m - MP) * D; norm_row(xr, a.norm_mix_pre, XN + (size_t)m * D, lane); }
    }
    xcd_barrier(bar);
    DERIVE(); tid = threadIdx.x; asm volatile("" : "+v"(tid)); lane = tid & 63;
    { pg8::Gemm g{XN, Win_t, M, 3 * D, D, D}; pg8::StaticOrder S; S.init(M, 3 * D, G, (int)blockIdx.x); pg8::EpiConvIn E{BA, BB};
      pg8::gemm_phase<pg8::EpiConvIn, pg8::StaticOrder, true, true>(lds, g, S, E); }
    xcd_barrier(bar);
    DERIVE(); tid = threadIdx.x; asm volatile("" : "+v"(tid)); lane = tid & 63;
    {
        const f32x4* wp = (const f32x4*)a.conv_kernel + lane;
        f32x4 w0[4], w1[4], w2[4];
#pragma unroll
        for (int j = 0; j < 4; ++j) { w0[j] = wp[64 * j]; w1[j] = wp[256 + 64 * j]; w2[j] = wp[512 + 64 * j]; }
        for (int blk = gw; blk < M / 4; blk += NGW) {
            const int m0 = blk * 4; const bool samp = m0 >= MP; const int t0 = samp ? ((m0 - MP) & 31) : (m0 & 2047); const int b = samp ? ((m0 - MP) >> 5) : (m0 >> 11); const int T = samp ? DS : SEQ;
            const u32x2* up = (const u32x2*)(BB + (size_t)m0 * D) + lane; const u32x2* bp = (const u32x2*)(BA + (size_t)m0 * D) + lane;
            u32x2 ur[6][4], br[4][4];
#pragma unroll
            for (int k = 2; k < 6; ++k)
#pragma unroll
                for (int j = 0; j < 4; ++j) { ur[k][j] = up[(k - 2) * 256 + 64 * j]; br[k - 2][j] = bp[(k - 2) * 256 + 64 * j]; }
            f32x4 h0[4], h1[4];
            if (t0 > 0) {
#pragma unroll
                for (int j = 0; j < 4; ++j) { const u32x2 a0 = up[64 * j - 512], a1 = up[64 * j - 256];
                    h0[j] = (f32x4){bflo(a0.x), bfhi(a0.x), bflo(a0.y), bfhi(a0.y)}; h1[j] = (f32x4){bflo(a1.x), bfhi(a1.x), bflo(a1.y), bfhi(a1.y)}; }
            } else if (samp) {
                const f32x4* st = (const f32x4*)(a.state_conv + (size_t)b * 2 * D) + lane;
#pragma unroll
                for (int j = 0; j < 4; ++j) { h0[j] = st[64 * j]; h1[j] = st[256 + 64 * j]; }
            } else {
#pragma unroll
                for (int j = 0; j < 4; ++j) { h0[j] = (f32x4){0.f, 0.f, 0.f, 0.f}; h1[j] = h0[j]; }
            }
            u32x2* yo = (u32x2*)(BC + (size_t)m0 * D) + lane;
            float* so = (t0 == T - 4) ? a.out + (samp ? O_CONVS : O_CONVP) + (size_t)b * 2 * D : nullptr;
#pragma unroll
            for (int j = 0; j < 4; ++j) {
                f32x4 u2 = h0[j], u1 = h1[j];
#pragma unroll
                for (int k = 0; k < 4; ++k) {
                    const u32x2 uw = ur[k + 2][j]; const f32x4 u0 = (f32x4){bflo(uw.x), bfhi(uw.x), bflo(uw.y), bfhi(uw.y)};
                    const u32x2 bw = br[k][j]; const f32x4 bg = (f32x4){bflo(bw.x), bfhi(bw.x), bflo(bw.y), bfhi(bw.y)};
                    const f32x4 y = bg * (w0[j] * u2 + w1[j] * u1 + w2[j] * u0);
                    u32x2 o; o.x = pk2(y.x, y.y); o.y = pk2(y.z, y.w); yo[k * 256 + 64 * j] = o;
                    if (so && k >= 2) *((f32x4*)(so + (size_t)(k - 2) * D) + lane + 64 * j) = u0;
                    u2 = u1; u1 = u0;
                }
            }
        }
    }
    xcd_barrier(bar);
    DERIVE(); tid = threadIdx.x; asm volatile("" : "+v"(tid)); lane = tid & 63;
    { pg8::Gemm g{BC, Wout_t, MP, D, D, D}; pg8::StaticOrder S; S.init(MP, D, G, (int)blockIdx.x); pg8::EpiBf16<0> E{MO, D, nullptr, 0, 0, 1.f};
      pg8::gemm_phase<pg8::EpiBf16<0>, pg8::StaticOrder, true, true>(lds, g, S, E); }
    { constexpr int KS = D / 4; pg8::Gemm g{BC, Wout_t, M, D, KS, D}; pg8::TailOrder S{4, KS * 2, G, (int)blockIdx.x}; pg8::EpiPartF32 E{PART, KS * 2};
      pg8::gemm_phase<pg8::EpiPartF32, pg8::TailOrder, true, true>(lds, g, S, E); }
    xcd_barrier(bar);
    DERIVE(); tid = threadIdx.x; asm volatile("" : "+v"(tid)); lane = tid & 63;
    res_pass<0, 0>(a, MO, XR, XN, Y, a.norm_mix_post, a.norm_ffn_pre, PART, 4, gw, NGW, lane);
    xcd_barrier(bar);
    DERIVE(); tid = threadIdx.x; asm volatile("" : "+v"(tid)); lane = tid & 63;
    { pg8::Gemm g{XN, Wgu_t0, M, 2 * DFF, D, D}; pg8::StaticOrder S; S.init(M, 2 * DFF, G, (int)blockIdx.x); pg8::EpiSwiGLU E{HB};
      pg8::gemm_phase<pg8::EpiSwiGLU, pg8::StaticOrder, true, true>(lds, g, S, E); }
    xcd_barrier(bar);
    DERIVE(); tid = threadIdx.x; asm volatile("" : "+v"(tid)); lane = tid & 63;
    { pg8::Gemm g{HB, Wd_t0, MP, D, DFF, DFF}; pg8::StaticOrder S; S.init(MP, D, G, (int)blockIdx.x); pg8::EpiBf16<0> E{MO, D, nullptr, 0, 0, 1.f};
      pg8::gemm_phase<pg8::EpiBf16<0>, pg8::StaticOrder, true, true>(lds, g, S, E); }
    { constexpr int KS = DFF / 11; pg8::Gemm g{HB, Wd_t0, M, D, KS, DFF}; pg8::TailOrder S{11, KS * 2, G, (int)blockIdx.x}; pg8::EpiPartF32 E{PART, KS * 2};
      pg8::gemm_phase<pg8::EpiPartF32, pg8::TailOrder, true, true>(lds, g, S, E); }
    xcd_barrier(bar);
    DERIVE(); tid = threadIdx.x; asm volatile("" : "+v"(tid)); lane = tid & 63;
    res_pass<1, 0>(a, MO, XR, XN, Y, a.norm_ffn_post, a.norm_mix_pre + D, PART, 11, gw, NGW, lane);
    xcd_barrier(bar);
    DERIVE(); tid = threadIdx.x; asm volatile("" : "+v"(tid)); lane = tid & 63;
    { pg8::Gemm g{XN, Wqkv_t, M, 3 * D, D, D}; pg8::StaticOrder S; S.init(M, 3 * D, G, (int)blockIdx.x);
      pg8::EpiBf16<0> E{BA, D, nullptr, D, (size_t)(WS_B - WS_A) / 2, QSCALE};
      pg8::gemm_phase<pg8::EpiBf16<0>, pg8::StaticOrder, true, true>(lds, g, S, E); }
    xcd_barrier(bar);
    DERIVE(); tid = threadIdx.x; asm volatile("" : "+v"(tid)); lane = tid & 63;
    {
        constexpr int NGS1 = (DB * NH) / 8, NPU1 = NB * NH * 8, NGS = NGS1 * REP_SAMPLE, NPU = NPU1 * REP_PROMPT;
        LAS unsigned char* vlds = lds + wave * 4096; LAS float* tabw = (LAS float*)(lds + 32768 + wave * 1088);
        volatile LAS int* slot = (volatile LAS int*)(lds + 65536);
        if (tid == 0) *slot = (int)atomicAdd(qctr, 1u);
        __syncthreads();
        int wi = *slot;
        __syncthreads();
        while (wi < NGS + NPU) {
            int nxt = 0;
            if (tid == 0) nxt = (int)atomicAdd(qctr, 1u);
            if (wi < NGS) {
                att::Item it;
                const int si = (wi % NGS1) * 8 + wave, b = si >> 4, hh = si & 15;
                const size_t rb = (size_t)MP + (size_t)b * DS;
                it.q = BA + rb * D + hh * HD; it.o = OB + rb * D + hh * HD;
                it.kc = nullptr; it.vc = nullptr; it.kcf = a.cache_k + (size_t)b * CROWS * D + hh * HD; it.vcf = a.cache_v + (size_t)b * CROWS * D + hh * HD; it.kn = BB + rb * D + hh * HD; it.vn = BC + rb * D + hh * HD; it.nc = CROWS / 32;
                it.kt0 = 0; it.kt1 = CROWS / 32 + 1; it.qpos0 = CROWS; it.head = hh;
                it.kso = (wi < NGS1) ? a.out + O_KS + (size_t)b * DS * D + hh * HD : nullptr; it.vso = a.out + O_VS + (size_t)b * DS * D + hh * HD;
                att::attn_item(it, vlds, tabw, a.attn_rel_bias, lane);
            } else {
                const int u = (wi - NGS) % NPU1, bh = u >> 3, cq = 7 - (u & 7);
                att::attn_unit(bh >> 4, bh & 15, cq, BA, BB, BC, OB, a.out + O_KP, a.out + O_VP, a.attn_rel_bias, lds, tid, lane, wave);
            }
            __syncthreads();
            if (tid == 0) *slot = nxt;
            __syncthreads();
            wi = *slot;
        }
    }
    xcd_barrier(bar);
    DERIVE(); tid = threadIdx.x; asm volatile("" : "+v"(tid)); lane = tid & 63;
    { pg8::Gemm g{OB, Wo_t, MP, D, D, D}; pg8::StaticOrder S; S.init(MP, D, G, (int)blockIdx.x); pg8::EpiBf16<0> E{MO, D, nullptr, 0, 0, 1.f};
      pg8::gemm_phase<pg8::EpiBf16<0>, pg8::StaticOrder, true, true>(lds, g, S, E); }
    { constexpr int KS = D / 4; pg8::Gemm g{OB, Wo_t, M, D, KS, D}; pg8::TailOrder S{4, KS * 2, G, (int)blockIdx.x}; pg8::EpiPartF32 E{PART, KS * 2};
      pg8::gemm_phase<pg8::EpiPartF32, pg8::TailOrder, true, true>(lds, g, S, E); }
    xcd_barrier(bar);
    DERIVE(); tid = threadIdx.x; asm volatile("" : "+v"(tid)); lane = tid & 63;
    res_pass<1, 0>(a, MO, XR, XN, Y, a.norm_mix_post + D, a.norm_ffn_pre + D, PART, 4, gw, NGW, lane);
    xcd_barrier(bar);
    DERIVE(); tid = threadIdx.x; asm volatile("" : "+v"(tid)); lane = tid & 63;
    { pg8::Gemm g{XN, Wgu_t1, M, 2 * DFF, D, D}; pg8::StaticOrder S; S.init(M, 2 * DFF, G, (int)blockIdx.x); pg8::EpiSwiGLU E{HB};
      pg8::gemm_phase<pg8::EpiSwiGLU, pg8::StaticOrder, true, true>(lds, g, S, E); }
    xcd_barrier(bar);
    DERIVE(); tid = threadIdx.x; asm volatile("" : "+v"(tid)); lane = tid & 63;
    { pg8::Gemm g{HB, Wd_t1, MP, D, DFF, DFF}; pg8::StaticOrder S; S.init(MP, D, G, (int)blockIdx.x); pg8::EpiBf16<0> E{MO, D, nullptr, 0, 0, 1.f};
      pg8::gemm_phase<pg8::EpiBf16<0>, pg8::StaticOrder, true, true>(lds, g, S, E); }
    { constexpr int KS = DFF / 11; pg8::Gemm g{HB, Wd_t1, M, D, KS, DFF}; pg8::TailOrder S{11, KS * 2, G, (int)blockIdx.x}; pg8::EpiPartF32 E{PART, KS * 2};
      pg8::gemm_phase<pg8::EpiPartF32, pg8::TailOrder, true, true>(lds, g, S, E); }
    xcd_barrier(bar);
    DERIVE(); tid = threadIdx.x; asm volatile("" : "+v"(tid)); lane = tid & 63;
    res_pass<1, 1>(a, MO, XR, XN, Y, a.norm_ffn_post + D, nullptr, PART, 11, gw, NGW, lane);
}

extern "C" void kernel_launch(void* const* d_in, const int* in_sizes, int n_in, void* d_out, int out_size, void* d_ws, size_t ws_size, hipStream_t stream) {
    static int grid = 0;
    if (grid == 0) {
        if (n_in != 17 || (size_t)out_size != O_END || ws_size < WS_END) { fprintf(stderr, "kernel_launch: unexpected shapes n_in %d out %d ws %zu\n", n_in, out_size, ws_size); grid = -1; return; }
        int dev = 0, cus = 0, per_cu = 0;
        hipGetDevice(&dev); hipDeviceGetAttribute(&cus, hipDeviceAttributeMultiprocessorCount, dev);
        if (hipFuncSetAttribute((const void*)fwd_kernel, hipFuncAttributeMaxDynamicSharedMemorySize, LDS_BYTES) != hipSuccess) { fprintf(stderr, "kernel_launch: hipFuncSetAttribute failed\n"); grid = -1; return; }
        if (hipOccupancyMaxActiveBlocksPerMultiprocessor(&per_cu, (const void*)fwd_kernel, NWAVES * 64, LDS_BYTES) != hipSuccess || per_cu < 1) { fprintf(stderr, "kernel_launch: occupancy query says %d\n", per_cu); per_cu = 1; }
        (void)hipGetLastError();
        grid = cus;
    }
    if (grid < 0) return;
    if (hipMemsetAsync((char*)d_ws + WS_CTL, 0, CTL_BYTES, stream) != hipSuccess) { fprintf(stderr, "kernel_launch: memset failed\n"); return; }
    Args a{};
    const float** p = (const float**)&a;
    for (int i = 0; i < 17; ++i) p[i] = (const float*)d_in[i];
    a.out = (float*)d_out; a.ws = (unsigned char*)d_ws;
    void* args[] = {&a};
    hipError_t e = hipLaunchCooperativeKernel((const void*)fwd_kernel, dim3(grid), dim3(NWAVES * 64), args, LDS_BYTES, stream);
    if (e != hipSuccess) fprintf(stderr, "cooperative launch failed: %s (grid %d)\n", hipGetErrorString(e), grid);
}
```

```cpp
#include <hip/hip_runtime.h>
#include <hip/hip_cooperative_groups.h>
#include <cstdio>
#include <cstdint>
namespace cg = cooperative_groups;
namespace pg8 {
#define PG8_LAS __attribute__((address_space(3)))
typedef unsigned short bf16_t;
typedef short bf16x8 __attribute__((ext_vector_type(8)));
typedef float f32x4 __attribute__((ext_vector_type(4)));
typedef unsigned u32x4 __attribute__((ext_vector_type(4)));
constexpr int BM = 256, BK = 64, HALF = 128, HTB = HALF * BK * 2  , STAGE_BYTES = 8 * HTB, NXCD = 8, WGM = 8;

__host__ __device__ __forceinline__ int lds_byte(int r, int c) { const int st = (r >> 4) * 2 + (c >> 5), rr = r & 15, cc = c & 31, ob = rr * 64 + cc * 2; return st * 1024 + (ob ^ (((ob >> 9) & 1) << 5)); }
__host__ __device__ __forceinline__ void stage_rc(int b, int& R, int& C) { const int st = b / 1024, sb = b % 1024, swz = sb ^ (((sb >> 9) & 1) << 5); R = (st >> 1) * 16 + swz / 64; C = (st & 1) * 32 + (swz % 64) / 2; }
__host__ __device__ __forceinline__ int perm32(int rho) { const int n = rho >> 4, i = rho & 15; return 8 * (i >> 2) + 4 * n + (i & 3); }

struct Unit { int pm, pn; int kb; };
struct Gemm { const bf16_t* A; const bf16_t* Bt; int M, N, K; int ld; };

struct StaticOrder {
    int nM, nN, nwg, G, c;
    __host__ __device__ void init(int M, int N, int G_, int c_) { nM = M / BM; nN = N / BM; nwg = nM * nN; G = G_; c = c_; }
    __host__ __device__ bool next(int i, Unit& u) const {
        const long L = (long)i * G + c; if (L >= nwg) return false;
        int wgid = (int)L; { const int q = nwg / NXCD, r = nwg % NXCD, xcd = wgid % NXCD, off = wgid / NXCD; wgid = (xcd < r ? xcd * (q + 1) : r * (q + 1) + (xcd - r) * q) + off; }
        const int nig = WGM * nN, gid = wgid / nig, fm = gid * WGM, gsz = (nM - fm) < WGM ? (nM - fm) : WGM;
        u.pm = fm + ((wgid % nig) % gsz); u.pn = (wgid % nig) / gsz; u.kb = 0; return true;
    }
    __device__ __forceinline__ void a_ready(const Unit&) const {}
    __device__ __forceinline__ void done(const Unit&) const {}
};

__device__ __forceinline__ unsigned cvt_pk_bf16(float lo, float hi) { unsigned r; asm volatile("v_cvt_pk_bf16_f32 %0, %1, %2" : "=v"(r) : "v"(lo), "v"(hi)); return r; }
typedef float f32x2 __attribute__((ext_vector_type(2)));
__device__ __forceinline__ f32x2 gelu_pk(f32x2 v) {
    const f32x2 av = __builtin_elementwise_abs(v), d = av * 0.2316418882f + 1.0f;
    f32x2 t; t.x = __builtin_amdgcn_rcpf(d.x); t.y = __builtin_amdgcn_rcpf(d.y);
    f32x2 q = t * 0.5307027145f + (-0.7265760135f); q = q * t + 0.7107068705f; q = q * t + (-0.142248368f); q = q * t + 0.127414796f; q = q * t;
    const f32x2 s = (v * v) * (-0.72134752044f);
    f32x2 e; e.x = __builtin_amdgcn_exp2f(s.x); e.y = __builtin_amdgcn_exp2f(s.y);
    const f32x2 m = v * (q * e), r = v - m;
    f32x2 o; o.x = v.x < 0.f ? m.x : r.x; o.y = v.y < 0.f ? m.y : r.y; return o;
}

template <int ACT  > struct EpiBf16 {
    static constexpr bool PERM = true, AFTER_DRAIN = false; static_assert(ACT == 0 || ACT == 1, "EpiBf16: ACT is 0 (none) or 1 (gelu_pk)");
    __device__ __forceinline__ void pre(const Unit&, int, int) const {}
    bf16_t* O; int ldc; const float* bias; int split_cols; size_t split_stride; float scale0;
    __device__ __forceinline__ void operator()(const f32x4 (&acc)[2][2][4][2], const Unit& u, int wr, int wc, int fr, int fq) const {
        const int row0 = u.pm * BM + wr * 64 + fr; int colt = u.pn * BM; bf16_t* base = O;
        float sc = 1.f; if (split_cols) { const int t = colt / split_cols; base += (size_t)t * split_stride; colt -= t * split_cols; if (t == 0) sc = scale0; }
        const int col0 = colt + wc * 32 + 8 * fq, bcol0 = u.pn * BM + wc * 32 + 8 * fq;
        f32x4 bv[2][2];
#pragma unroll
        for (int bj = 0; bj < 2; ++bj)
#pragma unroll
            for (int n = 0; n < 2; ++n) bv[bj][n] = bias ? *(const f32x4*)(bias + bcol0 + bj * HALF + 4 * n) : (f32x4){0.f, 0.f, 0.f, 0.f};
#pragma unroll
        for (int ai = 0; ai < 2; ++ai)
#pragma unroll
            for (int m = 0; m < 4; ++m) { bf16_t* rowp = base + (size_t)(row0 + ai * HALF + m * 16) * ldc + col0;
#pragma unroll
                for (int bj = 0; bj < 2; ++bj) { f32x4 v0 = acc[ai][bj][m][0] + bv[bj][0], v1 = acc[ai][bj][m][1] + bv[bj][1];
                    if (ACT == 1) { f32x2 a = gelu_pk((f32x2){v0[0], v0[1]}), b = gelu_pk((f32x2){v0[2], v0[3]}), c = gelu_pk((f32x2){v1[0], v1[1]}), d = gelu_pk((f32x2){v1[2], v1[3]});
                        v0 = (f32x4){a.x, a.y, b.x, b.y}; v1 = (f32x4){c.x, c.y, d.x, d.y}; }
                    v0 = v0 * sc; v1 = v1 * sc; u32x4 w; w.x = cvt_pk_bf16(v0[0], v0[1]); w.y = cvt_pk_bf16(v0[2], v0[3]); w.z = cvt_pk_bf16(v1[0], v1[1]); w.w = cvt_pk_bf16(v1[2], v1[3]);
                    *(u32x4*)(rowp + bj * HALF) = w; } }
    }
};
template <class Epi, class Sched, bool ALIGN_EPI = false, bool SP2 = false>
__device__ __forceinline__ void gemm_phase(PG8_LAS unsigned char* lds, const Gemm g, const Sched& S, const Epi& E) {
    int tid_ = threadIdx.x; asm volatile("" : "+v"(tid_)); const int tid = tid_, wid = __builtin_amdgcn_readfirstlane(tid >> 6), lane = tid & 63, wr = wid >> 2, wc = wid & 3, fr = lane & 15, fq = lane >> 4;
    const int K = g.ld, nt = g.K / BK;
    unsigned voffA[2], voffB[2];
#pragma unroll
    for (int i = 0; i < 2; ++i) { int R, C; stage_rc(tid * 16 + i * 8192, R, C); const int Rb = Epi::PERM ? ((R & ~31) + perm32(R & 31)) : R;
        voffA[i] = (unsigned)(R * K + C) * 2u; voffB[i] = (unsigned)(Rb * K + C) * 2u; }
    const size_t kstep = (size_t)(BK * 2);
    const size_t hstep = (size_t)HALF * K * 2;
    const size_t tstep = 2 * hstep;
    const unsigned ldsw = (unsigned)wid * 1024u;
    const int aoff = lds_byte(wr * 64 + fr, fq * 8), boff = lds_byte(wc * 32 + fr, fq * 8);
#define PG8_SA(b, h) (((b) * 2 + (h)) * HTB)
#define PG8_SB(b, h) ((4 + (b) * 2 + (h)) * HTB)
#define PG8_STAGE(bufoff, gbase, voff) do { _Pragma("unroll") for (int _i = 0; _i < 2; ++_i) \
        __builtin_amdgcn_global_load_lds((const unsigned*)((const char*)(gbase) + (voff)[_i]), (PG8_LAS unsigned*)(lds + (bufoff) + ldsw + _i * 8192), 16, 0, 0); } while (0)
#define PG8_LDA(dst, b, h) do { _Pragma("unroll") for (int m = 0; m < 4; ++m) _Pragma("unroll") for (int k = 0; k < 2; ++k) dst[m][k] = *(const PG8_LAS bf16x8*)(lds + PG8_SA(b, h) + aoff + m * 2048 + k * 1024); } while (0)
#define PG8_LDB(dst, b, h) do { _Pragma("unroll") for (int n = 0; n < 2; ++n) _Pragma("unroll") for (int k = 0; k < 2; ++k) dst[n][k] = *(const PG8_LAS bf16x8*)(lds + PG8_SB(b, h) + boff + n * 2048 + k * 1024); } while (0)
#define PG8_MMA(ai, bj, At, Bt) do { __builtin_amdgcn_s_setprio(1); _Pragma("unroll") for (int m = 0; m < 4; ++m) _Pragma("unroll") for (int n = 0; n < 2; ++n) _Pragma("unroll") for (int k = 0; k < 2; ++k) \
        acc[ai][bj][m][n] = __builtin_amdgcn_mfma_f32_16x16x32_bf16(Bt[n][k], At[m][k], acc[ai][bj][m][n], 0, 0, 0); __builtin_amdgcn_s_setprio(0); } while (0)
#define PG8_WAIT_V(n) asm volatile("s_waitcnt vmcnt(" #n ")" ::: "memory")
#define PG8_WAIT_L(n) asm volatile("s_waitcnt lgkmcnt(" #n ")" ::: "memory")
#define PG8_BAR __builtin_amdgcn_s_barrier()
#define PG8_SCHED __builtin_amdgcn_sched_barrier(0)
    Unit cur, nxt; int ui = 0;
    if (!S.next(0, cur)) return;
    f32x4 acc[2][2][4][2];
#pragma unroll
    for (int a = 0; a < 2; ++a)
#pragma unroll
        for (int b = 0; b < 2; ++b)
#pragma unroll
            for (int m = 0; m < 4; ++m)
#pragma unroll
                for (int n = 0; n < 2; ++n) acc[a][b][m][n] = (f32x4){0.f, 0.f, 0.f, 0.f};
    bf16x8 At[4][2], B0[2][2], B1[2][2];
    const char* cA = (const char*)g.A + (size_t)cur.pm * tstep + cur.kb; const char* cB = (const char*)g.Bt + (size_t)cur.pn * tstep + cur.kb;
    S.a_ready(cur);
    if constexpr (SP2) {
        PG8_STAGE(PG8_SB(0, 0), cB, voffB); PG8_STAGE(PG8_SB(0, 1), cB + hstep, voffB); PG8_STAGE(PG8_SA(0, 0), cA, voffA); PG8_STAGE(PG8_SA(0, 1), cA + hstep, voffA);
        if (wr == 1) PG8_BAR;
        PG8_WAIT_V(2); PG8_BAR;
        PG8_STAGE(PG8_SB(1, 0), cB + kstep, voffB); PG8_STAGE(PG8_SA(1, 0), cA + kstep, voffA); PG8_STAGE(PG8_SB(1, 1), cB + hstep + kstep, voffB);
        PG8_WAIT_V(6); PG8_BAR;
    } else {
        PG8_STAGE(PG8_SB(0, 0), cB, voffB); PG8_STAGE(PG8_SA(0, 0), cA, voffA); PG8_STAGE(PG8_SB(0, 1), cB + hstep, voffB); PG8_STAGE(PG8_SA(0, 1), cA + hstep, voffA);
        if (wr == 1) PG8_BAR;
        PG8_WAIT_V(4); PG8_BAR;
        PG8_STAGE(PG8_SB(1, 0), cB + kstep, voffB); PG8_STAGE(PG8_SA(1, 0), cA + kstep, voffA); PG8_STAGE(PG8_SB(1, 1), cB + hstep + kstep, voffB);
        PG8_WAIT_V(6); PG8_BAR;
    }
    for (;;) {
        const bool has_next = S.next(ui + 1, nxt);
        const char* nA = has_next ? (const char*)g.A + (size_t)nxt.pm * tstep + nxt.kb : cA; const char* nB = has_next ? (const char*)g.Bt + (size_t)nxt.pn * tstep + nxt.kb : cB;
        for (int t = 0; t < nt; t += 2) {
            const bool last = (t == nt - 2);
            const char* a1 = cA + (size_t)(t + 1) * kstep;
            const char* a2 = last ? nA : cA + (size_t)(t + 2) * kstep; const char* b2 = last ? nB : cB + (size_t)(t + 2) * kstep;
            const char* a3 = a2 + kstep; const char* b3 = b2 + kstep;
            if (last) E.pre(cur, wr, fr);
            if (last && has_next) S.a_ready(nxt);
            if constexpr (SP2) {
            PG8_LDB(B0, 0, 0); PG8_LDB(B1, 0, 1); PG8_SCHED; PG8_LDA(At, 0, 0); PG8_STAGE(PG8_SA(1, 1), a1 + hstep, voffA);
            PG8_WAIT_V(8); PG8_WAIT_L(0); PG8_BAR; PG8_MMA(0, 0, At, B0); PG8_MMA(0, 1, At, B1); PG8_BAR; PG8_SCHED;
            PG8_LDA(At, 0, 1); PG8_STAGE(PG8_SB(0, 0), b2, voffB); PG8_STAGE(PG8_SB(0, 1), b2 + hstep, voffB); PG8_STAGE(PG8_SA(0, 0), a2, voffA);
            PG8_WAIT_V(8); PG8_WAIT_L(0); PG8_BAR; PG8_MMA(1, 0, At, B0); PG8_MMA(1, 1, At, B1); PG8_BAR; PG8_SCHED;
            PG8_LDB(B0, 1, 0); PG8_LDB(B1, 1, 1); PG8_SCHED; PG8_LDA(At, 1, 0); PG8_STAGE(PG8_SA(0, 1), a2 + hstep, voffA);
            PG8_WAIT_V(8); PG8_WAIT_L(0); PG8_BAR; PG8_MMA(0, 0, At, B0); PG8_MMA(0, 1, At, B1); PG8_BAR; PG8_SCHED;
            PG8_LDA(At, 1, 1); PG8_STAGE(PG8_SB(1, 0), b3, voffB); PG8_STAGE(PG8_SB(1, 1), b3 + hstep, voffB); PG8_STAGE(PG8_SA(1, 0), a3, voffA);
            PG8_WAIT_V(8); PG8_WAIT_L(0); PG8_BAR; PG8_MMA(1, 0, At, B0); PG8_MMA(1, 1, At, B1); PG8_BAR; PG8_SCHED;
            } else {
            PG8_LDB(B0, 0, 0); PG8_SCHED; PG8_LDA(At, 0, 0); PG8_STAGE(PG8_SA(1, 1), a1 + hstep, voffA);
            PG8_WAIT_L(8); PG8_BAR; PG8_WAIT_L(0); PG8_MMA(0, 0, At, B0); PG8_BAR; PG8_SCHED;
            PG8_LDB(B1, 0, 1); PG8_STAGE(PG8_SB(0, 0), b2, voffB);
            PG8_BAR; PG8_WAIT_L(0); PG8_MMA(0, 1, At, B1); PG8_BAR;
            PG8_LDA(At, 0, 1); PG8_STAGE(PG8_SA(0, 0), a2, voffA);
            PG8_BAR; PG8_WAIT_L(0); PG8_MMA(1, 0, At, B0); PG8_BAR; PG8_SCHED;
            PG8_STAGE(PG8_SB(0, 1), b2 + hstep, voffB);
            PG8_WAIT_V(6); PG8_BAR; PG8_MMA(1, 1, At, B1); PG8_BAR;
            PG8_LDB(B0, 1, 0); PG8_SCHED; PG8_LDA(At, 1, 0); PG8_STAGE(PG8_SA(0, 1), a2 + hstep, voffA);
            PG8_WAIT_L(8); PG8_BAR; PG8_WAIT_L(0); PG8_MMA(0, 0, At, B0); PG8_BAR; PG8_SCHED;
            PG8_LDB(B1, 1, 1); PG8_STAGE(PG8_SB(1, 0), b3, voffB);
            PG8_BAR; PG8_WAIT_L(0); PG8_MMA(0, 1, At, B1); PG8_BAR;
            PG8_LDA(At, 1, 1); PG8_STAGE(PG8_SA(1, 0), a3, voffA);
            PG8_BAR; PG8_WAIT_L(0); PG8_MMA(1, 0, At, B0); PG8_BAR; PG8_SCHED;
            PG8_STAGE(PG8_SB(1, 1), b3 + hstep, voffB);
            PG8_WAIT_V(6); PG8_BAR; PG8_MMA(1, 1, At, B1); PG8_BAR;
            }
        }
        if constexpr (ALIGN_EPI) { if (wr == 0) PG8_BAR; }
        if constexpr (!Epi::AFTER_DRAIN) { E(acc, cur, wr, wc, fr, fq); S.done(cur); }
        if (!has_next) break;
#pragma unroll
        for (int a = 0; a < 2; ++a)
#pragma unroll
            for (int b = 0; b < 2; ++b)
#pragma unroll
                for (int m = 0; m < 4; ++m)
#pragma unroll
                    for (int n = 0; n < 2; ++n) acc[a][b][m][n] = (f32x4){0.f, 0.f, 0.f, 0.f};
        cur = nxt; cA = nA; cB = nB; ++ui;
        if constexpr (ALIGN_EPI) { if (wr == 1) PG8_BAR; }
    }
    PG8_WAIT_V(0);
    if constexpr (!ALIGN_EPI) { if (wr == 0) PG8_BAR; }
    PG8_BAR;
    if constexpr (Epi::AFTER_DRAIN) { E.fused(acc, cur, wr, wc, fr, fq, lds, wid, lane); S.done(cur); }
#undef PG8_SA
#undef PG8_SB
#undef PG8_STAGE
#undef PG8_LDA
#undef PG8_LDB
#undef PG8_MMA
#undef PG8_WAIT_V
#undef PG8_WAIT_L
#undef PG8_BAR
#undef PG8_SCHED
}
}

#define LAS __attribute__((address_space(3)))
typedef unsigned short bf16_t;
typedef unsigned u32x4 __attribute__((ext_vector_type(4)));
typedef unsigned u32x2 __attribute__((ext_vector_type(2)));
typedef float f32x4 __attribute__((ext_vector_type(4)));
typedef float f32x16 __attribute__((ext_vector_type(16)));
typedef short bf16x8 __attribute__((ext_vector_type(8)));
typedef short s16x4 __attribute__((ext_vector_type(4)));

constexpr int D = 1024, NB = 32, SEQ = 2048, DB = 32, DS = 32, NH = 16, HD = 64, DFF = 2816;
constexpr int MP = NB * SEQ;
constexpr int MS = DB * DS;
constexpr int M = MP + MS;
constexpr int CROWS = 512;
constexpr float EPS = 1e-6f;
constexpr float LOG2E = 1.4426950408889634f;
constexpr float QSCALE = 0.125f * LOG2E;
constexpr int NWAVES = 8;
#ifndef REP_KVOUT
#define REP_KVOUT 1
#endif
#ifndef REP_SAMPLE
#define REP_SAMPLE 1
#endif
#ifndef REP_PROMPT
#define REP_PROMPT 1
#endif

constexpr size_t O_Y = 0;
constexpr size_t O_CONVP = (size_t)M * D;
constexpr size_t O_CONVS = O_CONVP + 65536;
constexpr size_t O_KP = O_CONVS + 65536;
constexpr size_t O_VP = O_KP + (size_t)NB * CROWS * D;
constexpr size_t O_KS = O_VP + (size_t)NB * CROWS * D;
constexpr size_t O_VS = O_KS + (size_t)MS * D;
constexpr size_t O_END = O_VS + (size_t)MS * D;

constexpr size_t MiB = 1u << 20;
constexpr size_t WS_WIN = 0, WS_WOUT = 6 * MiB, WS_WGU0 = 8 * MiB, WS_WGU1 = 19 * MiB, WS_WD0 = 30 * MiB, WS_WD1 = 30 * MiB + 5632 * 1024,
                 WS_WQKV = 41 * MiB, WS_WO = 47 * MiB, WS_PART = 50 * MiB  , WS_CTL = 120 * MiB;
constexpr size_t WS_XN = 128 * MiB, WS_A = 258 * MiB, WS_B = 388 * MiB, WS_C = 518 * MiB, WS_MO = 648 * MiB, WS_O = 128 * MiB  , WS_XR = 778 * MiB, WS_END = 908 * MiB;

constexpr int LDS_BYTES = 131072 + 8192, MISC_OFF = 131072 + 4096, CW_BAR = 4096  , CTL_BYTES = 65536;

__device__ __forceinline__ float bf2f(unsigned short b) { return __uint_as_float(((unsigned)b) << 16); }
__device__ __forceinline__ float bflo(unsigned w) { return __uint_as_float(w << 16); }
__device__ __forceinline__ float bfhi(unsigned w) { return __uint_as_float(w & 0xffff0000u); }
__device__ __forceinline__ unsigned pk2(float lo, float hi) { return pg8::cvt_pk_bf16(lo, hi); }
__device__ __forceinline__ float wave_sum(float v) {
#pragma unroll
    for (int o = 1; o < 64; o <<= 1) v += __shfl_xor(v, o);
    return v;
}

namespace pg8 {
struct EpiConvIn {
    static constexpr bool PERM = true, AFTER_DRAIN = false;
    bf16_t* Bg; bf16_t* U; const float* inv; mutable float rs[8];
    __device__ __forceinline__ void pre(const Unit& u, int wr, int fr) const {
#pragma unroll
        for (int i = 0; i < 8; ++i) rs[i] = inv[u.pm * BM + (i >> 2) * HALF + wr * 64 + (i & 3) * 16 + fr]; }
    __device__ __forceinline__ void operator()(const f32x4 (&acc)[2][2][4][2], const Unit& u, int wr, int wc, int fr, int fq) const {
        const int row0 = u.pm * BM + wr * 64 + fr;
        if (u.pn < 4) {
            const int col0 = u.pn * BM + wc * 32 + 8 * fq;
#pragma unroll
            for (int ai = 0; ai < 2; ++ai)
#pragma unroll
                for (int m = 0; m < 4; ++m) { bf16_t* rowp = Bg + (size_t)(row0 + ai * HALF + m * 16) * 1024 + col0;
#pragma unroll
                    for (int bj = 0; bj < 2; ++bj) { const float r1 = rs[ai * 4 + m]; const f32x4 v0 = acc[ai][bj][m][0] * r1, v1 = acc[ai][bj][m][1] * r1;
                        u32x4 w; w.x = cvt_pk_bf16(v0[0], v0[1]); w.y = cvt_pk_bf16(v0[2], v0[3]); w.z = cvt_pk_bf16(v1[0], v1[1]); w.w = cvt_pk_bf16(v1[2], v1[3]);
                        *(u32x4*)(rowp + bj * HALF) = w; } }
        } else {
            const int col0 = (u.pn - 4) * HALF + wc * 32 + 8 * fq;
#pragma unroll
            for (int ai = 0; ai < 2; ++ai)
#pragma unroll
                for (int m = 0; m < 4; ++m) { bf16_t* rowp = U + (size_t)(row0 + ai * HALF + m * 16) * 1024 + col0;
                    const float r2 = rs[ai * 4 + m] * rs[ai * 4 + m]; const f32x4 v0 = acc[ai][0][m][0] * acc[ai][1][m][0] * r2, v1 = acc[ai][0][m][1] * acc[ai][1][m][1] * r2;
                    u32x4 w; w.x = cvt_pk_bf16(v0[0], v0[1]); w.y = cvt_pk_bf16(v0[2], v0[3]); w.z = cvt_pk_bf16(v1[0], v1[1]); w.w = cvt_pk_bf16(v1[2], v1[3]);
                    *(u32x4*)(rowp) = w; }
        }
    }
};
struct EpiSwiGLU {
    static constexpr bool PERM = true, AFTER_DRAIN = false;
    bf16_t* H; const float* inv; mutable float rs[8];
    __device__ __forceinline__ void pre(const Unit& u, int wr, int fr) const {
#pragma unroll
        for (int i = 0; i < 8; ++i) rs[i] = inv[u.pm * BM + (i >> 2) * HALF + wr * 64 + (i & 3) * 16 + fr]; }
    __device__ __forceinline__ float act(float g, float uu) const { return g * uu * __builtin_amdgcn_rcpf(1.0f + __builtin_amdgcn_exp2f(-1.4426950408889634f * g)); }
    __device__ __forceinline__ void operator()(const f32x4 (&acc)[2][2][4][2], const Unit& u, int wr, int wc, int fr, int fq) const {
        const int row0 = u.pm * BM + wr * 64 + fr;
        const int col0 = u.pn * HALF + wc * 32 + 8 * fq;
#pragma unroll
        for (int ai = 0; ai < 2; ++ai)
#pragma unroll
            for (int m = 0; m < 4; ++m) { bf16_t* rowp = H + (size_t)(row0 + ai * HALF + m * 16) * 2816 + col0;
                const float r1 = rs[ai * 4 + m]; const f32x4 g0 = acc[ai][0][m][0] * r1, g1 = acc[ai][0][m][1] * r1, u0 = acc[ai][1][m][0] * r1, u1 = acc[ai][1][m][1] * r1;
                u32x4 w; w.x = cvt_pk_bf16(act(g0[0], u0[0]), act(g0[1], u0[1])); w.y = cvt_pk_bf16(act(g0[2], u0[2]), act(g0[3], u0[3]));
                w.z = cvt_pk_bf16(act(g1[0], u1[0]), act(g1[1], u1[1])); w.w = cvt_pk_bf16(act(g1[2], u1[2]), act(g1[3], u1[3]));
                *(u32x4*)(rowp) = w; }
    }
};
struct EpiQKVs {
    static constexpr bool PERM = true, AFTER_DRAIN = false;
    bf16_t* O; size_t split_stride; const float* inv; float qscale; mutable float rs[8];
    __device__ __forceinline__ void pre(const Unit& u, int wr, int fr) const {
#pragma unroll
        for (int i = 0; i < 8; ++i) rs[i] = inv[u.pm * BM + (i >> 2) * HALF + wr * 64 + (i & 3) * 16 + fr]; }
    __device__ __forceinline__ void operator()(const f32x4 (&acc)[2][2][4][2], const Unit& u, int wr, int wc, int fr, int fq) const {
        const int t = u.pn >> 2; bf16_t* base = O + (size_t)t * split_stride; const float sc = t == 0 ? qscale : 1.f;
        const int row0 = u.pm * BM + wr * 64 + fr, col0 = (u.pn & 3) * BM + wc * 32 + 8 * fq;
#pragma unroll
        for (int ai = 0; ai < 2; ++ai)
#pragma unroll
            for (int m = 0; m < 4; ++m) { bf16_t* rowp = base + (size_t)(row0 + ai * HALF + m * 16) * 1024 + col0; const float r1 = rs[ai * 4 + m] * sc;
#pragma unroll
                for (int bj = 0; bj < 2; ++bj) { const f32x4 v0 = acc[ai][bj][m][0] * r1, v1 = acc[ai][bj][m][1] * r1;
                    u32x4 w; w.x = cvt_pk_bf16(v0[0], v0[1]); w.y = cvt_pk_bf16(v0[2], v0[3]); w.z = cvt_pk_bf16(v1[0], v1[1]); w.w = cvt_pk_bf16(v1[2], v1[3]);
                    *(u32x4*)(rowp + bj * HALF) = w; } }
    }
};
struct TailOrder {
    int nsplit, ksub_bytes, G, c;
    __device__ __forceinline__ bool next(int i, Unit& u) const { const int L = i * G + c; if (L >= 16 * nsplit) return false; const int ks = L >> 4, t = L & 15; u.pm = 256 + (t & 3); u.pn = t >> 2; u.kb = ks * ksub_bytes; return true; }
    __device__ __forceinline__ void a_ready(const Unit&) const {}
    __device__ __forceinline__ void done(const Unit&) const {}
};
struct EpiPartF32 {
    static constexpr bool PERM = false, AFTER_DRAIN = false;
    float* P; int ksub_bytes;
    __device__ __forceinline__ void pre(const Unit&, int, int) const {}
    __device__ __forceinline__ void operator()(const f32x4 (&acc)[2][2][4][2], const Unit& u, int wr, int wc, int fr, int fq) const {
        const int ks = u.kb / ksub_bytes; const int row0 = (u.pm - 256) * BM + wr * 64 + fr, col0 = u.pn * BM + wc * 32 + 4 * fq;
        float* base = P + (size_t)ks * 1024 * 1024;
#pragma unroll
        for (int ai = 0; ai < 2; ++ai)
#pragma unroll
            for (int m = 0; m < 4; ++m) { float* rowp = base + (size_t)(row0 + ai * HALF + m * 16) * 1024 + col0;
#pragma unroll
                for (int bj = 0; bj < 2; ++bj)
#pragma unroll
                    for (int n = 0; n < 2; ++n) *(f32x4*)(rowp + bj * HALF + n * 16) = acc[ai][bj][m][n]; }
    }
};
}

struct Args {
    const float *x_prompt, *x_sample, *state_conv, *cache_k, *cache_v, *conv_w_in, *conv_kernel, *conv_w_out, *attn_w_qkv, *attn_w_o, *attn_rel_bias,
        *norm_mix_pre, *norm_mix_post, *norm_ffn_pre, *norm_ffn_post, *ffn_w_gate_up, *ffn_w_down;
    float* out; unsigned char* ws;
};

template <int MODE> __device__ __forceinline__ int dest_row(int n) {
    if (MODE == 1) { const int hh = n / DFF, rem = n - hh * DFF; return ((rem >> 7) << 8) + (hh << 7) + (rem & 127); }
    if (MODE == 2) { if (n < 1024) return n; const int np = n - 1024, hh = np >> 10, rem = np & 1023; return 1024 + ((rem >> 7) << 8) + (hh << 7) + (rem & 127); }
    return n;
}
template <int MODE> __device__ __forceinline__ void transpose_item(const float* W, int K, int N, bf16_t* WT, LAS float* scr, int item, int lane, const float* gk) {
    const int nblk = N / 32, kb = item / nblk, nb = item % nblk, k0 = 64 * kb, n0 = 32 * nb;
#pragma unroll 8
    for (int i = 0; i < 32; ++i) { const int kk = 2 * i + (lane >> 5); scr[kk * 33 + (lane & 31)] = W[(size_t)(k0 + kk) * N + n0 + (lane & 31)]; }
    asm volatile("s_waitcnt lgkmcnt(0)" ::: "memory");
    const int c = lane & 7; const int drow = dest_row<MODE>(n0);
    f32x4 ga = (f32x4){1.f, 1.f, 1.f, 1.f}, gb = ga;
    if (gk) { ga = *(const f32x4*)(gk + k0 + 8 * c); gb = *(const f32x4*)(gk + k0 + 8 * c + 4); }
#pragma unroll
    for (int j = 0; j < 4; ++j) { const int n = (lane >> 3) + 8 * j; const LAS float* s = scr + (8 * c) * 33 + n;
        u32x4 o; o.x = pk2(s[0 * 33] * ga.x, s[1 * 33] * ga.y); o.y = pk2(s[2 * 33] * ga.z, s[3 * 33] * ga.w); o.z = pk2(s[4 * 33] * gb.x, s[5 * 33] * gb.y); o.w = pk2(s[6 * 33] * gb.z, s[7 * 33] * gb.w);
        *(u32x4*)(WT + (size_t)(drow + n) * K + k0 + 8 * c) = o; }
    asm volatile("s_waitcnt lgkmcnt(0)" ::: "memory");
}

__device__ __forceinline__ void norm_row(const float* xrow, bf16_t* orow, float* invp, int lane) {
    const f32x4* xr = (const f32x4*)xrow + lane;
    f32x4 v[4]; float s = 0.f;
#pragma unroll
    for (int j = 0; j < 4; ++j) { v[j] = xr[64 * j]; s += (v[j].x * v[j].x + v[j].y * v[j].y) + (v[j].z * v[j].z + v[j].w * v[j].w); }
    u32x2* o8 = (u32x2*)orow + lane;
#pragma unroll
    for (int j = 0; j < 4; ++j) { u32x2 w; w.x = pk2(v[j].x, v[j].y); w.y = pk2(v[j].z, v[j].w); o8[64 * j] = w; }
    const float inv = 1.0f / sqrtf(wave_sum(s) * (1.f / D) + EPS);
    if (lane == 0) *invp = inv;
}
template <int XIN> struct ResRaw { u32x2 m[2][4]; f32x4 xf[2][4]; u32x2 xb[2][4]; };
template <int XIN> __device__ __forceinline__ void res_load(ResRaw<XIN>& R, const Args& a, const bf16_t* MO, const bf16_t* XR, const float* part, int nsplit, int m0, int NGW, int lane) {
#pragma unroll
    for (int k = 0; k < 2; ++k) {
        const int m = (k == 0) ? m0 : ((m0 + NGW < M) ? m0 + NGW : m0);
        if (m >= MP) {
            const f32x4* pp = (const f32x4*)(part + (size_t)(m - MP) * D) + lane;
#pragma unroll
            for (int j = 0; j < 4; ++j) { f32x4 sacc = pp[64 * j];
                for (int ks = 1; ks < nsplit; ++ks) sacc = sacc + pp[(size_t)ks * 262144 + 64 * j];
                u32x2 w; w.x = pk2(sacc.x, sacc.y); w.y = pk2(sacc.z, sacc.w); R.m[k][j] = w; }
        } else {
            const u32x2* mr = (const u32x2*)(MO + (size_t)m * D) + lane;
#pragma unroll
            for (int j = 0; j < 4; ++j) R.m[k][j] = mr[64 * j];
        }
        if (XIN == 0) { const float* xr = m < MP ? a.x_prompt + (size_t)m * D : a.x_sample + (size_t)(m - MP) * D;
#pragma unroll
            for (int j = 0; j < 4; ++j) R.xf[k][j] = ((const f32x4*)xr + lane)[64 * j];
        } else { const u32x2* xr = (const u32x2*)(XR + (size_t)m * D) + lane;
#pragma unroll
            for (int j = 0; j < 4; ++j) R.xb[k][j] = xr[64 * j]; }
    }
}
template <int XIN, int XOUT> __device__ __forceinline__ void res_pass(const Args& a, const bf16_t* MO, bf16_t* XR, float* INV, float* Y, const float* gp, const float* part, int nsplit, int gw, int NGW, int lane) {
    const f32x4* gr = (const f32x4*)gp + lane;
    ResRaw<XIN> nx;
    if (gw < M) res_load<XIN>(nx, a, MO, XR, part, nsplit, gw, NGW, lane);
    for (int m0 = gw; m0 < M; m0 += 2 * NGW) {
        int mm[2]; mm[0] = m0; mm[1] = (m0 + NGW < M) ? m0 + NGW : m0;
        const ResRaw<XIN> cur = nx;
        if (m0 + 2 * NGW < M) res_load<XIN>(nx, a, MO, XR, part, nsplit, m0 + 2 * NGW, NGW, lane);
        f32x4 mv[2][4], xv[2][4]; float s[2] = {0.f, 0.f};
#pragma unroll
        for (int k = 0; k < 2; ++k)
#pragma unroll
            for (int j = 0; j < 4; ++j) { const u32x2 w = cur.m[k][j]; mv[k][j] = (f32x4){bflo(w.x), bfhi(w.x), bflo(w.y), bfhi(w.y)};
                if (XIN == 0) xv[k][j] = cur.xf[k][j]; else { const u32x2 x = cur.xb[k][j]; xv[k][j] = (f32x4){bflo(x.x), bfhi(x.x), bflo(x.y), bfhi(x.y)}; }
                s[k] += (mv[k][j].x * mv[k][j].x + mv[k][j].y * mv[k][j].y) + (mv[k][j].z * mv[k][j].z + mv[k][j].w * mv[k][j].w); }
        float inv[2], s2[2] = {0.f, 0.f};
#pragma unroll
        for (int k = 0; k < 2; ++k) inv[k] = 1.0f / sqrtf(wave_sum(s[k]) * (1.f / D) + EPS);
#pragma unroll
        for (int k = 0; k < 2; ++k)
#pragma unroll
            for (int j = 0; j < 4; ++j) { const f32x4 gg = gr[64 * j]; xv[k][j] = xv[k][j] + mv[k][j] * inv[k] * gg;
                s2[k] += (xv[k][j].x * xv[k][j].x + xv[k][j].y * xv[k][j].y) + (xv[k][j].z * xv[k][j].z + xv[k][j].w * xv[k][j].w); }
        if (XOUT == 1) {
#pragma unroll
            for (int k = 0; k < 2; ++k) { f32x4* xo = (f32x4*)(Y + (size_t)mm[k] * D) + lane;
#pragma unroll
                for (int j = 0; j < 4; ++j) xo[64 * j] = xv[k][j]; }
        } else {
#pragma unroll
            for (int k = 0; k < 2; ++k) {
                const float inv2 = 1.0f / sqrtf(wave_sum(s2[k]) * (1.f / D) + EPS);
                u32x2* xo = (u32x2*)(XR + (size_t)mm[k] * D) + lane;
#pragma unroll
                for (int j = 0; j < 4; ++j) { const f32x4 x = xv[k][j]; u32x2 wx; wx.x = pk2(x.x, x.y); wx.y = pk2(x.z, x.w); xo[64 * j] = wx; }
                if (lane == 0) INV[mm[k]] = inv2;
            }
        }
    }
}

namespace att {
__device__ __forceinline__ int crow(int i, int h) { return (i & 3) + 8 * (i >> 2) + 4 * h; }
typedef short v4i16_t __attribute__((ext_vector_type(4)));
__device__ __forceinline__ s16x4 vtr(const LAS unsigned char* p) { return __builtin_bit_cast(s16x4, __builtin_amdgcn_ds_read_tr16_b64_v4i16((LAS v4i16_t*)p)); }
struct Item { const bf16_t* q; const bf16_t* kc; const bf16_t* vc; const bf16_t* kn; const bf16_t* vn; bf16_t* o; float* kso; float* vso; const float* kcf; const float* vcf; int nc, kt0, kt1, qpos0, head; };

__device__ __forceinline__ void load_tile(const Item& it, int kt, int lane, bf16x8 (&kf)[4], u32x4 (&vr)[4]) {
    const int r = lane & 31, h = lane >> 5;
    if (it.kcf && kt < it.nc) {
        const float* kp = it.kcf + (size_t)kt * 32 * 1024 + (size_t)r * 1024 + 8 * h; const float* vp = it.vcf + (size_t)kt * 32 * 1024 + (size_t)(lane >> 3) * 1024 + (lane & 7) * 8;
#pragma unroll
        for (int s = 0; s < 4; ++s) { const f32x4 a = *(const f32x4*)(kp + 16 * s), b = *(const f32x4*)(kp + 16 * s + 4);
            u32x4 w; w.x = pk2(a.x, a.y); w.y = pk2(a.z, a.w); w.z = pk2(b.x, b.y); w.w = pk2(b.z, b.w); kf[s] = __builtin_bit_cast(bf16x8, w); }
#pragma unroll
        for (int i = 0; i < 4; ++i) { const f32x4 a = *(const f32x4*)(vp + (size_t)8 * i * 1024), b = *(const f32x4*)(vp + (size_t)8 * i * 1024 + 4);
            u32x4 w; w.x = pk2(a.x, a.y); w.y = pk2(a.z, a.w); w.z = pk2(b.x, b.y); w.w = pk2(b.z, b.w); vr[i] = w; }
        return;
    }
    const bf16_t* kp = it.kn + (size_t)(kt - it.nc) * 32 * 1024;
    const bf16_t* vp = it.vn + (size_t)(kt - it.nc) * 32 * 1024;
#pragma unroll
    for (int s = 0; s < 4; ++s) kf[s] = *(const bf16x8*)(kp + (size_t)r * 1024 + 16 * s + 8 * h);
#pragma unroll
    for (int i = 0; i < 4; ++i) vr[i] = *(const u32x4*)(vp + (size_t)((lane >> 3) + 8 * i) * 1024 + (lane & 7) * 8);
}

__device__ __forceinline__ void attn_item(const Item& it, LAS unsigned char* vlds, LAS float* tab, const float* table, int lane) {
    const int r = lane & 31, h = lane >> 5;
    asm volatile("s_waitcnt lgkmcnt(0)" ::: "memory");
    for (int i = lane; i < 257; i += 64) tab[i] = table[it.head * 257 + i] * LOG2E;
    bf16x8 qf[4];
#pragma unroll
    for (int s = 0; s < 4; ++s) qf[s] = *(const bf16x8*)(it.q + (size_t)r * 1024 + 16 * s + 8 * h);
    f32x16 o0, o1;
#pragma unroll
    for (int i = 0; i < 16; ++i) { o0[i] = 0.f; o1[i] = 0.f; }
    float mrun = -1e30f, lrun = 0.f;
    asm volatile("s_waitcnt lgkmcnt(0)" ::: "memory");
    const float cfar = tab[256];
    const int qpos = it.qpos0 + r;
    const int i16 = lane & 15, q4 = i16 >> 2, p4 = i16 & 3, g = (lane >> 4) & 1;
    const LAS unsigned char* trbase = vlds + (4 * h + q4) * 128 + (16 * g + 4 * p4) * 2;
    bf16x8 kf[4]; u32x4 vr[4];
    load_tile(it, it.kt0, lane, kf, vr);
    for (int kt = it.kt0; kt < it.kt1; ++kt) {
        bf16x8 kn_[4]; u32x4 vn_[4];
        if (kt + 1 < it.kt1) load_tile(it, kt + 1, lane, kn_, vn_);
        else {
#pragma unroll
            for (int s = 0; s < 4; ++s) { kn_[s] = kf[s]; vn_[s] = vr[s]; }
        }
        asm volatile("s_waitcnt lgkmcnt(0)" ::: "memory");
#pragma unroll
        for (int i = 0; i < 4; ++i) *(LAS u32x4*)(vlds + ((lane >> 3) + 8 * i) * 128 + (lane & 7) * 16) = vr[i];
        f32x16 p;
#pragma unroll
        for (int i = 0; i < 16; ++i) p[i] = 0.f;
#pragma unroll
        for (int s = 0; s < 4; ++s) p = __builtin_amdgcn_mfma_f32_32x32x16_bf16(kf[s], qf[s], p, 0, 0, 0);
        const int kb = 32 * kt;
        if (it.qpos0 - (kb + 31) >= 128) {
#pragma unroll
            for (int i = 0; i < 16; ++i) p[i] += cfar;
        } else {
#pragma unroll
            for (int i = 0; i < 16; ++i) { int dd = qpos - (kb + crow(i, h)); dd = dd < -128 ? -128 : (dd > 128 ? 128 : dd); p[i] += tab[dd + 128]; }
        }
        float tm = p[0];
#pragma unroll
        for (int i = 1; i < 16; ++i) tm = fmaxf(tm, p[i]);
        tm = fmaxf(tm, __shfl_xor(tm, 32));
        const float mnew = fmaxf(mrun, tm);
        const float sc = __builtin_amdgcn_exp2f(mrun - mnew);
        mrun = mnew;
        float ps = 0.f;
#pragma unroll
        for (int i = 0; i < 16; ++i) { p[i] = __builtin_amdgcn_exp2f(p[i] - mnew); ps += p[i]; }
        lrun = lrun * sc + ps;
#pragma unroll
        for (int i = 0; i < 16; ++i) { o0[i] *= sc; o1[i] *= sc; }
        u32x4 w0, w1;
        w0.x = pk2(p[0], p[1]); w0.y = pk2(p[2], p[3]); w0.z = pk2(p[4], p[5]); w0.w = pk2(p[6], p[7]);
        w1.x = pk2(p[8], p[9]); w1.y = pk2(p[10], p[11]); w1.z = pk2(p[12], p[13]); w1.w = pk2(p[14], p[15]);
        const bf16x8 pf0 = __builtin_bit_cast(bf16x8, w0), pf1 = __builtin_bit_cast(bf16x8, w1);
        asm volatile("s_waitcnt lgkmcnt(0)" ::: "memory");
#pragma unroll
        for (int s = 0; s < 2; ++s) {
            const s16x4 a_lo = vtr(trbase + (16 * s) * 128), a_hi = vtr(trbase + (16 * s + 8) * 128);
            const s16x4 b_lo = vtr(trbase + (16 * s) * 128 + 64), b_hi = vtr(trbase + (16 * s + 8) * 128 + 64);
            const bf16x8 va = __builtin_shufflevector(a_lo, a_hi, 0, 1, 2, 3, 4, 5, 6, 7), vb = __builtin_shufflevector(b_lo, b_hi, 0, 1, 2, 3, 4, 5, 6, 7);
            o0 = __builtin_amdgcn_mfma_f32_32x32x16_bf16(va, s == 0 ? pf0 : pf1, o0, 0, 0, 0);
            o1 = __builtin_amdgcn_mfma_f32_32x32x16_bf16(vb, s == 0 ? pf0 : pf1, o1, 0, 0, 0);
        }
#pragma unroll
        for (int s = 0; s < 4; ++s) { kf[s] = kn_[s]; vr[s] = vn_[s]; }
    }
    if (it.kso) {
        load_tile(it, it.nc, lane, kf, vr);
#pragma unroll
        for (int s = 0; s < 4; ++s) { const u32x4 w = __builtin_bit_cast(u32x4, kf[s]); float* d = it.kso + (size_t)r * 1024 + 16 * s + 8 * h;
            *(f32x4*)d = (f32x4){bflo(w.x), bfhi(w.x), bflo(w.y), bfhi(w.y)}; *(f32x4*)(d + 4) = (f32x4){bflo(w.z), bfhi(w.z), bflo(w.w), bfhi(w.w)}; }
#pragma unroll
        for (int i = 0; i < 4; ++i) { const u32x4 w = vr[i]; float* d = it.vso + (size_t)((lane >> 3) + 8 * i) * 1024 + (lane & 7) * 8;
            *(f32x4*)d = (f32x4){bflo(w.x), bfhi(w.x), bflo(w.y), bfhi(w.y)}; *(f32x4*)(d + 4) = (f32x4){bflo(w.z), bfhi(w.z), bflo(w.w), bfhi(w.w)}; }
    }
    lrun += __shfl_xor(lrun, 32);
    const float inv = 1.0f / lrun;
    bf16_t* orow = it.o + (size_t)r * 1024 + 4 * h;
#pragma unroll
    for (int g4 = 0; g4 < 4; ++g4) {
        u32x2 a, b;
        a.x = pk2(o0[4 * g4] * inv, o0[4 * g4 + 1] * inv); a.y = pk2(o0[4 * g4 + 2] * inv, o0[4 * g4 + 3] * inv);
        b.x = pk2(o1[4 * g4] * inv, o1[4 * g4 + 1] * inv); b.y = pk2(o1[4 * g4 + 2] * inv, o1[4 * g4 + 3] * inv);
        *(u32x2*)(orow + 8 * g4) = a; *(u32x2*)(orow + 32 + 8 * g4) = b;
    }
}

constexpr int KROW = 144, KTILE = 64 * KROW, VTILE = 64 * 128, A_K = 0, A_V = 2 * KTILE, A_TAB = A_V + 2 * VTILE, A_SLOT = A_TAB + 1296;
__device__ __forceinline__ float max3f(float a, float b, float c) { float r; asm("v_max3_f32 %0, %1, %2, %3" : "=v"(r) : "v"(a), "v"(b), "v"(c)); return r; }
__device__ __forceinline__ void attn_unit(int b, int hh, int cq, const bf16_t* Qg, const bf16_t* Kg, const bf16_t* Vg, bf16_t* Og, float* kout, float* vout, const float* table, LAS unsigned char* lds, int tid, int lane, int wave) {
    constexpr float THR = 8.0f;
    const int r = lane & 31, h = lane >> 5;
    const int c = 4 * cq + (wave >> 1), half = wave & 1;
    const int j0 = (4 * cq - 8) > 0 ? (4 * cq - 8) : 0, j1 = 4 * cq + 3;
    const size_t rb = (size_t)b * SEQ;
    LAS float* tab = (LAS float*)(lds + A_TAB);
    if (tid < 324) tab[tid] = table[hh * 257 + (tid < 256 ? tid : 256)] * LOG2E;
    const int lrow = tid >> 3, lch = tid & 7;
    const bf16_t* kgp = Kg + (rb + lrow) * D + hh * HD + lch * 8; const bf16_t* vgp = Vg + (rb + lrow) * D + hh * HD + lch * 8;
    const int kwoff = A_K + lrow * KROW + lch * 16, vwoff = A_V + lrow * 128 + ((lch ^ (((lrow >> 1) & 1) << 2)) << 4);
    const long korow = (long)b * CROWS - (SEQ - CROWS) + lrow; float* kop = kout + korow * D + hh * HD + lch * 8; float* vop = vout + korow * D + hh * HD + lch * 8;
#define ATT_KVOUT(tile) do { if (cq >= 6 && (tile) >= 4 * cq) { float* kd = kop + (long)(tile) * 64 * D; float* vd = vop + (long)(tile) * 64 * D; \
        *(f32x4*)kd = (f32x4){bflo(kreg.x), bfhi(kreg.x), bflo(kreg.y), bfhi(kreg.y)}; *(f32x4*)(kd + 4) = (f32x4){bflo(kreg.z), bfhi(kreg.z), bflo(kreg.w), bfhi(kreg.w)}; \
        *(f32x4*)vd = (f32x4){bflo(vreg.x), bfhi(vreg.x), bflo(vreg.y), bfhi(vreg.y)}; *(f32x4*)(vd + 4) = (f32x4){bflo(vreg.z), bfhi(vreg.z), bflo(vreg.w), bfhi(vreg.w)}; } } while (0)
    u32x4 kreg = *(const u32x4*)(kgp + (size_t)j0 * 64 * D), vreg = *(const u32x4*)(vgp + (size_t)j0 * 64 * D);
    bf16x8 qf[4];
    const bf16_t* qp = Qg + (rb + 64 * c + 32 * half + r) * D + hh * HD + 8 * h;
#pragma unroll
    for (int s = 0; s < 4; ++s) qf[s] = *(const bf16x8*)(qp + 16 * s);
    *(LAS u32x4*)(lds + kwoff) = kreg; *(LAS u32x4*)(lds + vwoff) = vreg;
    ATT_KVOUT(j0);
    kreg = *(const u32x4*)(kgp + (size_t)(j0 + 1) * 64 * D); vreg = *(const u32x4*)(vgp + (size_t)(j0 + 1) * 64 * D);
    f32x16 o0, o1;
#pragma unroll
    for (int i = 0; i < 16; ++i) { o0[i] = 0.f; o1[i] = 0.f; }
    float mrun = 0.f, lrun = 0.f;
    const int i16 = lane & 15, q4 = i16 >> 2, p4 = i16 & 3, g = (lane >> 4) & 1;
    const int troff = A_V + (4 * h + q4) * 128 + ((32 * g) ^ (((q4 >> 1) & 1) << 6)) + 8 * p4;
    const int kroff = A_K + r * KROW + 16 * h;
    __syncthreads();
    const float cfar = tab[256];
    f32x16 negf;
#pragma unroll
    for (int i = 0; i < 16; ++i) negf[i] = cfar;
    asm volatile("" : "+v"(negf));
    const int qpos = 64 * c + 32 * half + r;
    bool first = true;
    for (int j = j0; j <= j1; ++j) {
        const int bufk = ((j - j0) & 1) * KTILE, bufv = ((j - j0) & 1) * VTILE;
        if (j < j1) { const int nbk = ((j + 1 - j0) & 1) * KTILE, nbv = ((j + 1 - j0) & 1) * VTILE; *(LAS u32x4*)(lds + nbk + kwoff) = kreg; *(LAS u32x4*)(lds + nbv + vwoff) = vreg; ATT_KVOUT(j + 1); }
        if (j + 2 <= j1) { kreg = *(const u32x4*)(kgp + (size_t)(j + 2) * 64 * D); vreg = *(const u32x4*)(vgp + (size_t)(j + 2) * 64 * D); }
        if (j >= c - 8 && j <= c) {
            f32x16 p0, p1;
            bf16x8 ka[4], kb[4];
#pragma unroll
            for (int s = 0; s < 4; ++s) { ka[s] = *(const LAS bf16x8*)(lds + bufk + kroff + 32 * s); kb[s] = *(const LAS bf16x8*)(lds + bufk + kroff + 32 * KROW + 32 * s); }
            if (j <= c - 3) {
                p0 = __builtin_amdgcn_mfma_f32_32x32x16_bf16(ka[0], qf[0], negf, 0, 0, 0);
                p1 = __builtin_amdgcn_mfma_f32_32x32x16_bf16(kb[0], qf[0], negf, 0, 0, 0);
            } else {
                const LAS float* tb = tab + (qpos - 64 * j - 4 * h + 128 - 59);
#pragma unroll
                for (int i = 0; i < 16; ++i) { p0[i] = tb[59 - ((i & 3) + 8 * (i >> 2))] - mrun; p1[i] = tb[59 - 32 - ((i & 3) + 8 * (i >> 2))] - mrun; }
                p0 = __builtin_amdgcn_mfma_f32_32x32x16_bf16(ka[0], qf[0], p0, 0, 0, 0);
                p1 = __builtin_amdgcn_mfma_f32_32x32x16_bf16(kb[0], qf[0], p1, 0, 0, 0);
            }
#pragma unroll
            for (int s = 1; s < 4; ++s) {
                p0 = __builtin_amdgcn_mfma_f32_32x32x16_bf16(ka[s], qf[s], p0, 0, 0, 0);
                p1 = __builtin_amdgcn_mfma_f32_32x32x16_bf16(kb[s], qf[s], p1, 0, 0, 0);
            }
            float ta = max3f(p0[0], p0[1], p1[0]), tb2 = max3f(p0[2], p0[3], p1[1]);
            ta = max3f(ta, p1[2], p1[3]);
#pragma unroll
            for (int i = 4; i < 16; i += 4) { ta = max3f(ta, p0[i], p0[i + 1]); tb2 = max3f(tb2, p0[i + 2], p0[i + 3]); ta = max3f(ta, p1[i], p1[i + 1]); tb2 = max3f(tb2, p1[i + 2], p1[i + 3]); }
            float tm = fmaxf(ta, tb2);
            { auto rr = __builtin_amdgcn_permlane32_swap(__float_as_uint(tm), __float_as_uint(tm), false, false); tm = fmaxf(__uint_as_float(rr[0]), __uint_as_float(rr[1])); }
            if (first || __any(tm > THR)) {
                const float dl = first ? tm : fmaxf(tm, 0.f); mrun += dl;
                const float sc = __builtin_amdgcn_exp2f(-dl); lrun *= sc;
#pragma unroll
                for (int i = 0; i < 16; ++i) { p0[i] -= dl; p1[i] -= dl; o0[i] *= sc; o1[i] *= sc; negf[i] = cfar - mrun; }
                asm volatile("" : "+v"(negf));
                first = false;
            }
            float ps0 = 0.f, ps1 = 0.f;
#pragma unroll
            for (int i = 0; i < 16; ++i) { p0[i] = __builtin_amdgcn_exp2f(p0[i]); p1[i] = __builtin_amdgcn_exp2f(p1[i]); ps0 += p0[i]; ps1 += p1[i]; }
            lrun += ps0 + ps1;
            u32x4 w0, w1, w2, w3;
            w0.x = pk2(p0[0], p0[1]); w0.y = pk2(p0[2], p0[3]); w0.z = pk2(p0[4], p0[5]); w0.w = pk2(p0[6], p0[7]);
            w1.x = pk2(p0[8], p0[9]); w1.y = pk2(p0[10], p0[11]); w1.z = pk2(p0[12], p0[13]); w1.w = pk2(p0[14], p0[15]);
            w2.x = pk2(p1[0], p1[1]); w2.y = pk2(p1[2], p1[3]); w2.z = pk2(p1[4], p1[5]); w2.w = pk2(p1[6], p1[7]);
            w3.x = pk2(p1[8], p1[9]); w3.y = pk2(p1[10], p1[11]); w3.z = pk2(p1[12], p1[13]); w3.w = pk2(p1[14], p1[15]);
            const bf16x8 pf[4] = {__builtin_bit_cast(bf16x8, w0), __builtin_bit_cast(bf16x8, w1), __builtin_bit_cast(bf16x8, w2), __builtin_bit_cast(bf16x8, w3)};
#pragma unroll
            for (int ks = 0; ks < 4; ++ks) {
                const LAS unsigned char* tb = lds + bufv + troff + ks * 16 * 128;
                const s16x4 a_lo = vtr(tb), a_hi = vtr(tb + 8 * 128);
                const LAS unsigned char* tb1 = lds + bufv + (troff ^ 64) + ks * 16 * 128;
                const s16x4 b_lo = vtr(tb1), b_hi = vtr(tb1 + 8 * 128);
                const bf16x8 va = __builtin_shufflevector(a_lo, a_hi, 0, 1, 2, 3, 4, 5, 6, 7), vb = __builtin_shufflevector(b_lo, b_hi, 0, 1, 2, 3, 4, 5, 6, 7);
                o0 = __builtin_amdgcn_mfma_f32_32x32x16_bf16(va, pf[ks], o0, 0, 0, 0);
                o1 = __builtin_amdgcn_mfma_f32_32x32x16_bf16(vb, pf[ks], o1, 0, 0, 0);
            }
        }
        asm volatile("s_waitcnt lgkmcnt(0)\n\ts_barrier" ::: "memory");
    }
    lrun += __shfl_xor(lrun, 32);
    const float inv = 1.0f / lrun;
    bf16_t* orow = Og + (rb + 64 * c + 32 * half + r) * D + hh * HD + 4 * h;
#pragma unroll
    for (int g4 = 0; g4 < 4; ++g4) {
        u32x2 x, y;
        x.x = pk2(o0[4 * g4] * inv, o0[4 * g4 + 1] * inv); x.y = pk2(o0[4 * g4 + 2] * inv, o0[4 * g4 + 3] * inv);
        y.x = pk2(o1[4 * g4] * inv, o1[4 * g4 + 1] * inv); y.y = pk2(o1[4 * g4 + 2] * inv, o1[4 * g4 + 3] * inv);
        *(u32x2*)(orow + 8 * g4) = x; *(u32x2*)(orow + 32 + 8 * g4) = y;
    }
#undef ATT_KVOUT
}
}

#define XB_TMO      128
#define XB_XCNT(j)  (256  + 64 * (j))
#define XB_XSUB(j)  (1280 + 64 * (j))
#define XB_XGEN(j)  (2304 + 64 * (j))
#define XB_TOP      3328
#define XB_TOPGEN   3392
#define XCD_BAR_WORDS 3456
#define XB_SPIN_CAP (1u << 18)

__device__ __forceinline__ unsigned xb_ld(unsigned* p)              { return __hip_atomic_load(p, __ATOMIC_RELAXED, __HIP_MEMORY_SCOPE_AGENT); }
__device__ __forceinline__ unsigned xb_add(unsigned* p, unsigned v) { return __hip_atomic_fetch_add(p, v, __ATOMIC_RELAXED, __HIP_MEMORY_SCOPE_AGENT); }
__device__ __forceinline__ unsigned xb_xcc_id() { return (unsigned)__builtin_amdgcn_s_getreg((3 << 11) | 20) & 0xFu; }
#define XB_SPIN(cond, bar) do { unsigned _sp = 0; while (cond) { __builtin_amdgcn_s_sleep(1); \
    if ((++_sp & 255u) == 0u) { if (xb_ld(&(bar)[XB_TMO])) break; if (_sp > XB_SPIN_CAP) { atomicAdd(&(bar)[XB_TMO], 1u); break; } } } } while (0)

struct XcdBarrier {
    unsigned* bar; unsigned x;
    volatile LAS unsigned* st;
};

__device__ __forceinline__ XcdBarrier xcd_barrier_post(unsigned* bar, volatile LAS unsigned* st) {
    XcdBarrier b; b.bar = bar; b.x = xb_xcc_id(); b.st = st;
    if (threadIdx.x == 0) (void)xb_add(&bar[XB_XCNT(b.x)], 1u);
    return b;
}
__device__ __forceinline__ void xcd_barrier_complete(unsigned* bar, unsigned x, unsigned& nloc, unsigned& nx) {
    const unsigned G = gridDim.x * gridDim.y * gridDim.z;
    unsigned sum, cnt, mine, sp = 0u;
    for (;;) {
        sum = 0u; cnt = 0u; mine = 0u;
#pragma unroll
        for (unsigned j = 0; j < 16; ++j) { const unsigned c = xb_ld(&bar[XB_XCNT(j)]); sum += c; cnt += (c > 0u) ? 1u : 0u; mine = (j == x) ? c : mine; }
        if (sum == G) break;
        __builtin_amdgcn_s_sleep(1);
        if ((++sp & 255u) == 0u) { if (xb_ld(&bar[XB_TMO])) break; if (sp > XB_SPIN_CAP) { atomicAdd(&bar[XB_TMO], 1u); break; } }
    }
    nloc = mine > 0u ? mine : 1u; nx = cnt > 0u ? cnt : 1u;
}

__device__ __forceinline__ void xcd_barrier(const XcdBarrier& b) {
    asm volatile("s_waitcnt vmcnt(0)" ::: "memory");
    __syncthreads();
    if (threadIdx.x == 0) {
        unsigned* bar = b.bar;
        __builtin_amdgcn_s_waitcnt(0);
        unsigned nloc = b.st[0], nx = b.st[1];
        if (nloc == 0u) { xcd_barrier_complete(bar, b.x, nloc, nx); b.st[0] = nloc; b.st[1] = nx; }
        const unsigned old = xb_add(&bar[XB_XSUB(b.x)], 1u);
        const unsigned gen = old / nloc;
        if (old + 1u == (gen + 1u) * nloc) {
            __builtin_amdgcn_fence(__ATOMIC_RELEASE, "agent");
            asm volatile("s_waitcnt vmcnt(0)" ::: "memory");
            const unsigned og = xb_add(&bar[XB_TOP], 1u);
            const unsigned tg = og / nx;
            if (og + 1u == (tg + 1u) * nx) xb_add(&bar[XB_TOPGEN], 1u);
            else XB_SPIN(xb_ld(&bar[XB_TOPGEN]) == tg, bar);
            __builtin_amdgcn_fence(__ATOMIC_ACQUIRE, "agent");
            xb_add(&bar[XB_XGEN(b.x)], 1u);
            asm volatile("s_waitcnt vmcnt(0)" ::: "memory");
        } else {
            XB_SPIN(xb_ld(&bar[XB_XGEN(b.x)]) == gen, bar);
            __builtin_amdgcn_fence(__ATOMIC_ACQUIRE, "agent");
            asm volatile("s_waitcnt vmcnt(0)" ::: "memory");
        }
    }
    __syncthreads();
}


__global__ void __launch_bounds__(NWAVES * 64, 2) fwd_kernel(Args a) {
    extern __shared__ __attribute__((aligned(16))) unsigned char lds_raw[];
    cg::grid_group grid = cg::this_grid();
    LAS unsigned char* lds = (LAS unsigned char*)lds_raw;
    int tid = threadIdx.x, lane = tid & 63; const int wave = __builtin_amdgcn_readfirstlane(tid >> 6);
    const int G = gridDim.x, gw = blockIdx.x * NWAVES + wave, NGW = G * NWAVES;
    unsigned char* ws = a.ws;
    bf16_t *Win_t, *Wout_t, *Wgu_t0, *Wgu_t1, *Wd_t0, *Wd_t1, *Wqkv_t, *Wo_t, *BA, *BB, *BC, *MO, *OB, *HB, *XR; float *Y, *PART, *INV; unsigned* qctr;
#define DERIVE() do { size_t z_ = 0; asm volatile("" : "+s"(z_)); unsigned char* w_ = a.ws + z_;     \
        Win_t = (bf16_t*)(w_ + WS_WIN); Wout_t = (bf16_t*)(w_ + WS_WOUT); Wgu_t0 = (bf16_t*)(w_ + WS_WGU0); Wgu_t1 = (bf16_t*)(w_ + WS_WGU1); \
        Wd_t0 = (bf16_t*)(w_ + WS_WD0); Wd_t1 = (bf16_t*)(w_ + WS_WD1); Wqkv_t = (bf16_t*)(w_ + WS_WQKV); Wo_t = (bf16_t*)(w_ + WS_WO); \
        BA = (bf16_t*)(w_ + WS_A); BB = (bf16_t*)(w_ + WS_B); BC = (bf16_t*)(w_ + WS_C); MO = (bf16_t*)(w_ + WS_MO); OB = (bf16_t*)(w_ + WS_O); HB = BA; \
        XR = (bf16_t*)(w_ + WS_XR); Y = a.out + O_Y; PART = (float*)(w_ + WS_PART); INV = (float*)(w_ + WS_CTL + MiB); qctr = (unsigned*)(w_ + WS_CTL); } while (0)
    DERIVE(); tid = threadIdx.x; asm volatile("" : "+v"(tid)); lane = tid & 63;
    { volatile LAS unsigned* st0 = (volatile LAS unsigned*)(lds + MISC_OFF); if (tid < 16) st0[tid] = 0u; }
    __syncthreads();
    XcdBarrier bar = xcd_barrier_post((unsigned*)(ws + WS_CTL) + CW_BAR, (volatile LAS unsigned*)(lds + MISC_OFF) + 8);
    if (a.out == nullptr) grid.sync();

    DERIVE(); tid = threadIdx.x; asm volatile("" : "+v"(tid)); lane = tid & 63;
    {
        LAS float* scr = (LAS float*)(lds + wave * 16384);
        constexpr int I_IN = 16 * 96, I_OUT = 16 * 32, I_GU = 16 * 176, I_D = 44 * 32;
        constexpr int NITEMS = 2 * I_IN + 2 * I_OUT + 2 * I_GU + 2 * I_D;
        for (int it = gw; it < NITEMS; it += NGW) {
            int r = it;
            if (r < I_IN) { transpose_item<2>(a.conv_w_in, D, 3 * D, Win_t, scr, r, lane, a.norm_mix_pre); continue; } r -= I_IN;
            if (r < I_OUT) { transpose_item<0>(a.conv_w_out, D, D, Wout_t, scr, r, lane, nullptr); continue; } r -= I_OUT;
            if (r < I_GU) { transpose_item<1>(a.ffn_w_gate_up, D, 2 * DFF, Wgu_t0, scr, r, lane, a.norm_ffn_pre); continue; } r -= I_GU;
            if (r < I_GU) { transpose_item<1>(a.ffn_w_gate_up + (size_t)D * 2 * DFF, D, 2 * DFF, Wgu_t1, scr, r, lane, a.norm_ffn_pre + D); continue; } r -= I_GU;
            if (r < I_D) { transpose_item<0>(a.ffn_w_down, DFF, D, Wd_t0, scr, r, lane, nullptr); continue; } r -= I_D;
            if (r < I_D) { transpose_item<0>(a.ffn_w_down + (size_t)DFF * D, DFF, D, Wd_t1, scr, r, lane, nullptr); continue; } r -= I_D;
            if (r < I_IN) { transpose_item<0>(a.attn_w_qkv, D, 3 * D, Wqkv_t, scr, r, lane, a.norm_mix_pre + D); continue; } r -= I_IN;
            transpose_item<0>(a.attn_w_o, D, D, Wo_t, scr, r, lane, nullptr);
        }
        for (int m = gw; m < M; m += NGW) { const float* xr = m < MP ? a.x_prompt + (size_t)m * D : a.x_sample + (size_t)(m - MP) * D; norm_row(xr, XR + (size_t)m * D, INV + m, lane); }
    }
    xcd_barrier(bar);
    DERIVE(); tid = threadIdx.x; asm volatile("" : "+v"(tid)); lane = tid & 63;
    { pg8::Gemm g{XR, Win_t, M, 3 * D, D, D}; pg8::StaticOrder S; S.init(M, 3 * D, G, (int)blockIdx.x); pg8::EpiConvIn E{BA, BB, INV};
      pg8::gemm_phase<pg8::EpiConvIn, pg8::StaticOrder, true, true>(lds, g, S, E); }
    xcd_barrier(bar);
    DERIVE(); tid = threadIdx.x; asm volatile("" : "+v"(tid)); lane = tid & 63;
    {
        const f32x4* wp = (const f32x4*)a.conv_kernel + lane;
        f32x4 w0[4], w1[4], w2[4];
#pragma unroll
        for (int j = 0; j < 4; ++j) { w0[j] = wp[64 * j]; w1[j] = wp[256 + 64 * j]; w2[j] = wp[512 + 64 * j]; }
        for (int blk = gw; blk < M / 4; blk += NGW) {
            const int m0 = blk * 4; const bool samp = m0 >= MP; const int t0 = samp ? ((m0 - MP) & 31) : (m0 & 2047); const int b = samp ? ((m0 - MP) >> 5) : (m0 >> 11); const int T = samp ? DS : SEQ;
            const u32x2* up = (const u32x2*)(BB + (size_t)m0 * D) + lane; const u32x2* bp = (const u32x2*)(BA + (size_t)m0 * D) + lane;
            u32x2 ur[6][4], br[4][4];
#pragma unroll
            for (int k = 2; k < 6; ++k)
#pragma unroll
                for (int j = 0; j < 4; ++j) { ur[k][j] = up[(k - 2) * 256 + 64 * j]; br[k - 2][j] = bp[(k - 2) * 256 + 64 * j]; }
            f32x4 h0[4], h1[4];
            if (t0 > 0) {
#pragma unroll
                for (int j = 0; j < 4; ++j) { const u32x2 a0 = up[64 * j - 512], a1 = up[64 * j - 256];
                    h0[j] = (f32x4){bflo(a0.x), bfhi(a0.x), bflo(a0.y), bfhi(a0.y)}; h1[j] = (f32x4){bflo(a1.x), bfhi(a1.x), bflo(a1.y), bfhi(a1.y)}; }
            } else if (samp) {
                const f32x4* st = (const f32x4*)(a.state_conv + (size_t)b * 2 * D) + lane;
#pragma unroll
                for (int j = 0; j < 4; ++j) { h0[j] = st[64 * j]; h1[j] = st[256 + 64 * j]; }
            } else {
#pragma unroll
                for (int j = 0; j < 4; ++j) { h0[j] = (f32x4){0.f, 0.f, 0.f, 0.f}; h1[j] = h0[j]; }
            }
            u32x2* yo = (u32x2*)(BC + (size_t)m0 * D) + lane;
            float* so = (t0 == T - 4) ? a.out + (samp ? O_CONVS : O_CONVP) + (size_t)b * 2 * D : nullptr;
#pragma unroll
            for (int j = 0; j < 4; ++j) {
                f32x4 u2 = h0[j], u1 = h1[j];
#pragma unroll
                for (int k = 0; k < 4; ++k) {
                    const u32x2 uw = ur[k + 2][j]; const f32x4 u0 = (f32x4){bflo(uw.x), bfhi(uw.x), bflo(uw.y), bfhi(uw.y)};
                    const u32x2 bw = br[k][j]; const f32x4 bg = (f32x4){bflo(bw.x), bfhi(bw.x), bflo(bw.y), bfhi(bw.y)};
                    const f32x4 y = bg * (w0[j] * u2 + w1[j] * u1 + w2[j] * u0);
                    u32x2 o; o.x = pk2(y.x, y.y); o.y = pk2(y.z, y.w); yo[k * 256 + 64 * j] = o;
                    if (so && k >= 2) *((f32x4*)(so + (size_t)(k - 2) * D) + lane + 64 * j) = u0;
                    u2 = u1; u1 = u0;
                }
            }
        }
    }
    xcd_barrier(bar);
    DERIVE(); tid = threadIdx.x; asm volatile("" : "+v"(tid)); lane = tid & 63;
    { pg8::Gemm g{BC, Wout_t, MP, D, D, D}; pg8::StaticOrder S; S.init(MP, D, G, (int)blockIdx.x); pg8::EpiBf16<0> E{MO, D, nullptr, 0, 0, 1.f};
      pg8::gemm_phase<pg8::EpiBf16<0>, pg8::StaticOrder, true, true>(lds, g, S, E); }
    { constexpr int KS = D / 4; pg8::Gemm g{BC, Wout_t, M, D, KS, D}; pg8::TailOrder S{4, KS * 2, G, (int)blockIdx.x}; pg8::EpiPartF32 E{PART, KS * 2};
      pg8::gemm_phase<pg8::EpiPartF32, pg8::TailOrder, true, true>(lds, g, S, E); }
    xcd_barrier(bar);
    DERIVE(); tid = threadIdx.x; asm volatile("" : "+v"(tid)); lane = tid & 63;
    res_pass<0, 0>(a, MO, XR, INV, Y, a.norm_mix_post, PART, 4, gw, NGW, lane);
    xcd_barrier(bar);
    DERIVE(); tid = threadIdx.x; asm volatile("" : "+v"(tid)); lane = tid & 63;
    { pg8::Gemm g{XR, Wgu_t0, M, 2 * DFF, D, D}; pg8::StaticOrder S; S.init(M, 2 * DFF, G, (int)blockIdx.x); pg8::EpiSwiGLU E{HB, INV};
      pg8::gemm_phase<pg8::EpiSwiGLU, pg8::StaticOrder, true, true>(lds, g, S, E); }
    xcd_barrier(bar);
    DERIVE(); tid = threadIdx.x; asm volatile("" : "+v"(tid)); lane = tid & 63;
    { pg8::Gemm g{HB, Wd_t0, MP, D, DFF, DFF}; pg8::StaticOrder S; S.init(MP, D, G, (int)blockIdx.x); pg8::EpiBf16<0> E{MO, D, nullptr, 0, 0, 1.f};
      pg8::gemm_phase<pg8::EpiBf16<0>, pg8::StaticOrder, true, true>(lds, g, S, E); }
    { constexpr int KS = DFF / 11; pg8::Gemm g{HB, Wd_t0, M, D, KS, DFF}; pg8::TailOrder S{11, KS * 2, G, (int)blockIdx.x}; pg8::EpiPartF32 E{PART, KS * 2};
      pg8::gemm_phase<pg8::EpiPartF32, pg8::TailOrder, true, true>(lds, g, S, E); }
    xcd_barrier(bar);
    DERIVE(); tid = threadIdx.x; asm volatile("" : "+v"(tid)); lane = tid & 63;
    res_pass<1, 0>(a, MO, XR, INV, Y, a.norm_ffn_post, PART, 11, gw, NGW, lane);
    xcd_barrier(bar);
    DERIVE(); tid = threadIdx.x; asm volatile("" : "+v"(tid)); lane = tid & 63;
    { pg8::Gemm g{XR, Wqkv_t, M, 3 * D, D, D}; pg8::StaticOrder S; S.init(M, 3 * D, G, (int)blockIdx.x);
      pg8::EpiQKVs E{BA, (size_t)(WS_B - WS_A) / 2, INV, QSCALE};
      pg8::gemm_phase<pg8::EpiQKVs, pg8::StaticOrder, true, true>(lds, g, S, E); }
    xcd_barrier(bar);
    DERIVE(); tid = threadIdx.x; asm volatile("" : "+v"(tid)); lane = tid & 63;
    {
        constexpr int NGS1 = (DB * NH) / 8, NPU1 = NB * NH * 8, NGS = NGS1 * REP_SAMPLE, NPU = NPU1 * REP_PROMPT;
        LAS unsigned char* vlds = lds + wave * 4096; LAS float* tabw = (LAS float*)(lds + 32768 + wave * 1088);
        volatile LAS int* slot = (volatile LAS int*)(lds + 65536);
        if (tid == 0) *slot = (int)atomicAdd(qctr, 1u);
        __syncthreads();
        int wi = *slot;
        __syncthreads();
        while (wi < NGS + NPU) {
            int nxt = 0;
            if (tid == 0) nxt = (int)atomicAdd(qctr, 1u);
            if (wi < NGS) {
                att::Item it;
                const int si = (wi % NGS1) * 8 + wave, b = si >> 4, hh = si & 15;
                const size_t rb = (size_t)MP + (size_t)b * DS;
                it.q = BA + rb * D + hh * HD; it.o = OB + rb * D + hh * HD;
                it.kc = nullptr; it.vc = nullptr; it.kcf = a.cache_k + (size_t)b * CROWS * D + hh * HD; it.vcf = a.cache_v + (size_t)b * CROWS * D + hh * HD; it.kn = BB + rb * D + hh * HD; it.vn = BC + rb * D + hh * HD; it.nc = CROWS / 32;
                it.kt0 = 0; it.kt1 = CROWS / 32 + 1; it.qpos0 = CROWS; it.head = hh;
                it.kso = (wi < NGS1) ? a.out + O_KS + (size_t)b * DS * D + hh * HD : nullptr; it.vso = a.out + O_VS + (size_t)b * DS * D + hh * HD;
                att::attn_item(it, vlds, tabw, a.attn_rel_bias, lane);
            } else {
                const int u = (wi - NGS) % NPU1, bh = u >> 3, cq = 7 - (u & 7);
                att::attn_unit(bh >> 4, bh & 15, cq, BA, BB, BC, OB, a.out + O_KP, a.out + O_VP, a.attn_rel_bias, lds, tid, lane, wave);
            }
            __syncthreads();
            if (tid == 0) *slot = nxt;
            __syncthreads();
            wi = *slot;
        }
    }
    xcd_barrier(bar);
    DERIVE(); tid = threadIdx.x; asm volatile("" : "+v"(tid)); lane = tid & 63;
    { pg8::Gemm g{OB, Wo_t, MP, D, D, D}; pg8::StaticOrder S; S.init(MP, D, G, (int)blockIdx.x); pg8::EpiBf16<0> E{MO, D, nullptr, 0, 0, 1.f};
      pg8::gemm_phase<pg8::EpiBf16<0>, pg8::StaticOrder, true, true>(lds, g, S, E); }
    { constexpr int KS = D / 4; pg8::Gemm g{OB, Wo_t, M, D, KS, D}; pg8::TailOrder S{4, KS * 2, G, (int)blockIdx.x}; pg8::EpiPartF32 E{PART, KS * 2};
      pg8::gemm_phase<pg8::EpiPartF32, pg8::TailOrder, true, true>(lds, g, S, E); }
    xcd_barrier(bar);
    DERIVE(); tid = threadIdx.x; asm volatile("" : "+v"(tid)); lane = tid & 63;
    res_pass<1, 0>(a, MO, XR, INV, Y, a.norm_mix_post + D, PART, 4, gw, NGW, lane);
    xcd_barrier(bar);
    DERIVE(); tid = threadIdx.x; asm volatile("" : "+v"(tid)); lane = tid & 63;
    { pg8::Gemm g{XR, Wgu_t1, M, 2 * DFF, D, D}; pg8::StaticOrder S; S.init(M, 2 * DFF, G, (int)blockIdx.x); pg8::EpiSwiGLU E{HB, INV};
      pg8::gemm_phase<pg8::EpiSwiGLU, pg8::StaticOrder, true, true>(lds, g, S, E); }
    xcd_barrier(bar);
    DERIVE(); tid = threadIdx.x; asm volatile("" : "+v"(tid)); lane = tid & 63;
    { pg8::Gemm g{HB, Wd_t1, MP, D, DFF, DFF}; pg8::StaticOrder S; S.init(MP, D, G, (int)blockIdx.x); pg8::EpiBf16<0> E{MO, D, nullptr, 0, 0, 1.f};
      pg8::gemm_phase<pg8::EpiBf16<0>, pg8::StaticOrder, true, true>(lds, g, S, E); }
    { constexpr int KS = DFF / 11; pg8::Gemm g{HB, Wd_t1, M, D, KS, DFF}; pg8::TailOrder S{11, KS * 2, G, (int)blockIdx.x}; pg8::EpiPartF32 E{PART, KS * 2};
      pg8::gemm_phase<pg8::EpiPartF32, pg8::TailOrder, true, true>(lds, g, S, E); }
    xcd_barrier(bar);
    DERIVE(); tid = threadIdx.x; asm volatile("" : "+v"(tid)); lane = tid & 63;
    res_pass<1, 1>(a, MO, XR, INV, Y, a.norm_ffn_post + D, PART, 11, gw, NGW, lane);
}

extern "C" void kernel_launch(void* const* d_in, const int* in_sizes, int n_in, void* d_out, int out_size, void* d_ws, size_t ws_size, hipStream_t stream) {
    static int grid = 0;
    if (grid == 0) {
        if (n_in != 17 || (size_t)out_size != O_END || ws_size < WS_END) { fprintf(stderr, "kernel_launch: unexpected shapes n_in %d out %d ws %zu\n", n_in, out_size, ws_size); grid = -1; return; }
        int dev = 0, cus = 0, per_cu = 0;
        hipGetDevice(&dev); hipDeviceGetAttribute(&cus, hipDeviceAttributeMultiprocessorCount, dev);
        if (hipFuncSetAttribute((const void*)fwd_kernel, hipFuncAttributeMaxDynamicSharedMemorySize, LDS_BYTES) != hipSuccess) { fprintf(stderr, "kernel_launch: hipFuncSetAttribute failed\n"); grid = -1; return; }
        if (hipOccupancyMaxActiveBlocksPerMultiprocessor(&per_cu, (const void*)fwd_kernel, NWAVES * 64, LDS_BYTES) != hipSuccess || per_cu < 1) { fprintf(stderr, "kernel_launch: occupancy query says %d\n", per_cu); per_cu = 1; }
        (void)hipGetLastError();
        grid = cus;
    }
    if (grid < 0) return;
    if (hipMemsetAsync((char*)d_ws + WS_CTL, 0, CTL_BYTES, stream) != hipSuccess) { fprintf(stderr, "kernel_launch: memset failed\n"); return; }
    Args a{};
    const float** p = (const float**)&a;
    for (int i = 0; i < 17; ++i) p[i] = (const float*)d_in[i];
    a.out = (float*)d_out; a.ws = (unsigned char*)d_ws;
    void* args[] = {&a};
    hipError_t e = hipLaunchCooperativeKernel((const void*)fwd_kernel, dim3(grid), dim3(NWAVES * 64), args, LDS_BYTES, stream);
    if (e != hipSuccess) fprintf(stderr, "cooperative launch failed: %s (grid %d)\n", hipGetErrorString(e), grid);
}
```

```cpp
#include <hip/hip_runtime.h>
#include <hip/hip_cooperative_groups.h>
#include <cstdio>
#include <cstdint>
namespace cg = cooperative_groups;
namespace pg8 {
#define PG8_LAS __attribute__((address_space(3)))
typedef unsigned short bf16_t;
typedef short bf16x8 __attribute__((ext_vector_type(8)));
typedef float f32x4 __attribute__((ext_vector_type(4)));
typedef unsigned u32x4 __attribute__((ext_vector_type(4)));
constexpr int BM = 256, BK = 64, HALF = 128, HTB = HALF * BK * 2  , STAGE_BYTES = 8 * HTB, NXCD = 8, WGM = 8;

__host__ __device__ __forceinline__ int lds_byte(int r, int c) { const int st = (r >> 4) * 2 + (c >> 5), rr = r & 15, cc = c & 31, ob = rr * 64 + cc * 2; return st * 1024 + (ob ^ (((ob >> 9) & 1) << 5)); }
__host__ __device__ __forceinline__ void stage_rc(int b, int& R, int& C) { const int st = b / 1024, sb = b % 1024, swz = sb ^ (((sb >> 9) & 1) << 5); R = (st >> 1) * 16 + swz / 64; C = (st & 1) * 32 + (swz % 64) / 2; }
__host__ __device__ __forceinline__ int perm32(int rho) { const int n = rho >> 4, i = rho & 15; return 8 * (i >> 2) + 4 * n + (i & 3); }

struct Unit { int pm, pn; int kb; };
struct Gemm { const bf16_t* A; const bf16_t* Bt; int M, N, K; int ld; };

struct StaticOrder {
    int nM, nN, nwg, G, c;
    __host__ __device__ void init(int M, int N, int G_, int c_) { nM = M / BM; nN = N / BM; nwg = nM * nN; G = G_; c = c_; }
    __host__ __device__ bool next(int i, Unit& u) const {
        const long L = (long)i * G + c; if (L >= nwg) return false;
        int wgid = (int)L; { const int q = nwg / NXCD, r = nwg % NXCD, xcd = wgid % NXCD, off = wgid / NXCD; wgid = (xcd < r ? xcd * (q + 1) : r * (q + 1) + (xcd - r) * q) + off; }
        const int nig = WGM * nN, gid = wgid / nig, fm = gid * WGM, gsz = (nM - fm) < WGM ? (nM - fm) : WGM;
        u.pm = fm + ((wgid % nig) % gsz); u.pn = (wgid % nig) / gsz; u.kb = 0; return true;
    }
    __device__ __forceinline__ void a_ready(const Unit&) const {}
    __device__ __forceinline__ void done(const Unit&) const {}
};

__device__ __forceinline__ unsigned cvt_pk_bf16(float lo, float hi) { unsigned r; asm volatile("v_cvt_pk_bf16_f32 %0, %1, %2" : "=v"(r) : "v"(lo), "v"(hi)); return r; }
typedef float f32x2 __attribute__((ext_vector_type(2)));
__device__ __forceinline__ f32x2 gelu_pk(f32x2 v) {
    const f32x2 av = __builtin_elementwise_abs(v), d = av * 0.2316418882f + 1.0f;
    f32x2 t; t.x = __builtin_amdgcn_rcpf(d.x); t.y = __builtin_amdgcn_rcpf(d.y);
    f32x2 q = t * 0.5307027145f + (-0.7265760135f); q = q * t + 0.7107068705f; q = q * t + (-0.142248368f); q = q * t + 0.127414796f; q = q * t;
    const f32x2 s = (v * v) * (-0.72134752044f);
    f32x2 e; e.x = __builtin_amdgcn_exp2f(s.x); e.y = __builtin_amdgcn_exp2f(s.y);
    const f32x2 m = v * (q * e), r = v - m;
    f32x2 o; o.x = v.x < 0.f ? m.x : r.x; o.y = v.y < 0.f ? m.y : r.y; return o;
}

template <int ACT  > struct EpiBf16 {
    static constexpr bool PERM = true, AFTER_DRAIN = false; static_assert(ACT == 0 || ACT == 1, "EpiBf16: ACT is 0 (none) or 1 (gelu_pk)");
    __device__ __forceinline__ void pre(const Unit&, int, int) const {}
    bf16_t* O; int ldc; const float* bias; int split_cols; size_t split_stride; float scale0;
    __device__ __forceinline__ void operator()(const f32x4 (&acc)[2][2][4][2], const Unit& u, int wr, int wc, int fr, int fq) const {
        const int row0 = u.pm * BM + wr * 64 + fr; int colt = u.pn * BM; bf16_t* base = O;
        float sc = 1.f; if (split_cols) { const int t = colt / split_cols; base += (size_t)t * split_stride; colt -= t * split_cols; if (t == 0) sc = scale0; }
        const int col0 = colt + wc * 32 + 8 * fq, bcol0 = u.pn * BM + wc * 32 + 8 * fq;
        f32x4 bv[2][2];
#pragma unroll
        for (int bj = 0; bj < 2; ++bj)
#pragma unroll
            for (int n = 0; n < 2; ++n) bv[bj][n] = bias ? *(const f32x4*)(bias + bcol0 + bj * HALF + 4 * n) : (f32x4){0.f, 0.f, 0.f, 0.f};
#pragma unroll
        for (int ai = 0; ai < 2; ++ai)
#pragma unroll
            for (int m = 0; m < 4; ++m) { bf16_t* rowp = base + (size_t)(row0 + ai * HALF + m * 16) * ldc + col0;
#pragma unroll
                for (int bj = 0; bj < 2; ++bj) { f32x4 v0 = acc[ai][bj][m][0] + bv[bj][0], v1 = acc[ai][bj][m][1] + bv[bj][1];
                    if (ACT == 1) { f32x2 a = gelu_pk((f32x2){v0[0], v0[1]}), b = gelu_pk((f32x2){v0[2], v0[3]}), c = gelu_pk((f32x2){v1[0], v1[1]}), d = gelu_pk((f32x2){v1[2], v1[3]});
                        v0 = (f32x4){a.x, a.y, b.x, b.y}; v1 = (f32x4){c.x, c.y, d.x, d.y}; }
                    v0 = v0 * sc; v1 = v1 * sc; u32x4 w; w.x = cvt_pk_bf16(v0[0], v0[1]); w.y = cvt_pk_bf16(v0[2], v0[3]); w.z = cvt_pk_bf16(v1[0], v1[1]); w.w = cvt_pk_bf16(v1[2], v1[3]);
                    *(u32x4*)(rowp + bj * HALF) = w; } }
    }
};
template <class Epi, class Sched, bool ALIGN_EPI = false, bool SP2 = false>
__device__ __forceinline__ void gemm_phase(PG8_LAS unsigned char* lds, const Gemm g, const Sched& S, const Epi& E) {
    int tid_ = threadIdx.x; asm volatile("" : "+v"(tid_)); const int tid = tid_, wid = __builtin_amdgcn_readfirstlane(tid >> 6), lane = tid & 63, wr = wid >> 2, wc = wid & 3, fr = lane & 15, fq = lane >> 4;
    const int K = g.ld, nt = g.K / BK;
    unsigned voffA[2], voffB[2];
#pragma unroll
    for (int i = 0; i < 2; ++i) { int R, C; stage_rc(tid * 16 + i * 8192, R, C); const int Rb = Epi::PERM ? ((R & ~31) + perm32(R & 31)) : R;
        voffA[i] = (unsigned)(R * K + C) * 2u; voffB[i] = (unsigned)(Rb * K + C) * 2u; }
    const size_t kstep = (size_t)(BK * 2);
    const size_t hstep = (size_t)HALF * K * 2;
    const size_t tstep = 2 * hstep;
    const unsigned ldsw = (unsigned)wid * 1024u;
    const int aoff = lds_byte(wr * 64 + fr, fq * 8), boff = lds_byte(wc * 32 + fr, fq * 8);
#define PG8_SA(b, h) (((b) * 2 + (h)) * HTB)
#define PG8_SB(b, h) ((4 + (b) * 2 + (h)) * HTB)
#define PG8_STAGE(bufoff, gbase, voff) do { _Pragma("unroll") for (int _i = 0; _i < 2; ++_i) \
        __builtin_amdgcn_global_load_lds((const unsigned*)((const char*)(gbase) + (voff)[_i]), (PG8_LAS unsigned*)(lds + (bufoff) + ldsw + _i * 8192), 16, 0, 0); } while (0)
#define PG8_LDA(dst, b, h) do { _Pragma("unroll") for (int m = 0; m < 4; ++m) _Pragma("unroll") for (int k = 0; k < 2; ++k) dst[m][k] = *(const PG8_LAS bf16x8*)(lds + PG8_SA(b, h) + aoff + m * 2048 + k * 1024); } while (0)
#define PG8_LDB(dst, b, h) do { _Pragma("unroll") for (int n = 0; n < 2; ++n) _Pragma("unroll") for (int k = 0; k < 2; ++k) dst[n][k] = *(const PG8_LAS bf16x8*)(lds + PG8_SB(b, h) + boff + n * 2048 + k * 1024); } while (0)
#define PG8_MMA(ai, bj, At, Bt) do { __builtin_amdgcn_s_setprio(1); _Pragma("unroll") for (int m = 0; m < 4; ++m) _Pragma("unroll") for (int n = 0; n < 2; ++n) _Pragma("unroll") for (int k = 0; k < 2; ++k) \
        acc[ai][bj][m][n] = __builtin_amdgcn_mfma_f32_16x16x32_bf16(Bt[n][k], At[m][k], acc[ai][bj][m][n], 0, 0, 0); __builtin_amdgcn_s_setprio(0); } while (0)
#define PG8_WAIT_V(n) asm volatile("s_waitcnt vmcnt(" #n ")" ::: "memory")
#define PG8_WAIT_L(n) asm volatile("s_waitcnt lgkmcnt(" #n ")" ::: "memory")
#define PG8_BAR __builtin_amdgcn_s_barrier()
#define PG8_SCHED __builtin_amdgcn_sched_barrier(0)
    Unit cur, nxt; int ui = 0;
    if (!S.next(0, cur)) return;
    f32x4 acc[2][2][4][2];
#pragma unroll
    for (int a = 0; a < 2; ++a)
#pragma unroll
        for (int b = 0; b < 2; ++b)
#pragma unroll
            for (int m = 0; m < 4; ++m)
#pragma unroll
                for (int n = 0; n < 2; ++n) acc[a][b][m][n] = (f32x4){0.f, 0.f, 0.f, 0.f};
    bf16x8 At[4][2], B0[2][2], B1[2][2];
    const char* cA = (const char*)g.A + (size_t)cur.pm * tstep + cur.kb; const char* cB = (const char*)g.Bt + (size_t)cur.pn * tstep + cur.kb;
    S.a_ready(cur);
    if constexpr (SP2) {
        PG8_STAGE(PG8_SB(0, 0), cB, voffB); PG8_STAGE(PG8_SB(0, 1), cB + hstep, voffB); PG8_STAGE(PG8_SA(0, 0), cA, voffA); PG8_STAGE(PG8_SA(0, 1), cA + hstep, voffA);
        if (wr == 1) PG8_BAR;
        PG8_WAIT_V(2); PG8_BAR;
        PG8_STAGE(PG8_SB(1, 0), cB + kstep, voffB); PG8_STAGE(PG8_SA(1, 0), cA + kstep, voffA); PG8_STAGE(PG8_SB(1, 1), cB + hstep + kstep, voffB);
        PG8_WAIT_V(6); PG8_BAR;
    } else {
        PG8_STAGE(PG8_SB(0, 0), cB, voffB); PG8_STAGE(PG8_SA(0, 0), cA, voffA); PG8_STAGE(PG8_SB(0, 1), cB + hstep, voffB); PG8_STAGE(PG8_SA(0, 1), cA + hstep, voffA);
        if (wr == 1) PG8_BAR;
        PG8_WAIT_V(4); PG8_BAR;
        PG8_STAGE(PG8_SB(1, 0), cB + kstep, voffB); PG8_STAGE(PG8_SA(1, 0), cA + kstep, voffA); PG8_STAGE(PG8_SB(1, 1), cB + hstep + kstep, voffB);
        PG8_WAIT_V(6); PG8_BAR;
    }
    for (;;) {
        const bool has_next = S.next(ui + 1, nxt);
        const char* nA = has_next ? (const char*)g.A + (size_t)nxt.pm * tstep + nxt.kb : cA; const char* nB = has_next ? (const char*)g.Bt + (size_t)nxt.pn * tstep + nxt.kb : cB;
        for (int t = 0; t < nt; t += 2) {
            const bool last = (t == nt - 2);
            const char* a1 = cA + (size_t)(t + 1) * kstep;
            const char* a2 = last ? nA : cA + (size_t)(t + 2) * kstep; const char* b2 = last ? nB : cB + (size_t)(t + 2) * kstep;
            const char* a3 = a2 + kstep; const char* b3 = b2 + kstep;
            if (last) E.pre(cur, wr, fr);
            if (last && has_next) S.a_ready(nxt);
            if constexpr (SP2) {
            PG8_LDB(B0, 0, 0); PG8_LDB(B1, 0, 1); PG8_SCHED; PG8_LDA(At, 0, 0); PG8_STAGE(PG8_SA(1, 1), a1 + hstep, voffA);
            PG8_WAIT_V(8); PG8_WAIT_L(0); PG8_BAR; PG8_MMA(0, 0, At, B0); PG8_MMA(0, 1, At, B1); PG8_BAR; PG8_SCHED;
            PG8_LDA(At, 0, 1); PG8_STAGE(PG8_SB(0, 0), b2, voffB); PG8_STAGE(PG8_SB(0, 1), b2 + hstep, voffB); PG8_STAGE(PG8_SA(0, 0), a2, voffA);
            PG8_WAIT_V(8); PG8_WAIT_L(0); PG8_BAR; PG8_MMA(1, 0, At, B0); PG8_MMA(1, 1, At, B1); PG8_BAR; PG8_SCHED;
            PG8_LDB(B0, 1, 0); PG8_LDB(B1, 1, 1); PG8_SCHED; PG8_LDA(At, 1, 0); PG8_STAGE(PG8_SA(0, 1), a2 + hstep, voffA);
            PG8_WAIT_V(8); PG8_WAIT_L(0); PG8_BAR; PG8_MMA(0, 0, At, B0); PG8_MMA(0, 1, At, B1); PG8_BAR; PG8_SCHED;
            PG8_LDA(At, 1, 1); PG8_STAGE(PG8_SB(1, 0), b3, voffB); PG8_STAGE(PG8_SB(1, 1), b3 + hstep, voffB); PG8_STAGE(PG8_SA(1, 0), a3, voffA);
            PG8_WAIT_V(8); PG8_WAIT_L(0); PG8_BAR; PG8_MMA(1, 0, At, B0); PG8_MMA(1, 1, At, B1); PG8_BAR; PG8_SCHED;
            } else {
            PG8_LDB(B0, 0, 0); PG8_SCHED; PG8_LDA(At, 0, 0); PG8_STAGE(PG8_SA(1, 1), a1 + hstep, voffA);
            PG8_WAIT_L(8); PG8_BAR; PG8_WAIT_L(0); PG8_MMA(0, 0, At, B0); PG8_BAR; PG8_SCHED;
            PG8_LDB(B1, 0, 1); PG8_STAGE(PG8_SB(0, 0), b2, voffB);
            PG8_BAR; PG8_WAIT_L(0); PG8_MMA(0, 1, At, B1); PG8_BAR;
            PG8_LDA(At, 0, 1); PG8_STAGE(PG8_SA(0, 0), a2, voffA);
            PG8_BAR; PG8_WAIT_L(0); PG8_MMA(1, 0, At, B0); PG8_BAR; PG8_SCHED;
            PG8_STAGE(PG8_SB(0, 1), b2 + hstep, voffB);
            PG8_WAIT_V(6); PG8_BAR; PG8_MMA(1, 1, At, B1); PG8_BAR;
            PG8_LDB(B0, 1, 0); PG8_SCHED; PG8_LDA(At, 1, 0); PG8_STAGE(PG8_SA(0, 1), a2 + hstep, voffA);
            PG8_WAIT_L(8); PG8_BAR; PG8_WAIT_L(0); PG8_MMA(0, 0, At, B0); PG8_BAR; PG8_SCHED;
            PG8_LDB(B1, 1, 1); PG8_STAGE(PG8_SB(1, 0), b3, voffB);
            PG8_BAR; PG8_WAIT_L(0); PG8_MMA(0, 1, At, B1); PG8_BAR;
            PG8_LDA(At, 1, 1); PG8_STAGE(PG8_SA(1, 0), a3, voffA);
            PG8_BAR; PG8_WAIT_L(0); PG8_MMA(1, 0, At, B0); PG8_BAR; PG8_SCHED;
            PG8_STAGE(PG8_SB(1, 1), b3 + hstep, voffB);
            PG8_WAIT_V(6); PG8_BAR; PG8_MMA(1, 1, At, B1); PG8_BAR;
            }
        }
        if constexpr (ALIGN_EPI) { if (wr == 0) PG8_BAR; }
        if constexpr (!Epi::AFTER_DRAIN) { E(acc, cur, wr, wc, fr, fq); S.done(cur); }
        if (!has_next) break;
#pragma unroll
        for (int a = 0; a < 2; ++a)
#pragma unroll
            for (int b = 0; b < 2; ++b)
#pragma unroll
                for (int m = 0; m < 4; ++m)
#pragma unroll
                    for (int n = 0; n < 2; ++n) acc[a][b][m][n] = (f32x4){0.f, 0.f, 0.f, 0.f};
        cur = nxt; cA = nA; cB = nB; ++ui;
        if constexpr (ALIGN_EPI) { if (wr == 1) PG8_BAR; }
    }
    PG8_WAIT_V(0);
    if constexpr (!ALIGN_EPI) { if (wr == 0) PG8_BAR; }
    PG8_BAR;
    if constexpr (Epi::AFTER_DRAIN) { E.fused(acc, cur, wr, wc, fr, fq, lds, wid, lane); S.done(cur); }
#undef PG8_SA
#undef PG8_SB
#undef PG8_STAGE
#undef PG8_LDA
#undef PG8_LDB
#undef PG8_MMA
#undef PG8_WAIT_V
#undef PG8_WAIT_L
#undef PG8_BAR
#undef PG8_SCHED
}
}

#define LAS __attribute__((address_space(3)))
typedef unsigned short bf16_t;
typedef unsigned u32x4 __attribute__((ext_vector_type(4)));
typedef unsigned u32x2 __attribute__((ext_vector_type(2)));
typedef float f32x4 __attribute__((ext_vector_type(4)));
typedef float f32x16 __attribute__((ext_vector_type(16)));
typedef short bf16x8 __attribute__((ext_vector_type(8)));
typedef short s16x4 __attribute__((ext_vector_type(4)));

constexpr int D = 1024, NB = 32, SEQ = 2048, DB = 32, DS = 32, NH = 16, HD = 64, DFF = 2816;
constexpr int MP = NB * SEQ;
constexpr int MS = DB * DS;
constexpr int M = MP + MS;
constexpr int CROWS = 512;
constexpr float EPS = 1e-6f;
constexpr float LOG2E = 1.4426950408889634f;
constexpr float QSCALE = 0.125f * LOG2E;
constexpr int NWAVES = 8;
#ifndef REP_KVOUT
#define REP_KVOUT 1
#endif
#ifndef REP_SAMPLE
#define REP_SAMPLE 1
#endif
#ifndef REP_PROMPT
#define REP_PROMPT 1
#endif

constexpr size_t O_Y = 0;
constexpr size_t O_CONVP = (size_t)M * D;
constexpr size_t O_CONVS = O_CONVP + 65536;
constexpr size_t O_KP = O_CONVS + 65536;
constexpr size_t O_VP = O_KP + (size_t)NB * CROWS * D;
constexpr size_t O_KS = O_VP + (size_t)NB * CROWS * D;
constexpr size_t O_VS = O_KS + (size_t)MS * D;
constexpr size_t O_END = O_VS + (size_t)MS * D;

constexpr size_t MiB = 1u << 20;
constexpr size_t WS_WIN = 0, WS_WOUT = 6 * MiB, WS_WGU0 = 8 * MiB, WS_WGU1 = 19 * MiB, WS_WD0 = 30 * MiB, WS_WD1 = 30 * MiB + 5632 * 1024,
                 WS_WQKV = 41 * MiB, WS_WO = 47 * MiB, WS_PART = 50 * MiB  , WS_CTL = 120 * MiB;
constexpr size_t WS_XN = 128 * MiB, WS_A = 258 * MiB, WS_B = 388 * MiB, WS_C = 518 * MiB, WS_MO = 648 * MiB, WS_O = 128 * MiB  , WS_XR = 778 * MiB, WS_END = 908 * MiB;

constexpr int LDS_BYTES = 131072 + 8192, MISC_OFF = 131072 + 4096, CW_BAR = 4096  , CTL_BYTES = 65536;

__device__ __forceinline__ float bf2f(unsigned short b) { return __uint_as_float(((unsigned)b) << 16); }
__device__ __forceinline__ float bflo(unsigned w) { return __uint_as_float(w << 16); }
__device__ __forceinline__ float bfhi(unsigned w) { return __uint_as_float(w & 0xffff0000u); }
__device__ __forceinline__ unsigned pk2(float lo, float hi) { return pg8::cvt_pk_bf16(lo, hi); }
__device__ __forceinline__ float wave_sum(float v) {
#pragma unroll
    for (int o = 1; o < 64; o <<= 1) v += __shfl_xor(v, o);
    return v;
}

namespace pg8 {
struct EpiConvIn {
    static constexpr bool PERM = true, AFTER_DRAIN = false;
    bf16_t* Bg; bf16_t* U; const float* inv; mutable float rs[8];
    __device__ __forceinline__ void pre(const Unit& u, int wr, int fr) const {
#pragma unroll
        for (int i = 0; i < 8; ++i) rs[i] = inv[u.pm * BM + (i >> 2) * HALF + wr * 64 + (i & 3) * 16 + fr]; }
    __device__ __forceinline__ void operator()(const f32x4 (&acc)[2][2][4][2], const Unit& u, int wr, int wc, int fr, int fq) const {
        const int row0 = u.pm * BM + wr * 64 + fr;
        if (u.pn < 4) {
            const int col0 = u.pn * BM + wc * 32 + 8 * fq;
#pragma unroll
            for (int ai = 0; ai < 2; ++ai)
#pragma unroll
                for (int m = 0; m < 4; ++m) { bf16_t* rowp = Bg + (size_t)(row0 + ai * HALF + m * 16) * 1024 + col0;
#pragma unroll
                    for (int bj = 0; bj < 2; ++bj) { const float r1 = rs[ai * 4 + m]; const f32x4 v0 = acc[ai][bj][m][0] * r1, v1 = acc[ai][bj][m][1] * r1;
                        u32x4 w; w.x = cvt_pk_bf16(v0[0], v0[1]); w.y = cvt_pk_bf16(v0[2], v0[3]); w.z = cvt_pk_bf16(v1[0], v1[1]); w.w = cvt_pk_bf16(v1[2], v1[3]);
                        *(u32x4*)(rowp + bj * HALF) = w; } }
        } else {
            const int col0 = (u.pn - 4) * HALF + wc * 32 + 8 * fq;
#pragma unroll
            for (int ai = 0; ai < 2; ++ai)
#pragma unroll
                for (int m = 0; m < 4; ++m) { bf16_t* rowp = U + (size_t)(row0 + ai * HALF + m * 16) * 1024 + col0;
                    const float r2 = rs[ai * 4 + m] * rs[ai * 4 + m]; const f32x4 v0 = acc[ai][0][m][0] * acc[ai][1][m][0] * r2, v1 = acc[ai][0][m][1] * acc[ai][1][m][1] * r2;
                    u32x4 w; w.x = cvt_pk_bf16(v0[0], v0[1]); w.y = cvt_pk_bf16(v0[2], v0[3]); w.z = cvt_pk_bf16(v1[0], v1[1]); w.w = cvt_pk_bf16(v1[2], v1[3]);
                    *(u32x4*)(rowp) = w; }
        }
    }
};
struct EpiSwiGLU {
    static constexpr bool PERM = true, AFTER_DRAIN = false;
    bf16_t* H; const float* inv; mutable float rs[8];
    __device__ __forceinline__ void pre(const Unit& u, int wr, int fr) const {
#pragma unroll
        for (int i = 0; i < 8; ++i) rs[i] = inv[u.pm * BM + (i >> 2) * HALF + wr * 64 + (i & 3) * 16 + fr]; }
    __device__ __forceinline__ float act(float g, float uu) const { return g * uu * __builtin_amdgcn_rcpf(1.0f + __builtin_amdgcn_exp2f(-1.4426950408889634f * g)); }
    __device__ __forceinline__ void operator()(const f32x4 (&acc)[2][2][4][2], const Unit& u, int wr, int wc, int fr, int fq) const {
        const int row0 = u.pm * BM + wr * 64 + fr;
        const int col0 = u.pn * HALF + wc * 32 + 8 * fq;
#pragma unroll
        for (int ai = 0; ai < 2; ++ai)
#pragma unroll
            for (int m = 0; m < 4; ++m) { bf16_t* rowp = H + (size_t)(row0 + ai * HALF + m * 16) * 2816 + col0;
                const float r1 = rs[ai * 4 + m]; const f32x4 g0 = acc[ai][0][m][0] * r1, g1 = acc[ai][0][m][1] * r1, u0 = acc[ai][1][m][0] * r1, u1 = acc[ai][1][m][1] * r1;
                u32x4 w; w.x = cvt_pk_bf16(act(g0[0], u0[0]), act(g0[1], u0[1])); w.y = cvt_pk_bf16(act(g0[2], u0[2]), act(g0[3], u0[3]));
                w.z = cvt_pk_bf16(act(g1[0], u1[0]), act(g1[1], u1[1])); w.w = cvt_pk_bf16(act(g1[2], u1[2]), act(g1[3], u1[3]));
                __builtin_nontemporal_store(w, (u32x4*)(rowp)); }
    }
};
struct EpiQKVs {
    static constexpr bool PERM = true, AFTER_DRAIN = false;
    bf16_t* O; size_t split_stride; const float* inv; float qscale; mutable float rs[8];
    __device__ __forceinline__ void pre(const Unit& u, int wr, int fr) const {
#pragma unroll
        for (int i = 0; i < 8; ++i) rs[i] = inv[u.pm * BM + (i >> 2) * HALF + wr * 64 + (i & 3) * 16 + fr]; }
    __device__ __forceinline__ void operator()(const f32x4 (&acc)[2][2][4][2], const Unit& u, int wr, int wc, int fr, int fq) const {
        const int t = u.pn >> 2; bf16_t* base = O + (size_t)t * split_stride; const float sc = t == 0 ? qscale : 1.f;
        const int row0 = u.pm * BM + wr * 64 + fr, col0 = (u.pn & 3) * BM + wc * 32 + 8 * fq;
#pragma unroll
        for (int ai = 0; ai < 2; ++ai)
#pragma unroll
            for (int m = 0; m < 4; ++m) { bf16_t* rowp = base + (size_t)(row0 + ai * HALF + m * 16) * 1024 + col0; const float r1 = rs[ai * 4 + m] * sc;
#pragma unroll
                for (int bj = 0; bj < 2; ++bj) { const f32x4 v0 = acc[ai][bj][m][0] * r1, v1 = acc[ai][bj][m][1] * r1;
                    u32x4 w; w.x = cvt_pk_bf16(v0[0], v0[1]); w.y = cvt_pk_bf16(v0[2], v0[3]); w.z = cvt_pk_bf16(v1[0], v1[1]); w.w = cvt_pk_bf16(v1[2], v1[3]);
                    *(u32x4*)(rowp + bj * HALF) = w; } }
    }
};
struct TailOrder {
    int nsplit, ksub_bytes, G, c;
    __device__ __forceinline__ bool next(int i, Unit& u) const { const int L = i * G + c; if (L >= 16 * nsplit) return false; const int ks = L >> 4, t = L & 15; u.pm = 256 + (t & 3); u.pn = t >> 2; u.kb = ks * ksub_bytes; return true; }
    __device__ __forceinline__ void a_ready(const Unit&) const {}
    __device__ __forceinline__ void done(const Unit&) const {}
};
struct EpiPartF32 {
    static constexpr bool PERM = false, AFTER_DRAIN = false;
    float* P; int ksub_bytes;
    __device__ __forceinline__ void pre(const Unit&, int, int) const {}
    __device__ __forceinline__ void operator()(const f32x4 (&acc)[2][2][4][2], const Unit& u, int wr, int wc, int fr, int fq) const {
        const int ks = u.kb / ksub_bytes; const int row0 = (u.pm - 256) * BM + wr * 64 + fr, col0 = u.pn * BM + wc * 32 + 4 * fq;
        float* base = P + (size_t)ks * 1024 * 1024;
#pragma unroll
        for (int ai = 0; ai < 2; ++ai)
#pragma unroll
            for (int m = 0; m < 4; ++m) { float* rowp = base + (size_t)(row0 + ai * HALF + m * 16) * 1024 + col0;
#pragma unroll
                for (int bj = 0; bj < 2; ++bj)
#pragma unroll
                    for (int n = 0; n < 2; ++n) *(f32x4*)(rowp + bj * HALF + n * 16) = acc[ai][bj][m][n]; }
    }
};
}

struct Args {
    const float *x_prompt, *x_sample, *state_conv, *cache_k, *cache_v, *conv_w_in, *conv_kernel, *conv_w_out, *attn_w_qkv, *attn_w_o, *attn_rel_bias,
        *norm_mix_pre, *norm_mix_post, *norm_ffn_pre, *norm_ffn_post, *ffn_w_gate_up, *ffn_w_down;
    float* out; unsigned char* ws;
};

template <int MODE> __device__ __forceinline__ int dest_row(int n) {
    if (MODE == 1) { const int hh = n / DFF, rem = n - hh * DFF; return ((rem >> 7) << 8) + (hh << 7) + (rem & 127); }
    if (MODE == 2) { if (n < 1024) return n; const int np = n - 1024, hh = np >> 10, rem = np & 1023; return 1024 + ((rem >> 7) << 8) + (hh << 7) + (rem & 127); }
    return n;
}
template <int MODE> __device__ __forceinline__ void transpose_item(const float* W, int K, int N, bf16_t* WT, LAS float* scr, int item, int lane, const float* gk) {
    const int nblk = N / 32, kb = item / nblk, nb = item % nblk, k0 = 64 * kb, n0 = 32 * nb;
#pragma unroll 8
    for (int i = 0; i < 32; ++i) { const int kk = 2 * i + (lane >> 5); scr[kk * 33 + (lane & 31)] = W[(size_t)(k0 + kk) * N + n0 + (lane & 31)]; }
    asm volatile("s_waitcnt lgkmcnt(0)" ::: "memory");
    const int c = lane & 7; const int drow = dest_row<MODE>(n0);
    f32x4 ga = (f32x4){1.f, 1.f, 1.f, 1.f}, gb = ga;
    if (gk) { ga = *(const f32x4*)(gk + k0 + 8 * c); gb = *(const f32x4*)(gk + k0 + 8 * c + 4); }
#pragma unroll
    for (int j = 0; j < 4; ++j) { const int n = (lane >> 3) + 8 * j; const LAS float* s = scr + (8 * c) * 33 + n;
        u32x4 o; o.x = pk2(s[0 * 33] * ga.x, s[1 * 33] * ga.y); o.y = pk2(s[2 * 33] * ga.z, s[3 * 33] * ga.w); o.z = pk2(s[4 * 33] * gb.x, s[5 * 33] * gb.y); o.w = pk2(s[6 * 33] * gb.z, s[7 * 33] * gb.w);
        *(u32x4*)(WT + (size_t)(drow + n) * K + k0 + 8 * c) = o; }
    asm volatile("s_waitcnt lgkmcnt(0)" ::: "memory");
}

__device__ __forceinline__ void norm_row(const float* xrow, bf16_t* orow, float* invp, int lane) {
    const f32x4* xr = (const f32x4*)xrow + lane;
    f32x4 v[4]; float s = 0.f;
#pragma unroll
    for (int j = 0; j < 4; ++j) { v[j] = xr[64 * j]; s += (v[j].x * v[j].x + v[j].y * v[j].y) + (v[j].z * v[j].z + v[j].w * v[j].w); }
    u32x2* o8 = (u32x2*)orow + lane;
#pragma unroll
    for (int j = 0; j < 4; ++j) { u32x2 w; w.x = pk2(v[j].x, v[j].y); w.y = pk2(v[j].z, v[j].w); o8[64 * j] = w; }
    const float inv = 1.0f / sqrtf(wave_sum(s) * (1.f / D) + EPS);
    if (lane == 0) *invp = inv;
}
template <int XIN> struct ResRaw { u32x2 m[2][4]; f32x4 xf[2][4]; u32x2 xb[2][4]; };
template <int XIN> __device__ __forceinline__ void res_load(ResRaw<XIN>& R, const Args& a, const bf16_t* MO, const bf16_t* XR, const float* part, int nsplit, int m0, int NGW, int lane) {
#pragma unroll
    for (int k = 0; k < 2; ++k) {
        const int m = (k == 0) ? m0 : ((m0 + NGW < M) ? m0 + NGW : m0);
        if (m >= MP) {
            const f32x4* pp = (const f32x4*)(part + (size_t)(m - MP) * D) + lane;
#pragma unroll
            for (int j = 0; j < 4; ++j) { f32x4 sacc = pp[64 * j];
                for (int ks = 1; ks < nsplit; ++ks) sacc = sacc + pp[(size_t)ks * 262144 + 64 * j];
                u32x2 w; w.x = pk2(sacc.x, sacc.y); w.y = pk2(sacc.z, sacc.w); R.m[k][j] = w; }
        } else {
            const u32x2* mr = (const u32x2*)(MO + (size_t)m * D) + lane;
#pragma unroll
            for (int j = 0; j < 4; ++j) R.m[k][j] = mr[64 * j];
        }
        if (XIN == 0) { const float* xr = m < MP ? a.x_prompt + (size_t)m * D : a.x_sample + (size_t)(m - MP) * D;
#pragma unroll
            for (int j = 0; j < 4; ++j) R.xf[k][j] = ((const f32x4*)xr + lane)[64 * j];
        } else { const u32x2* xr = (const u32x2*)(XR + (size_t)m * D) + lane;
#pragma unroll
            for (int j = 0; j < 4; ++j) R.xb[k][j] = xr[64 * j]; }
    }
}
template <int XIN, int XOUT> __device__ __forceinline__ void res_pass(const Args& a, const bf16_t* MO, bf16_t* XR, float* INV, float* Y, const float* gp, const float* part, int nsplit, int gw, int NGW, int lane) {
    const f32x4* gr = (const f32x4*)gp + lane;
    ResRaw<XIN> nx;
    if (gw < M) res_load<XIN>(nx, a, MO, XR, part, nsplit, gw, NGW, lane);
    for (int m0 = gw; m0 < M; m0 += 2 * NGW) {
        int mm[2]; mm[0] = m0; mm[1] = (m0 + NGW < M) ? m0 + NGW : m0;
        const ResRaw<XIN> cur = nx;
        if (m0 + 2 * NGW < M) res_load<XIN>(nx, a, MO, XR, part, nsplit, m0 + 2 * NGW, NGW, lane);
        f32x4 mv[2][4], xv[2][4]; float s[2] = {0.f, 0.f};
#pragma unroll
        for (int k = 0; k < 2; ++k)
#pragma unroll
            for (int j = 0; j < 4; ++j) { const u32x2 w = cur.m[k][j]; mv[k][j] = (f32x4){bflo(w.x), bfhi(w.x), bflo(w.y), bfhi(w.y)};
                if (XIN == 0) xv[k][j] = cur.xf[k][j]; else { const u32x2 x = cur.xb[k][j]; xv[k][j] = (f32x4){bflo(x.x), bfhi(x.x), bflo(x.y), bfhi(x.y)}; }
                s[k] += (mv[k][j].x * mv[k][j].x + mv[k][j].y * mv[k][j].y) + (mv[k][j].z * mv[k][j].z + mv[k][j].w * mv[k][j].w); }
        float inv[2], s2[2] = {0.f, 0.f};
#pragma unroll
        for (int k = 0; k < 2; ++k) inv[k] = 1.0f / sqrtf(wave_sum(s[k]) * (1.f / D) + EPS);
#pragma unroll
        for (int k = 0; k < 2; ++k)
#pragma unroll
            for (int j = 0; j < 4; ++j) { const f32x4 gg = gr[64 * j]; xv[k][j] = xv[k][j] + mv[k][j] * inv[k] * gg;
                s2[k] += (xv[k][j].x * xv[k][j].x + xv[k][j].y * xv[k][j].y) + (xv[k][j].z * xv[k][j].z + xv[k][j].w * xv[k][j].w); }
        if (XOUT == 1) {
#pragma unroll
            for (int k = 0; k < 2; ++k) { f32x4* xo = (f32x4*)(Y + (size_t)mm[k] * D) + lane;
#pragma unroll
                for (int j = 0; j < 4; ++j) xo[64 * j] = xv[k][j]; }
        } else {
#pragma unroll
            for (int k = 0; k < 2; ++k) {
                const float inv2 = 1.0f / sqrtf(wave_sum(s2[k]) * (1.f / D) + EPS);
                u32x2* xo = (u32x2*)(XR + (size_t)mm[k] * D) + lane;
#pragma unroll
                for (int j = 0; j < 4; ++j) { const f32x4 x = xv[k][j]; u32x2 wx; wx.x = pk2(x.x, x.y); wx.y = pk2(x.z, x.w); xo[64 * j] = wx; }
                if (lane == 0) INV[mm[k]] = inv2;
            }
        }
    }
}

namespace att {
__device__ __forceinline__ int crow(int i, int h) { return (i & 3) + 8 * (i >> 2) + 4 * h; }
typedef short v4i16_t __attribute__((ext_vector_type(4)));
__device__ __forceinline__ s16x4 vtr(const LAS unsigned char* p) { return __builtin_bit_cast(s16x4, __builtin_amdgcn_ds_read_tr16_b64_v4i16((LAS v4i16_t*)p)); }
struct Item { const bf16_t* q; const bf16_t* kc; const bf16_t* vc; const bf16_t* kn; const bf16_t* vn; bf16_t* o; float* kso; float* vso; const float* kcf; const float* vcf; int nc, kt0, kt1, qpos0, head; };

__device__ __forceinline__ void load_tile(const Item& it, int kt, int lane, bf16x8 (&kf)[4], u32x4 (&vr)[4]) {
    const int r = lane & 31, h = lane >> 5;
    if (it.kcf && kt < it.nc) {
        const float* kp = it.kcf + (size_t)kt * 32 * 1024 + (size_t)r * 1024 + 8 * h; const float* vp = it.vcf + (size_t)kt * 32 * 1024 + (size_t)(lane >> 3) * 1024 + (lane & 7) * 8;
#pragma unroll
        for (int s = 0; s < 4; ++s) { const f32x4 a = *(const f32x4*)(kp + 16 * s), b = *(const f32x4*)(kp + 16 * s + 4);
            u32x4 w; w.x = pk2(a.x, a.y); w.y = pk2(a.z, a.w); w.z = pk2(b.x, b.y); w.w = pk2(b.z, b.w); kf[s] = __builtin_bit_cast(bf16x8, w); }
#pragma unroll
        for (int i = 0; i < 4; ++i) { const f32x4 a = *(const f32x4*)(vp + (size_t)8 * i * 1024), b = *(const f32x4*)(vp + (size_t)8 * i * 1024 + 4);
            u32x4 w; w.x = pk2(a.x, a.y); w.y = pk2(a.z, a.w); w.z = pk2(b.x, b.y); w.w = pk2(b.z, b.w); vr[i] = w; }
        return;
    }
    const bf16_t* kp = it.kn + (size_t)(kt - it.nc) * 32 * 1024;
    const bf16_t* vp = it.vn + (size_t)(kt - it.nc) * 32 * 1024;
#pragma unroll
    for (int s = 0; s < 4; ++s) kf[s] = *(const bf16x8*)(kp + (size_t)r * 1024 + 16 * s + 8 * h);
#pragma unroll
    for (int i = 0; i < 4; ++i) vr[i] = *(const u32x4*)(vp + (size_t)((lane >> 3) + 8 * i) * 1024 + (lane & 7) * 8);
}

__device__ __forceinline__ void attn_item(const Item& it, LAS unsigned char* vlds, LAS float* tab, const float* table, int lane) {
    const int r = lane & 31, h = lane >> 5;
    asm volatile("s_waitcnt lgkmcnt(0)" ::: "memory");
    for (int i = lane; i < 257; i += 64) tab[i] = table[it.head * 257 + i] * LOG2E;
    bf16x8 qf[4];
#pragma unroll
    for (int s = 0; s < 4; ++s) qf[s] = *(const bf16x8*)(it.q + (size_t)r * 1024 + 16 * s + 8 * h);
    f32x16 o0, o1;
#pragma unroll
    for (int i = 0; i < 16; ++i) { o0[i] = 0.f; o1[i] = 0.f; }
    float mrun = -1e30f, lrun = 0.f;
    asm volatile("s_waitcnt lgkmcnt(0)" ::: "memory");
    const float cfar = tab[256];
    const int qpos = it.qpos0 + r;
    const int i16 = lane & 15, q4 = i16 >> 2, p4 = i16 & 3, g = (lane >> 4) & 1;
    const LAS unsigned char* trbase = vlds + (4 * h + q4) * 128 + (16 * g + 4 * p4) * 2;
    bf16x8 kf[4]; u32x4 vr[4];
    load_tile(it, it.kt0, lane, kf, vr);
    for (int kt = it.kt0; kt < it.kt1; ++kt) {
        bf16x8 kn_[4]; u32x4 vn_[4];
        if (kt + 1 < it.kt1) load_tile(it, kt + 1, lane, kn_, vn_);
        else {
#pragma unroll
            for (int s = 0; s < 4; ++s) { kn_[s] = kf[s]; vn_[s] = vr[s]; }
        }
        asm volatile("s_waitcnt lgkmcnt(0)" ::: "memory");
#pragma unroll
        for (int i = 0; i < 4; ++i) *(LAS u32x4*)(vlds + ((lane >> 3) + 8 * i) * 128 + (lane & 7) * 16) = vr[i];
        f32x16 p;
#pragma unroll
        for (int i = 0; i < 16; ++i) p[i] = 0.f;
#pragma unroll
        for (int s = 0; s < 4; ++s) p = __builtin_amdgcn_mfma_f32_32x32x16_bf16(kf[s], qf[s], p, 0, 0, 0);
        const int kb = 32 * kt;
        if (it.qpos0 - (kb + 31) >= 128) {
#pragma unroll
            for (int i = 0; i < 16; ++i) p[i] += cfar;
        } else {
#pragma unroll
            for (int i = 0; i < 16; ++i) { int dd = qpos - (kb + crow(i, h)); dd = dd < -128 ? -128 : (dd > 128 ? 128 : dd); p[i] += tab[dd + 128]; }
        }
        float tm = p[0];
#pragma unroll
        for (int i = 1; i < 16; ++i) tm = fmaxf(tm, p[i]);
        tm = fmaxf(tm, __shfl_xor(tm, 32));
        const float mnew = fmaxf(mrun, tm);
        const float sc = __builtin_amdgcn_exp2f(mrun - mnew);
        mrun = mnew;
        float ps = 0.f;
#pragma unroll
        for (int i = 0; i < 16; ++i) { p[i] = __builtin_amdgcn_exp2f(p[i] - mnew); ps += p[i]; }
        lrun = lrun * sc + ps;
#pragma unroll
        for (int i = 0; i < 16; ++i) { o0[i] *= sc; o1[i] *= sc; }
        u32x4 w0, w1;
        w0.x = pk2(p[0], p[1]); w0.y = pk2(p[2], p[3]); w0.z = pk2(p[4], p[5]); w0.w = pk2(p[6], p[7]);
        w1.x = pk2(p[8], p[9]); w1.y = pk2(p[10], p[11]); w1.z = pk2(p[12], p[13]); w1.w = pk2(p[14], p[15]);
        const bf16x8 pf0 = __builtin_bit_cast(bf16x8, w0), pf1 = __builtin_bit_cast(bf16x8, w1);
        asm volatile("s_waitcnt lgkmcnt(0)" ::: "memory");
#pragma unroll
        for (int s = 0; s < 2; ++s) {
            const s16x4 a_lo = vtr(trbase + (16 * s) * 128), a_hi = vtr(trbase + (16 * s + 8) * 128);
            const s16x4 b_lo = vtr(trbase + (16 * s) * 128 + 64), b_hi = vtr(trbase + (16 * s + 8) * 128 + 64);
            const bf16x8 va = __builtin_shufflevector(a_lo, a_hi, 0, 1, 2, 3, 4, 5, 6, 7), vb = __builtin_shufflevector(b_lo, b_hi, 0, 1, 2, 3, 4, 5, 6, 7);
            o0 = __builtin_amdgcn_mfma_f32_32x32x16_bf16(va, s == 0 ? pf0 : pf1, o0, 0, 0, 0);
            o1 = __builtin_amdgcn_mfma_f32_32x32x16_bf16(vb, s == 0 ? pf0 : pf1, o1, 0, 0, 0);
        }
#pragma unroll
        for (int s = 0; s < 4; ++s) { kf[s] = kn_[s]; vr[s] = vn_[s]; }
    }
    if (it.kso) {
        load_tile(it, it.nc, lane, kf, vr);
#pragma unroll
        for (int s = 0; s < 4; ++s) { const u32x4 w = __builtin_bit_cast(u32x4, kf[s]); float* d = it.kso + (size_t)r * 1024 + 16 * s + 8 * h;
            *(f32x4*)d = (f32x4){bflo(w.x), bfhi(w.x), bflo(w.y), bfhi(w.y)}; *(f32x4*)(d + 4) = (f32x4){bflo(w.z), bfhi(w.z), bflo(w.w), bfhi(w.w)}; }
#pragma unroll
        for (int i = 0; i < 4; ++i) { const u32x4 w = vr[i]; float* d = it.vso + (size_t)((lane >> 3) + 8 * i) * 1024 + (lane & 7) * 8;
            *(f32x4*)d = (f32x4){bflo(w.x), bfhi(w.x), bflo(w.y), bfhi(w.y)}; *(f32x4*)(d + 4) = (f32x4){bflo(w.z), bfhi(w.z), bflo(w.w), bfhi(w.w)}; }
    }
    lrun += __shfl_xor(lrun, 32);
    const float inv = 1.0f / lrun;
    bf16_t* orow = it.o + (size_t)r * 1024 + 4 * h;
#pragma unroll
    for (int g4 = 0; g4 < 4; ++g4) {
        u32x2 a, b;
        a.x = pk2(o0[4 * g4] * inv, o0[4 * g4 + 1] * inv); a.y = pk2(o0[4 * g4 + 2] * inv, o0[4 * g4 + 3] * inv);
        b.x = pk2(o1[4 * g4] * inv, o1[4 * g4 + 1] * inv); b.y = pk2(o1[4 * g4 + 2] * inv, o1[4 * g4 + 3] * inv);
        *(u32x2*)(orow + 8 * g4) = a; *(u32x2*)(orow + 32 + 8 * g4) = b;
    }
}

constexpr int KROW = 144, KTILE = 64 * KROW, VTILE = 64 * 128, A_K = 0, A_V = 2 * KTILE, A_TAB = A_V + 2 * VTILE, A_SLOT = A_TAB + 1296;
__device__ __forceinline__ float max3f(float a, float b, float c) { float r; asm("v_max3_f32 %0, %1, %2, %3" : "=v"(r) : "v"(a), "v"(b), "v"(c)); return r; }
__device__ __forceinline__ void attn_unit(int b, int hh, int cq, const bf16_t* Qg, const bf16_t* Kg, const bf16_t* Vg, bf16_t* Og, float* kout, float* vout, const float* table, LAS unsigned char* lds, int tid, int lane, int wave) {
    constexpr float THR = 8.0f;
    const int r = lane & 31, h = lane >> 5;
    const int c = 4 * cq + (wave >> 1), half = wave & 1;
    const int j0 = (4 * cq - 8) > 0 ? (4 * cq - 8) : 0, j1 = 4 * cq + 3;
    const size_t rb = (size_t)b * SEQ;
    LAS float* tab = (LAS float*)(lds + A_TAB);
    if (tid < 324) tab[tid] = table[hh * 257 + (tid < 256 ? tid : 256)] * LOG2E;
    const int lrow = tid >> 3, lch = tid & 7;
    const bf16_t* kgp = Kg + (rb + lrow) * D + hh * HD + lch * 8; const bf16_t* vgp = Vg + (rb + lrow) * D + hh * HD + lch * 8;
    const int kwoff = A_K + lrow * KROW + lch * 16, vwoff = A_V + lrow * 128 + ((lch ^ (((lrow >> 1) & 1) << 2)) << 4);
    const long korow = (long)b * CROWS - (SEQ - CROWS) + lrow; float* kop = kout + korow * D + hh * HD + lch * 8; float* vop = vout + korow * D + hh * HD + lch * 8;
#define ATT_KVOUT(tile) do { if (cq >= 6 && (tile) >= 4 * cq) { float* kd = kop + (long)(tile) * 64 * D; float* vd = vop + (long)(tile) * 64 * D; \
        *(f32x4*)kd = (f32x4){bflo(kreg.x), bfhi(kreg.x), bflo(kreg.y), bfhi(kreg.y)}; *(f32x4*)(kd + 4) = (f32x4){bflo(kreg.z), bfhi(kreg.z), bflo(kreg.w), bfhi(kreg.w)}; \
        *(f32x4*)vd = (f32x4){bflo(vreg.x), bfhi(vreg.x), bflo(vreg.y), bfhi(vreg.y)}; *(f32x4*)(vd + 4) = (f32x4){bflo(vreg.z), bfhi(vreg.z), bflo(vreg.w), bfhi(vreg.w)}; } } while (0)
    u32x4 kreg = *(const u32x4*)(kgp + (size_t)j0 * 64 * D), vreg = *(const u32x4*)(vgp + (size_t)j0 * 64 * D);
    bf16x8 qf[4];
    const bf16_t* qp = Qg + (rb + 64 * c + 32 * half + r) * D + hh * HD + 8 * h;
#pragma unroll
    for (int s = 0; s < 4; ++s) qf[s] = *(const bf16x8*)(qp + 16 * s);
    *(LAS u32x4*)(lds + kwoff) = kreg; *(LAS u32x4*)(lds + vwoff) = vreg;
    ATT_KVOUT(j0);
    kreg = *(const u32x4*)(kgp + (size_t)(j0 + 1) * 64 * D); vreg = *(const u32x4*)(vgp + (size_t)(j0 + 1) * 64 * D);
    f32x16 o0, o1;
#pragma unroll
    for (int i = 0; i < 16; ++i) { o0[i] = 0.f; o1[i] = 0.f; }
    float mrun = 0.f, lrun = 0.f;
    const int i16 = lane & 15, q4 = i16 >> 2, p4 = i16 & 3, g = (lane >> 4) & 1;
    const int troff = A_V + (4 * h + q4) * 128 + ((32 * g) ^ (((q4 >> 1) & 1) << 6)) + 8 * p4;
    const int kroff = A_K + r * KROW + 16 * h;
    __syncthreads();
    const float cfar = tab[256];
    f32x16 negf;
#pragma unroll
    for (int i = 0; i < 16; ++i) negf[i] = cfar;
    asm volatile("" : "+v"(negf));
    const int qpos = 64 * c + 32 * half + r;
    bool first = true;
    for (int j = j0; j <= j1; ++j) {
        const int bufk = ((j - j0) & 1) * KTILE, bufv = ((j - j0) & 1) * VTILE;
        if (j < j1) { const int nbk = ((j + 1 - j0) & 1) * KTILE, nbv = ((j + 1 - j0) & 1) * VTILE; *(LAS u32x4*)(lds + nbk + kwoff) = kreg; *(LAS u32x4*)(lds + nbv + vwoff) = vreg; ATT_KVOUT(j + 1); }
        if (j + 2 <= j1) { kreg = *(const u32x4*)(kgp + (size_t)(j + 2) * 64 * D); vreg = *(const u32x4*)(vgp + (size_t)(j + 2) * 64 * D); }
        if (j >= c - 8 && j <= c) {
            f32x16 p0, p1;
            bf16x8 ka[4], kb[4];
#pragma unroll
            for (int s = 0; s < 4; ++s) { ka[s] = *(const LAS bf16x8*)(lds + bufk + kroff + 32 * s); kb[s] = *(const LAS bf16x8*)(lds + bufk + kroff + 32 * KROW + 32 * s); }
            if (j <= c - 3) {
                p0 = __builtin_amdgcn_mfma_f32_32x32x16_bf16(ka[0], qf[0], negf, 0, 0, 0);
                p1 = __builtin_amdgcn_mfma_f32_32x32x16_bf16(kb[0], qf[0], negf, 0, 0, 0);
            } else {
                const LAS float* tb = tab + (qpos - 64 * j - 4 * h + 128 - 59);
#pragma unroll
                for (int i = 0; i < 16; ++i) { p0[i] = tb[59 - ((i & 3) + 8 * (i >> 2))] - mrun; p1[i] = tb[59 - 32 - ((i & 3) + 8 * (i >> 2))] - mrun; }
                p0 = __builtin_amdgcn_mfma_f32_32x32x16_bf16(ka[0], qf[0], p0, 0, 0, 0);
                p1 = __builtin_amdgcn_mfma_f32_32x32x16_bf16(kb[0], qf[0], p1, 0, 0, 0);
            }
#pragma unroll
            for (int s = 1; s < 4; ++s) {
                p0 = __builtin_amdgcn_mfma_f32_32x32x16_bf16(ka[s], qf[s], p0, 0, 0, 0);
                p1 = __builtin_amdgcn_mfma_f32_32x32x16_bf16(kb[s], qf[s], p1, 0, 0, 0);
            }
            float ta = max3f(p0[0], p0[1], p1[0]), tb2 = max3f(p0[2], p0[3], p1[1]);
            ta = max3f(ta, p1[2], p1[3]);
#pragma unroll
            for (int i = 4; i < 16; i += 4) { ta = max3f(ta, p0[i], p0[i + 1]); tb2 = max3f(tb2, p0[i + 2], p0[i + 3]); ta = max3f(ta, p1[i], p1[i + 1]); tb2 = max3f(tb2, p1[i + 2], p1[i + 3]); }
            float tm = fmaxf(ta, tb2);
            { auto rr = __builtin_amdgcn_permlane32_swap(__float_as_uint(tm), __float_as_uint(tm), false, false); tm = fmaxf(__uint_as_float(rr[0]), __uint_as_float(rr[1])); }
            if (first || __any(tm > THR)) {
                const float dl = first ? tm : fmaxf(tm, 0.f); mrun += dl;
                const float sc = __builtin_amdgcn_exp2f(-dl); lrun *= sc;
#pragma unroll
                for (int i = 0; i < 16; ++i) { p0[i] -= dl; p1[i] -= dl; o0[i] *= sc; o1[i] *= sc; negf[i] = cfar - mrun; }
                asm volatile("" : "+v"(negf));
                first = false;
            }
            float ps0 = 0.f, ps1 = 0.f;
#pragma unroll
            for (int i = 0; i < 16; ++i) { p0[i] = __builtin_amdgcn_exp2f(p0[i]); p1[i] = __builtin_amdgcn_exp2f(p1[i]); ps0 += p0[i]; ps1 += p1[i]; }
            lrun += ps0 + ps1;
            u32x4 w0, w1, w2, w3;
            w0.x = pk2(p0[0], p0[1]); w0.y = pk2(p0[2], p0[3]); w0.z = pk2(p0[4], p0[5]); w0.w = pk2(p0[6], p0[7]);
            w1.x = pk2(p0[8], p0[9]); w1.y = pk2(p0[10], p0[11]); w1.z = pk2(p0[12], p0[13]); w1.w = pk2(p0[14], p0[15]);
            w2.x = pk2(p1[0], p1[1]); w2.y = pk2(p1[2], p1[3]); w2.z = pk2(p1[4], p1[5]); w2.w = pk2(p1[6], p1[7]);
            w3.x = pk2(p1[8], p1[9]); w3.y = pk2(p1[10], p1[11]); w3.z = pk2(p1[12], p1[13]); w3.w = pk2(p1[14], p1[15]);
            const bf16x8 pf[4] = {__builtin_bit_cast(bf16x8, w0), __builtin_bit_cast(bf16x8, w1), __builtin_bit_cast(bf16x8, w2), __builtin_bit_cast(bf16x8, w3)};
#pragma unroll
            for (int ks = 0; ks < 4; ++ks) {
                const LAS unsigned char* tb = lds + bufv + troff + ks * 16 * 128;
                const s16x4 a_lo = vtr(tb), a_hi = vtr(tb + 8 * 128);
                const LAS unsigned char* tb1 = lds + bufv + (troff ^ 64) + ks * 16 * 128;
                const s16x4 b_lo = vtr(tb1), b_hi = vtr(tb1 + 8 * 128);
                const bf16x8 va = __builtin_shufflevector(a_lo, a_hi, 0, 1, 2, 3, 4, 5, 6, 7), vb = __builtin_shufflevector(b_lo, b_hi, 0, 1, 2, 3, 4, 5, 6, 7);
                o0 = __builtin_amdgcn_mfma_f32_32x32x16_bf16(va, pf[ks], o0, 0, 0, 0);
                o1 = __builtin_amdgcn_mfma_f32_32x32x16_bf16(vb, pf[ks], o1, 0, 0, 0);
            }
        }
        asm volatile("s_waitcnt lgkmcnt(0)\n\ts_barrier" ::: "memory");
    }
    lrun += __shfl_xor(lrun, 32);
    const float inv = 1.0f / lrun;
    bf16_t* orow = Og + (rb + 64 * c + 32 * half + r) * D + hh * HD + 4 * h;
#pragma unroll
    for (int g4 = 0; g4 < 4; ++g4) {
        u32x2 x, y;
        x.x = pk2(o0[4 * g4] * inv, o0[4 * g4 + 1] * inv); x.y = pk2(o0[4 * g4 + 2] * inv, o0[4 * g4 + 3] * inv);
        y.x = pk2(o1[4 * g4] * inv, o1[4 * g4 + 1] * inv); y.y = pk2(o1[4 * g4 + 2] * inv, o1[4 * g4 + 3] * inv);
        *(u32x2*)(orow + 8 * g4) = x; *(u32x2*)(orow + 32 + 8 * g4) = y;
    }
#undef ATT_KVOUT
}
}

#define XB_TMO      128
#define XB_XCNT(j)  (256  + 64 * (j))
#define XB_XSUB(j)  (1280 + 64 * (j))
#define XB_XGEN(j)  (2304 + 64 * (j))
#define XB_TOP      3328
#define XB_TOPGEN   3392
#define XCD_BAR_WORDS 3456
#define XB_SPIN_CAP (1u << 18)

__device__ __forceinline__ unsigned xb_ld(unsigned* p)              { return __hip_atomic_load(p, __ATOMIC_RELAXED, __HIP_MEMORY_SCOPE_AGENT); }
__device__ __forceinline__ unsigned xb_add(unsigned* p, unsigned v) { return __hip_atomic_fetch_add(p, v, __ATOMIC_RELAXED, __HIP_MEMORY_SCOPE_AGENT); }
__device__ __forceinline__ unsigned xb_xcc_id() { return (unsigned)__builtin_amdgcn_s_getreg((3 << 11) | 20) & 0xFu; }
#define XB_SPIN(cond, bar) do { unsigned _sp = 0; while (cond) { __builtin_amdgcn_s_sleep(1); \
    if ((++_sp & 255u) == 0u) { if (xb_ld(&(bar)[XB_TMO])) break; if (_sp > XB_SPIN_CAP) { atomicAdd(&(bar)[XB_TMO], 1u); break; } } } } while (0)

struct XcdBarrier {
    unsigned* bar; unsigned x;
    volatile LAS unsigned* st;
};

__device__ __forceinline__ XcdBarrier xcd_barrier_post(unsigned* bar, volatile LAS unsigned* st) {
    XcdBarrier b; b.bar = bar; b.x = xb_xcc_id(); b.st = st;
    if (threadIdx.x == 0) (void)xb_add(&bar[XB_XCNT(b.x)], 1u);
    return b;
}
__device__ __forceinline__ void xcd_barrier_complete(unsigned* bar, unsigned x, unsigned& nloc, unsigned& nx) {
    const unsigned G = gridDim.x * gridDim.y * gridDim.z;
    unsigned sum, cnt, mine, sp = 0u;
    for (;;) {
        sum = 0u; cnt = 0u; mine = 0u;
#pragma unroll
        for (unsigned j = 0; j < 16; ++j) { const unsigned c = xb_ld(&bar[XB_XCNT(j)]); sum += c; cnt += (c > 0u) ? 1u : 0u; mine = (j == x) ? c : mine; }
        if (sum == G) break;
        __builtin_amdgcn_s_sleep(1);
        if ((++sp & 255u) == 0u) { if (xb_ld(&bar[XB_TMO])) break; if (sp > XB_SPIN_CAP) { atomicAdd(&bar[XB_TMO], 1u); break; } }
    }
    nloc = mine > 0u ? mine : 1u; nx = cnt > 0u ? cnt : 1u;
}

__device__ __forceinline__ void xcd_barrier(const XcdBarrier& b) {
    asm volatile("s_waitcnt vmcnt(0)" ::: "memory");
    __syncthreads();
    if (threadIdx.x == 0) {
        unsigned* bar = b.bar;
        __builtin_amdgcn_s_waitcnt(0);
        unsigned nloc = b.st[0], nx = b.st[1];
        if (nloc == 0u) { xcd_barrier_complete(bar, b.x, nloc, nx); b.st[0] = nloc; b.st[1] = nx; }
        const unsigned old = xb_add(&bar[XB_XSUB(b.x)], 1u);
        const unsigned gen = old / nloc;
        if (old + 1u == (gen + 1u) * nloc) {
            __builtin_amdgcn_fence(__ATOMIC_RELEASE, "agent");
            asm volatile("s_waitcnt vmcnt(0)" ::: "memory");
            const unsigned og = xb_add(&bar[XB_TOP], 1u);
            const unsigned tg = og / nx;
            if (og + 1u == (tg + 1u) * nx) xb_add(&bar[XB_TOPGEN], 1u);
            else XB_SPIN(xb_ld(&bar[XB_TOPGEN]) == tg, bar);
            __builtin_amdgcn_fence(__ATOMIC_ACQUIRE, "agent");
            xb_add(&bar[XB_XGEN(b.x)], 1u);
            asm volatile("s_waitcnt vmcnt(0)" ::: "memory");
        } else {
            XB_SPIN(xb_ld(&bar[XB_XGEN(b.x)]) == gen, bar);
            __builtin_amdgcn_fence(__ATOMIC_ACQUIRE, "agent");
            asm volatile("s_waitcnt vmcnt(0)" ::: "memory");
        }
    }
    __syncthreads();
}


__global__ void __launch_bounds__(NWAVES * 64, 2) fwd_kernel(Args a) {
    extern __shared__ __attribute__((aligned(16))) unsigned char lds_raw[];
    cg::grid_group grid = cg::this_grid();
    LAS unsigned char* lds = (LAS unsigned char*)lds_raw;
    int tid = threadIdx.x, lane = tid & 63; const int wave = __builtin_amdgcn_readfirstlane(tid >> 6);
    const int G = gridDim.x, gw = blockIdx.x * NWAVES + wave, NGW = G * NWAVES;
    unsigned char* ws = a.ws;
    bf16_t *Win_t, *Wout_t, *Wgu_t0, *Wgu_t1, *Wd_t0, *Wd_t1, *Wqkv_t, *Wo_t, *BA, *BB, *BC, *MO, *OB, *HB, *XR; float *Y, *PART, *INV; unsigned* qctr;
#define DERIVE() do { size_t z_ = 0; asm volatile("" : "+s"(z_)); unsigned char* w_ = a.ws + z_;     \
        Win_t = (bf16_t*)(w_ + WS_WIN); Wout_t = (bf16_t*)(w_ + WS_WOUT); Wgu_t0 = (bf16_t*)(w_ + WS_WGU0); Wgu_t1 = (bf16_t*)(w_ + WS_WGU1); \
        Wd_t0 = (bf16_t*)(w_ + WS_WD0); Wd_t1 = (bf16_t*)(w_ + WS_WD1); Wqkv_t = (bf16_t*)(w_ + WS_WQKV); Wo_t = (bf16_t*)(w_ + WS_WO); \
        BA = (bf16_t*)(w_ + WS_A); BB = (bf16_t*)(w_ + WS_B); BC = (bf16_t*)(w_ + WS_C); MO = (bf16_t*)(w_ + WS_MO); OB = (bf16_t*)(w_ + WS_O); HB = BA; \
        XR = (bf16_t*)(w_ + WS_XR); Y = a.out + O_Y; PART = (float*)(w_ + WS_PART); INV = (float*)(w_ + WS_CTL + MiB); qctr = (unsigned*)(w_ + WS_CTL); } while (0)
    DERIVE(); tid = threadIdx.x; asm volatile("" : "+v"(tid)); lane = tid & 63;
    { volatile LAS unsigned* st0 = (volatile LAS unsigned*)(lds + MISC_OFF); if (tid < 16) st0[tid] = 0u; }
    __syncthreads();
    XcdBarrier bar = xcd_barrier_post((unsigned*)(ws + WS_CTL) + CW_BAR, (volatile LAS unsigned*)(lds + MISC_OFF) + 8);
    if (a.out == nullptr) grid.sync();

    DERIVE(); tid = threadIdx.x; asm volatile("" : "+v"(tid)); lane = tid & 63;
    {
        LAS float* scr = (LAS float*)(lds + wave * 16384);
        constexpr int I_IN = 16 * 96, I_OUT = 16 * 32, I_GU = 16 * 176, I_D = 44 * 32;
        constexpr int NITEMS = 2 * I_IN + 2 * I_OUT + 2 * I_GU + 2 * I_D;
        for (int it = gw; it < NITEMS; it += NGW) {
            int r = it;
            if (r < I_IN) { transpose_item<2>(a.conv_w_in, D, 3 * D, Win_t, scr, r, lane, a.norm_mix_pre); continue; } r -= I_IN;
            if (r < I_OUT) { transpose_item<0>(a.conv_w_out, D, D, Wout_t, scr, r, lane, nullptr); continue; } r -= I_OUT;
            if (r < I_GU) { transpose_item<1>(a.ffn_w_gate_up, D, 2 * DFF, Wgu_t0, scr, r, lane, a.norm_ffn_pre); continue; } r -= I_GU;
            if (r < I_GU) { transpose_item<1>(a.ffn_w_gate_up + (size_t)D * 2 * DFF, D, 2 * DFF, Wgu_t1, scr, r, lane, a.norm_ffn_pre + D); continue; } r -= I_GU;
            if (r < I_D) { transpose_item<0>(a.ffn_w_down, DFF, D, Wd_t0, scr, r, lane, nullptr); continue; } r -= I_D;
            if (r < I_D) { transpose_item<0>(a.ffn_w_down + (size_t)DFF * D, DFF, D, Wd_t1, scr, r, lane, nullptr); continue; } r -= I_D;
            if (r < I_IN) { transpose_item<0>(a.attn_w_qkv, D, 3 * D, Wqkv_t, scr, r, lane, a.norm_mix_pre + D); continue; } r -= I_IN;
            transpose_item<0>(a.attn_w_o, D, D, Wo_t, scr, r, lane, nullptr);
        }
        for (int m = gw; m < M; m += NGW) { const float* xr = m < MP ? a.x_prompt + (size_t)m * D : a.x_sample + (size_t)(m - MP) * D; norm_row(xr, XR + (size_t)m * D, INV + m, lane); }
    }
    xcd_barrier(bar);
    DERIVE(); tid = threadIdx.x; asm volatile("" : "+v"(tid)); lane = tid & 63;
    { pg8::Gemm g{XR, Win_t, M, 3 * D, D, D}; pg8::StaticOrder S; S.init(M, 3 * D, G, (int)blockIdx.x); pg8::EpiConvIn E{BA, BB, INV};
      pg8::gemm_phase<pg8::EpiConvIn, pg8::StaticOrder, true, true>(lds, g, S, E); }
    xcd_barrier(bar);
    DERIVE(); tid = threadIdx.x; asm volatile("" : "+v"(tid)); lane = tid & 63;
    {
        const f32x4* wp = (const f32x4*)a.conv_kernel + lane;
        f32x4 w0[4], w1[4], w2[4];
#pragma unroll
        for (int j = 0; j < 4; ++j) { w0[j] = wp[64 * j]; w1[j] = wp[256 + 64 * j]; w2[j] = wp[512 + 64 * j]; }
        for (int blk = gw; blk < M / 4; blk += NGW) {
            const int m0 = blk * 4; const bool samp = m0 >= MP; const int t0 = samp ? ((m0 - MP) & 31) : (m0 & 2047); const int b = samp ? ((m0 - MP) >> 5) : (m0 >> 11); const int T = samp ? DS : SEQ;
            const u32x2* up = (const u32x2*)(BB + (size_t)m0 * D) + lane; const u32x2* bp = (const u32x2*)(BA + (size_t)m0 * D) + lane;
            u32x2 ur[6][4], br[4][4];
#pragma unroll
            for (int k = 2; k < 6; ++k)
#pragma unroll
                for (int j = 0; j < 4; ++j) { ur[k][j] = up[(k - 2) * 256 + 64 * j]; br[k - 2][j] = bp[(k - 2) * 256 + 64 * j]; }
            f32x4 h0[4], h1[4];
            if (t0 > 0) {
#pragma unroll
                for (int j = 0; j < 4; ++j) { const u32x2 a0 = up[64 * j - 512], a1 = up[64 * j - 256];
                    h0[j] = (f32x4){bflo(a0.x), bfhi(a0.x), bflo(a0.y), bfhi(a0.y)}; h1[j] = (f32x4){bflo(a1.x), bfhi(a1.x), bflo(a1.y), bfhi(a1.y)}; }
            } else if (samp) {
                const f32x4* st = (const f32x4*)(a.state_conv + (size_t)b * 2 * D) + lane;
#pragma unroll
                for (int j = 0; j < 4; ++j) { h0[j] = st[64 * j]; h1[j] = st[256 + 64 * j]; }
            } else {
#pragma unroll
                for (int j = 0; j < 4; ++j) { h0[j] = (f32x4){0.f, 0.f, 0.f, 0.f}; h1[j] = h0[j]; }
            }
            u32x2* yo = (u32x2*)(BC + (size_t)m0 * D) + lane;
            float* so = (t0 == T - 4) ? a.out + (samp ? O_CONVS : O_CONVP) + (size_t)b * 2 * D : nullptr;
#pragma unroll
            for (int j = 0; j < 4; ++j) {
                f32x4 u2 = h0[j], u1 = h1[j];
#pragma unroll
                for (int k = 0; k < 4; ++k) {
                    const u32x2 uw = ur[k + 2][j]; const f32x4 u0 = (f32x4){bflo(uw.x), bfhi(uw.x), bflo(uw.y), bfhi(uw.y)};
                    const u32x2 bw = br[k][j]; const f32x4 bg = (f32x4){bflo(bw.x), bfhi(bw.x), bflo(bw.y), bfhi(bw.y)};
                    const f32x4 y = bg * (w0[j] * u2 + w1[j] * u1 + w2[j] * u0);
                    u32x2 o; o.x = pk2(y.x, y.y); o.y = pk2(y.z, y.w); yo[k * 256 + 64 * j] = o;
                    if (so && k >= 2) *((f32x4*)(so + (size_t)(k - 2) * D) + lane + 64 * j) = u0;
                    u2 = u1; u1 = u0;
                }
            }
        }
    }
    xcd_barrier(bar);
    DERIVE(); tid = threadIdx.x; asm volatile("" : "+v"(tid)); lane = tid & 63;
    { pg8::Gemm g{BC, Wout_t, MP, D, D, D}; pg8::StaticOrder S; S.init(MP, D, G, (int)blockIdx.x); pg8::EpiBf16<0> E{MO, D, nullptr, 0, 0, 1.f};
      pg8::gemm_phase<pg8::EpiBf16<0>, pg8::StaticOrder, true, true>(lds, g, S, E); }
    { constexpr int KS = D / 4; pg8::Gemm g{BC, Wout_t, M, D, KS, D}; pg8::TailOrder S{4, KS * 2, G, (int)blockIdx.x}; pg8::EpiPartF32 E{PART, KS * 2};
      pg8::gemm_phase<pg8::EpiPartF32, pg8::TailOrder, true, true>(lds, g, S, E); }
    xcd_barrier(bar);
    DERIVE(); tid = threadIdx.x; asm volatile("" : "+v"(tid)); lane = tid & 63;
    res_pass<1, 0>(a, MO, XR, INV, Y, a.norm_mix_post, PART, 4, gw, NGW, lane);
    xcd_barrier(bar);
    DERIVE(); tid = threadIdx.x; asm volatile("" : "+v"(tid)); lane = tid & 63;
    { pg8::Gemm g{XR, Wgu_t0, M, 2 * DFF, D, D}; pg8::StaticOrder S; S.init(M, 2 * DFF, G, (int)blockIdx.x); pg8::EpiSwiGLU E{HB, INV};
      pg8::gemm_phase<pg8::EpiSwiGLU, pg8::StaticOrder, true, true>(lds, g, S, E); }
    xcd_barrier(bar);
    DERIVE(); tid = threadIdx.x; asm volatile("" : "+v"(tid)); lane = tid & 63;
    { pg8::Gemm g{HB, Wd_t0, MP, D, DFF, DFF}; pg8::StaticOrder S; S.init(MP, D, G, (int)blockIdx.x); pg8::EpiBf16<0> E{MO, D, nullptr, 0, 0, 1.f};
      pg8::gemm_phase<pg8::EpiBf16<0>, pg8::StaticOrder, true, true>(lds, g, S, E); }
    { constexpr int KS = DFF / 11; pg8::Gemm g{HB, Wd_t0, M, D, KS, DFF}; pg8::TailOrder S{11, KS * 2, G, (int)blockIdx.x}; pg8::EpiPartF32 E{PART, KS * 2};
      pg8::gemm_phase<pg8::EpiPartF32, pg8::TailOrder, true, true>(lds, g, S, E); }
    xcd_barrier(bar);
    DERIVE(); tid = threadIdx.x; asm volatile("" : "+v"(tid)); lane = tid & 63;
    res_pass<1, 0>(a, MO, XR, INV, Y, a.norm_ffn_post, PART, 11, gw, NGW, lane);
    xcd_barrier(bar);
    DERIVE(); tid = threadIdx.x; asm volatile("" : "+v"(tid)); lane = tid & 63;
    { pg8::Gemm g{XR, Wqkv_t, M, 3 * D, D, D}; pg8::StaticOrder S; S.init(M, 3 * D, G, (int)blockIdx.x);
      pg8::EpiQKVs E{BA, (size_t)(WS_B - WS_A) / 2, INV, QSCALE};
      pg8::gemm_phase<pg8::EpiQKVs, pg8::StaticOrder, true, true>(lds, g, S, E); }
    xcd_barrier(bar);
    DERIVE(); tid = threadIdx.x; asm volatile("" : "+v"(tid)); lane = tid & 63;
    {
        constexpr int NGS1 = (DB * NH) / 8, NPU1 = NB * NH * 8, NGS = NGS1 * REP_SAMPLE, NPU = NPU1 * REP_PROMPT;
        LAS unsigned char* vlds = lds + wave * 4096; LAS float* tabw = (LAS float*)(lds + 32768 + wave * 1088);
        volatile LAS int* slot = (volatile LAS int*)(lds + 65536);
        if (tid == 0) *slot = (int)atomicAdd(qctr, 1u);
        __syncthreads();
        int wi = *slot;
        __syncthreads();
        while (wi < NGS + NPU) {
            int nxt = 0;
            if (tid == 0) nxt = (int)atomicAdd(qctr, 1u);
            if (wi < NGS) {
                att::Item it;
                const int si = (wi % NGS1) * 8 + wave, b = si >> 4, hh = si & 15;
                const size_t rb = (size_t)MP + (size_t)b * DS;
                it.q = BA + rb * D + hh * HD; it.o = OB + rb * D + hh * HD;
                it.kc = nullptr; it.vc = nullptr; it.kcf = a.cache_k + (size_t)b * CROWS * D + hh * HD; it.vcf = a.cache_v + (size_t)b * CROWS * D + hh * HD; it.kn = BB + rb * D + hh * HD; it.vn = BC + rb * D + hh * HD; it.nc = CROWS / 32;
                it.kt0 = 0; it.kt1 = CROWS / 32 + 1; it.qpos0 = CROWS; it.head = hh;
                it.kso = (wi < NGS1) ? a.out + O_KS + (size_t)b * DS * D + hh * HD : nullptr; it.vso = a.out + O_VS + (size_t)b * DS * D + hh * HD;
                att::attn_item(it, vlds, tabw, a.attn_rel_bias, lane);
            } else {
                const int u = (wi - NGS) % NPU1, bh = u >> 3, cq = 7 - (u & 7);
                att::attn_unit(bh >> 4, bh & 15, cq, BA, BB, BC, OB, a.out + O_KP, a.out + O_VP, a.attn_rel_bias, lds, tid, lane, wave);
            }
            __syncthreads();
            if (tid == 0) *slot = nxt;
            __syncthreads();
            wi = *slot;
        }
    }
    xcd_barrier(bar);
    DERIVE(); tid = threadIdx.x; asm volatile("" : "+v"(tid)); lane = tid & 63;
    { pg8::Gemm g{OB, Wo_t, MP, D, D, D}; pg8::StaticOrder S; S.init(MP, D, G, (int)blockIdx.x); pg8::EpiBf16<0> E{MO, D, nullptr, 0, 0, 1.f};
      pg8::gemm_phase<pg8::EpiBf16<0>, pg8::StaticOrder, true, true>(lds, g, S, E); }
    { constexpr int KS = D / 4; pg8::Gemm g{OB, Wo_t, M, D, KS, D}; pg8::TailOrder S{4, KS * 2, G, (int)blockIdx.x}; pg8::EpiPartF32 E{PART, KS * 2};
      pg8::gemm_phase<pg8::EpiPartF32, pg8::TailOrder, true, true>(lds, g, S, E); }
    xcd_barrier(bar);
    DERIVE(); tid = threadIdx.x; asm volatile("" : "+v"(tid)); lane = tid & 63;
    res_pass<1, 0>(a, MO, XR, INV, Y, a.norm_mix_post + D, PART, 4, gw, NGW, lane);
    xcd_barrier(bar);
    DERIVE(); tid = threadIdx.x; asm volatile("" : "+v"(tid)); lane = tid & 63;
    { pg8::Gemm g{XR, Wgu_t1, M, 2 * DFF, D, D}; pg8::StaticOrder S; S.init(M, 2 * DFF, G, (int)blockIdx.x); pg8::EpiSwiGLU E{HB, INV};
      pg8::gemm_phase<pg8::EpiSwiGLU, pg8::StaticOrder, true, true>(lds, g, S, E); }
    xcd_barrier(bar);
    DERIVE(); tid = threadIdx.x; asm volatile("" : "+v"(tid)); lane = tid & 63;
    { pg8::Gemm g{HB, Wd_t1, MP, D, DFF, DFF}; pg8::StaticOrder S; S.init(MP, D, G, (int)blockIdx.x); pg8::EpiBf16<0> E{MO, D, nullptr, 0, 0, 1.f};
      pg8::gemm_phase<pg8::EpiBf16<0>, pg8::StaticOrder, true, true>(lds, g, S, E); }
    { constexpr int KS = DFF / 11; pg8::Gemm g{HB, Wd_t1, M, D, KS, DFF}; pg8::TailOrder S{11, KS * 2, G, (int)blockIdx.x}; pg8::EpiPartF32 E{PART, KS * 2};
      pg8::gemm_phase<pg8::EpiPartF32, pg8::TailOrder, true, true>(lds, g, S, E); }
    xcd_barrier(bar);
    DERIVE(); tid = threadIdx.x; asm volatile("" : "+v"(tid)); lane = tid & 63;
    res_pass<1, 1>(a, MO, XR, INV, Y, a.norm_ffn_post + D, PART, 11, gw, NGW, lane);
}

extern "C" void kernel_launch(void* const* d_in, const int* in_sizes, int n_in, void* d_out, int out_size, void* d_ws, size_t ws_size, hipStream_t stream) {
    static int grid = 0;
    if (grid == 0) {
        if (n_in != 17 || (size_t)out_size != O_END || ws_size < WS_END) { fprintf(stderr, "kernel_launch: unexpected shapes n_in %d out %d ws %zu\n", n_in, out_size, ws_size); grid = -1; return; }
        int dev = 0, cus = 0, per_cu = 0;
        hipGetDevice(&dev); hipDeviceGetAttribute(&cus, hipDeviceAttributeMultiprocessorCount, dev);
        if (hipFuncSetAttribute((const void*)fwd_kernel, hipFuncAttributeMaxDynamicSharedMemorySize, LDS_BYTES) != hipSuccess) { fprintf(stderr, "kernel_launch: hipFuncSetAttribute failed\n"); grid = -1; return; }
        if (hipOccupancyMaxActiveBlocksPerMultiprocessor(&per_cu, (const void*)fwd_kernel, NWAVES * 64, LDS_BYTES) != hipSuccess || per_cu < 1) { fprintf(stderr, "kernel_launch: occupancy query says %d\n", per_cu); per_cu = 1; }
        (void)hipGetLastError();
        grid = cus;
    }
    if (grid < 0) return;
    if (hipMemsetAsync((char*)d_ws + WS_CTL, 0, CTL_BYTES, stream) != hipSuccess) { fprintf(stderr, "kernel_launch: memset failed\n"); return; }
    Args a{};
    const float** p = (const float**)&a;
    for (int i = 0; i < 17; ++i) p[i] = (const float*)d_in[i];
    a.out = (float*)d_out; a.ws = (unsigned char*)d_ws;
    void* args[] = {&a};
    hipError_t e = hipLaunchCooperativeKernel((const void*)fwd_kernel, dim3(grid), dim3(NWAVES * 64), args, LDS_BYTES, stream);
    if (e != hipSuccess) fprintf(stderr, "cooperative launch failed: %s (grid %d)\n", hipGetErrorString(e), grid);
}
```
